# Optimizing an MI355X kernel written in HIP

```python
import math
import jax, jax.numpy as jnp
from jax import lax
import numpy as np

D_MODEL = 1024
BATCH = 8
SEQ = 4096
DEPTH = 1

SSM_WIDTH = D_MODEL // 2
SSM_GROUP = 16
SSM_GROUPS = SSM_WIDTH // SSM_GROUP
SSM_STATE = 64
DT_MIN = 1e-3
DT_MAX = 1e-1
ATTN_HEADS = 8
HEAD_DIM = 64
ATTN_WIDTH = ATTN_HEADS * HEAD_DIM
MOBA_BLOCK = 256
MOBA_TOPK = 3
Q_CHUNK = 16
D_FF = 4 * D_MODEL
RMS_EPS = 1e-6
NEG_INF = -1e30
IN_COLS = SSM_WIDTH + 3 * ATTN_WIDTH + 2 * D_MODEL

kernel_name = "hybrid_s5_moba_gated_block"


def rms_norm(x, g):
    xf = x.astype(jnp.float32)
    var = jnp.mean(xf * xf, axis=-1, keepdims=True)
    return (xf * lax.rsqrt(var + RMS_EPS)).astype(x.dtype) * g


def _ssm_combine(left, right):
    ar1, ai1, br1, bi1 = left
    ar2, ai2, br2, bi2 = right
    ar = ar2 * ar1 - ai2 * ai1
    ai = ar2 * ai1 + ai2 * ar1
    br = ar2 * br1 - ai2 * bi1 + br2
    bi = ar2 * bi1 + ai2 * br1 + bi2
    return ar, ai, br, bi


def s5_mixer(u, lam_re, lam_im, log_dt, b_re, b_im, c_re, c_im, d_skip, w_glu, b_glu):
    f32 = jnp.float32
    bsz, seq, _ = u.shape
    uf = u.astype(f32)
    ug = uf.reshape(bsz, seq, SSM_GROUPS, SSM_GROUP)
    lr = lam_re.astype(f32)
    li = lam_im.astype(f32)
    dt = jnp.exp(log_dt.astype(f32))[:, None]
    mag = jnp.exp(lr * dt)
    ab_re = mag * jnp.cos(li * dt)
    ab_im = mag * jnp.sin(li * dt)
    nr = ab_re - 1.0
    ni = ab_im
    den = lr * lr + li * li
    coef_re = (nr * lr + ni * li) / den
    coef_im = (ni * lr - nr * li) / den
    br = b_re.astype(f32)
    bi = b_im.astype(f32)
    bb_re = coef_re[..., None] * br - coef_im[..., None] * bi
    bb_im = coef_re[..., None] * bi + coef_im[..., None] * br
    bu_re = jnp.einsum('blgh,gph->lbgp', ug, bb_re)
    bu_im = jnp.einsum('blgh,gph->lbgp', ug, bb_im)
    a_re = jnp.broadcast_to(ab_re[None, None], (seq, 1, SSM_GROUPS, SSM_STATE))
    a_im = jnp.broadcast_to(ab_im[None, None], (seq, 1, SSM_GROUPS, SSM_STATE))
    _, _, x_re, x_im = lax.associative_scan(_ssm_combine, (a_re, a_im, bu_re, bu_im), axis=0)
    y = (jnp.einsum('lbgp,ghp->blgh', x_re, c_re.astype(f32))
         - jnp.einsum('lbgp,ghp->blgh', x_im, c_im.astype(f32)))
    y = y.reshape(bsz, seq, SSM_WIDTH) + d_skip.astype(f32) * uf
    v = jax.nn.gelu(y)
    out = v * jax.nn.sigmoid(v @ w_glu.astype(f32) + b_glu.astype(f32))
    return out.astype(u.dtype)


def moba_attention(q, k, v):
    f32 = jnp.float32
    bsz, seq, nh, dh = q.shape
    nb = -(-seq // MOBA_BLOCK)
    lp = nb * MOBA_BLOCK
    pad = lp - seq
    def prep(t):
        t = jnp.transpose(t, (0, 2, 1, 3))
        return jnp.pad(t, ((0, 0), (0, 0), (0, pad), (0, 0)))
    q, k, v = prep(q), prep(k), prep(v)
    kb = k.reshape(bsz, nh, nb, MOBA_BLOCK, dh)
    vb = v.reshape(bsz, nh, nb, MOBA_BLOCK, dh)
    k_mean = jnp.mean(kb.astype(f32), axis=3)
    gate = jnp.einsum('bhtd,bhnd->bhtn', q.astype(f32), k_mean)
    pos = jnp.arange(lp, dtype=jnp.int32)
    qblk = pos // MOBA_BLOCK
    past = jnp.arange(nb, dtype=jnp.int32)[None, :] < qblk[:, None]
    gate = jnp.where(past, gate, NEG_INF)
    n_sel = min(MOBA_TOPK, max(nb - 1, 0))
    if n_sel > 0:
        _, sel = lax.top_k(gate, n_sel)
        sel = sel.astype(jnp.int32)
    else:
        sel = jnp.zeros(gate.shape[:-1] + (0,), jnp.int32)
    sel_valid = sel < qblk[:, None]
    own = jnp.broadcast_to(qblk[:, None], sel.shape[:-1] + (1,))
    idx = jnp.concatenate([sel, own], axis=-1)
    valid = jnp.concatenate([sel_valid, jnp.ones(own.shape, bool)], axis=-1)
    n_slots = idx.shape[-1]
    bh = bsz * nh
    nc = lp // Q_CHUNK
    def to_chunks(t):
        t = t.reshape((bh, nc, Q_CHUNK) + t.shape[3:])
        return jnp.moveaxis(t, 1, 0)
    q_ch = to_chunks(q)
    idx_ch = to_chunks(idx)
    val_ch = to_chunks(valid)
    pos_ch = pos.reshape(nc, Q_CHUNK)
    kb_f = kb.reshape(bh, nb, MOBA_BLOCK, dh)
    vb_f = vb.reshape(bh, nb, MOBA_BLOCK, dh)
    scale = 1.0 / math.sqrt(dh)
    offs = jnp.arange(MOBA_BLOCK, dtype=jnp.int32)
    gather = jax.vmap(lambda blocks, ii: blocks[ii])

    def chunk_fn(args):
        qc, ic, vc, pc = args
        kg = gather(kb_f, ic)
        vg = gather(vb_f, ic)
        s = jnp.einsum('nqd,nqjsd->nqjs', qc, kg).astype(f32) * scale
        key_pos = ic[..., None] * MOBA_BLOCK + offs
        mask = vc[..., None] & (key_pos <= pc[None, :, None, None])
        s = jnp.where(mask, s, NEG_INF)
        p = jax.nn.softmax(s.reshape(bh, Q_CHUNK, n_slots * MOBA_BLOCK), axis=-1)
        p = p.reshape(s.shape).astype(vg.dtype)
        return jnp.einsum('nqjs,nqjsd->nqd', p, vg)

    out = lax.map(chunk_fn, (q_ch, idx_ch, val_ch, pos_ch))
    out = jnp.moveaxis(out, 0, 1).reshape(bsz, nh, lp, dh)[:, :, :seq]
    return jnp.transpose(out, (0, 2, 1, 3)).reshape(bsz, seq, nh * dh)


def setup_inputs(seed: int = 0) -> dict:
    key = jax.random.key(seed)
    ks = jax.random.split(key, 24)
    f32 = jnp.float32
    def nrm(k, shape, scale):
        return jax.random.normal(k, shape, f32) * scale
    def gain(k):
        return 1.0 + 0.01 * jax.random.normal(k, (DEPTH, D_MODEL), f32)
    x = jax.random.normal(ks[0], (BATCH, SEQ, D_MODEL), f32)
    lam_re = -0.5 + 0.01 * jax.random.normal(ks[1], (DEPTH, SSM_GROUPS, SSM_STATE), f32)
    lam_im = (math.pi * jnp.arange(SSM_STATE, dtype=f32))[None, None, :] \
        + 0.01 * jax.random.normal(ks[2], (DEPTH, SSM_GROUPS, SSM_STATE), f32)
    log_dt = jax.random.uniform(ks[3], (DEPTH, SSM_GROUPS), f32,
                                minval=math.log(DT_MIN), maxval=math.log(DT_MAX))
    return {
        "x": x,
        "g_pre_mix": gain(ks[4]),
        "w_in": nrm(ks[5], (DEPTH, D_MODEL, IN_COLS), D_MODEL ** -0.5),
        "lam_re": lam_re,
        "lam_im": lam_im,
        "log_dt": log_dt,
        "b_re": nrm(ks[6], (DEPTH, SSM_GROUPS, SSM_STATE, SSM_GROUP), (2 * SSM_GROUP) ** -0.5),
        "b_im": nrm(ks[7], (DEPTH, SSM_GROUPS, SSM_STATE, SSM_GROUP), (2 * SSM_GROUP) ** -0.5),
        "c_re": nrm(ks[8], (DEPTH, SSM_GROUPS, SSM_GROUP, SSM_STATE), (2 * SSM_STATE) ** -0.5),
        "c_im": nrm(ks[9], (DEPTH, SSM_GROUPS, SSM_GROUP, SSM_STATE), (2 * SSM_STATE) ** -0.5),
        "d_skip": nrm(ks[10], (DEPTH, SSM_WIDTH), 1.0),
        "w_glu": nrm(ks[11], (DEPTH, SSM_WIDTH, SSM_WIDTH), SSM_WIDTH ** -0.5),
        "b_glu": nrm(ks[12], (DEPTH, SSM_WIDTH), 0.01),
        "w_branch_a": nrm(ks[13], (DEPTH, SSM_WIDTH, D_MODEL), SSM_WIDTH ** -0.5),
        "w_branch_b": nrm(ks[14], (DEPTH, ATTN_WIDTH, D_MODEL), ATTN_WIDTH ** -0.5),
        "w_out": nrm(ks[15], (DEPTH, D_MODEL, D_MODEL), D_MODEL ** -0.5),
        "g_post_mix": gain(ks[16]),
        "g_pre_ffn": gain(ks[17]),
        "w_ff1": nrm(ks[18], (DEPTH, D_MODEL, D_FF), D_MODEL ** -0.5),
        "w_ff2": nrm(ks[19], (DEPTH, D_FF, D_MODEL), D_FF ** -0.5),
        "g_post_ffn": gain(ks[20]),
    }


def reference(x, g_pre_mix, w_in, lam_re, lam_im, log_dt, b_re, b_im, c_re, c_im, d_skip,
              w_glu, b_glu, w_branch_a, w_branch_b, w_out, g_post_mix, g_pre_ffn,
              w_ff1, w_ff2, g_post_ffn):
    bsz, seq, _ = x.shape
    cuts = [SSM_WIDTH,
            SSM_WIDTH + ATTN_WIDTH,
            SSM_WIDTH + 2 * ATTN_WIDTH,
            SSM_WIDTH + 3 * ATTN_WIDTH,
            SSM_WIDTH + 3 * ATTN_WIDTH + D_MODEL]
    h = x
    for l in range(DEPTH):
        u = rms_norm(h, g_pre_mix[l])
        z = u @ w_in[l]
        z_ssm, z_q, z_k, z_v, z_ga, z_gb = jnp.split(z, cuts, axis=-1)
        y_a = s5_mixer(z_ssm, lam_re[l], lam_im[l], log_dt[l], b_re[l], b_im[l],
                       c_re[l], c_im[l], d_skip[l], w_glu[l], b_glu[l])
        heads = (bsz, seq, ATTN_HEADS, HEAD_DIM)
        y_b = moba_attention(z_q.reshape(heads), z_k.reshape(heads), z_v.reshape(heads))
        merged = (jax.nn.sigmoid(z_ga) * (y_a @ w_branch_a[l])
                  + jax.nn.sigmoid(z_gb) * (y_b @ w_branch_b[l]))
        mix = merged @ w_out[l]
        h = h + rms_norm(mix, g_post_mix[l])
        f = rms_norm(h, g_pre_ffn[l])
        f = jnp.square(jax.nn.relu(f @ w_ff1[l])) @ w_ff2[l]
        h = h + rms_norm(f, g_post_ffn[l])
    return h
```

```cpp
#include <hip/hip_runtime.h>
#include <cstdio>
#include <cstdint>
#include <cmath>
namespace pg8 {
#define PG8_LAS __attribute__((address_space(3)))
typedef unsigned short bf16_t;
typedef short bf16x8 __attribute__((ext_vector_type(8)));
typedef float f32x4 __attribute__((ext_vector_type(4)));
typedef unsigned u32x4 __attribute__((ext_vector_type(4)));
constexpr int BM = 256, BK = 64, HALF = 128, HTB = HALF * BK * 2  , STAGE_BYTES = 8 * HTB, NXCD = 8, WGM = 8;

__host__ __device__ __forceinline__ int lds_byte(int r, int c) { const int st = (r >> 4) * 2 + (c >> 5), rr = r & 15, cc = c & 31, ob = rr * 64 + cc * 2; return st * 1024 + (ob ^ (((ob >> 9) & 1) << 5)); }
__host__ __device__ __forceinline__ void stage_rc(int b, int& R, int& C) { const int st = b / 1024, sb = b % 1024, swz = sb ^ (((sb >> 9) & 1) << 5); R = (st >> 1) * 16 + swz / 64; C = (st & 1) * 32 + (swz % 64) / 2; }
__host__ __device__ __forceinline__ int perm32(int rho) { const int n = rho >> 4, i = rho & 15; return 8 * (i >> 2) + 4 * n + (i & 3); }

struct Unit { int pm, pn; };
struct Gemm { const bf16_t* A; const bf16_t* Bt; int M, N, K; };

struct StaticOrder {
    int nM, nN, nwg, G, c;
    __host__ __device__ void init(int M, int N, int G_, int c_) { nM = M / BM; nN = N / BM; nwg = nM * nN; G = G_; c = c_; }
    __host__ __device__ bool next(int i, Unit& u) const {
        const long L = (long)i * G + c; if (L >= nwg) return false;
        int wgid = (int)L; { const int q = nwg / NXCD, r = nwg % NXCD, xcd = wgid % NXCD, off = wgid / NXCD; wgid = (xcd < r ? xcd * (q + 1) : r * (q + 1) + (xcd - r) * q) + off; }
        const int nig = WGM * nN, gid = wgid / nig, fm = gid * WGM, gsz = (nM - fm) < WGM ? (nM - fm) : WGM;
        u.pm = fm + ((wgid % nig) % gsz); u.pn = (wgid % nig) / gsz; return true;
    }
    __device__ __forceinline__ void a_ready(const Unit&) const {}
    __device__ __forceinline__ void done(const Unit&) const {}
};

__device__ __forceinline__ unsigned cvt_pk_bf16(float lo, float hi) { unsigned r; asm volatile("v_cvt_pk_bf16_f32 %0, %1, %2" : "=v"(r) : "v"(lo), "v"(hi)); return r; }
typedef float f32x2 __attribute__((ext_vector_type(2)));
__device__ __forceinline__ f32x2 gelu_pk(f32x2 v) {
    const f32x2 av = __builtin_elementwise_abs(v), d = av * 0.2316418882f + 1.0f;
    f32x2 t; t.x = __builtin_amdgcn_rcpf(d.x); t.y = __builtin_amdgcn_rcpf(d.y);
    f32x2 q = t * 0.5307027145f + (-0.7265760135f); q = q * t + 0.7107068705f; q = q * t + (-0.142248368f); q = q * t + 0.127414796f; q = q * t;
    const f32x2 s = (v * v) * (-0.72134752044f);
    f32x2 e; e.x = __builtin_amdgcn_exp2f(s.x); e.y = __builtin_amdgcn_exp2f(s.y);
    const f32x2 m = v * (q * e), r = v - m;
    f32x2 o; o.x = v.x < 0.f ? m.x : r.x; o.y = v.y < 0.f ? m.y : r.y; return o;
}
template <int ACT  > struct EpiBf16 {
    static constexpr bool PERM = true, AFTER_DRAIN = false; static_assert(ACT == 0 || ACT == 1, "EpiBf16: ACT is 0 (none) or 1 (gelu_pk)");
    bf16_t* O; int ldc; const float* bias; int split_cols; size_t split_stride; float scale0;
    __device__ __forceinline__ void operator()(const f32x4 (&acc)[2][2][4][2], const Unit& u, int wr, int wc, int fr, int fq) const {
        const int row0 = u.pm * BM + wr * 64 + fr; int colt = u.pn * BM; bf16_t* base = O;
        float sc = 1.f; if (split_cols) { const int t = colt / split_cols; base += (size_t)t * split_stride; colt -= t * split_cols; if (t == 0) sc = scale0; }
        const int col0 = colt + wc * 32 + 8 * fq, bcol0 = u.pn * BM + wc * 32 + 8 * fq;
        f32x4 bv[2][2];
#pragma unroll
        for (int bj = 0; bj < 2; ++bj)
#pragma unroll
            for (int n = 0; n < 2; ++n) bv[bj][n] = bias ? *(const f32x4*)(bias + bcol0 + bj * HALF + 4 * n) : (f32x4){0.f, 0.f, 0.f, 0.f};
#pragma unroll
        for (int ai = 0; ai < 2; ++ai)
#pragma unroll
            for (int m = 0; m < 4; ++m) { bf16_t* rowp = base + (size_t)(row0 + ai * HALF + m * 16) * ldc + col0;
#pragma unroll
                for (int bj = 0; bj < 2; ++bj) { f32x4 v0 = acc[ai][bj][m][0] + bv[bj][0], v1 = acc[ai][bj][m][1] + bv[bj][1];
                    if (ACT == 1) { f32x2 a = gelu_pk((f32x2){v0[0], v0[1]}), b = gelu_pk((f32x2){v0[2], v0[3]}), c = gelu_pk((f32x2){v1[0], v1[1]}), d = gelu_pk((f32x2){v1[2], v1[3]});
                        v0 = (f32x4){a.x, a.y, b.x, b.y}; v1 = (f32x4){c.x, c.y, d.x, d.y}; }
                    v0 = v0 * sc; v1 = v1 * sc; u32x4 w; w.x = cvt_pk_bf16(v0[0], v0[1]); w.y = cvt_pk_bf16(v0[2], v0[3]); w.z = cvt_pk_bf16(v1[0], v1[1]); w.w = cvt_pk_bf16(v1[2], v1[3]);
                    *(u32x4*)(rowp + bj * HALF) = w; } }
    }
};
__device__ __forceinline__ float bf_lo(unsigned w) { return __builtin_bit_cast(float, w << 16); }
__device__ __forceinline__ float bf_hi(unsigned w) { return __builtin_bit_cast(float, w & 0xffff0000u); }
__device__ __forceinline__ float sigmoid_f(float x) { return __builtin_amdgcn_rcpf(1.0f + __builtin_amdgcn_exp2f(-1.4426950408889634f * x)); }
__device__ __forceinline__ u32x4 pack8(f32x4 v0, f32x4 v1) { u32x4 w; w.x = cvt_pk_bf16(v0[0], v0[1]); w.y = cvt_pk_bf16(v0[2], v0[3]); w.z = cvt_pk_bf16(v1[0], v1[1]); w.w = cvt_pk_bf16(v1[2], v1[3]); return w; }
__device__ __forceinline__ void unpack8(u32x4 w, f32x4& v0, f32x4& v1) { v0 = (f32x4){bf_lo(w.x), bf_hi(w.x), bf_lo(w.y), bf_hi(w.y)}; v1 = (f32x4){bf_lo(w.z), bf_hi(w.z), bf_lo(w.w), bf_hi(w.w)}; }

struct EpiIn {
    static constexpr bool PERM = true, AFTER_DRAIN = false;
    bf16_t *ZS, *Q, *K, *V, *SGA, *SGB; float* ksum; float qscale;
    __device__ __forceinline__ void operator()(const f32x4 (&acc)[2][2][4][2], const Unit& u, int wr, int wc, int fr, int fq) const {
        const int pn = u.pn, row0 = u.pm * BM + wr * 64 + fr;
        bf16_t* base; int ldc, colt, mode;
        if (pn < 2) { base = ZS; ldc = 512; colt = pn * 256; mode = 0; }
        else if (pn < 4) { base = Q; ldc = 512; colt = (pn - 2) * 256; mode = 1; }
        else if (pn < 6) { base = K; ldc = 512; colt = (pn - 4) * 256; mode = 3; }
        else if (pn < 8) { base = V; ldc = 512; colt = (pn - 6) * 256; mode = 0; }
        else if (pn < 12) { base = SGA; ldc = 1024; colt = (pn - 8) * 256; mode = 2; }
        else { base = SGB; ldc = 1024; colt = (pn - 12) * 256; mode = 2; }
        const int col0 = colt + wc * 32 + 8 * fq;
        const float sc = (mode == 1) ? qscale : 1.0f;
#pragma unroll
        for (int ai = 0; ai < 2; ++ai)
#pragma unroll
            for (int m = 0; m < 4; ++m) { bf16_t* rowp = base + (size_t)(row0 + ai * HALF + m * 16) * ldc + col0;
#pragma unroll
                for (int bj = 0; bj < 2; ++bj) { f32x4 v0 = acc[ai][bj][m][0], v1 = acc[ai][bj][m][1];
                    if (mode == 2) {
#pragma unroll
                        for (int j = 0; j < 4; ++j) { v0[j] = sigmoid_f(v0[j]); v1[j] = sigmoid_f(v1[j]); } }
                    else { v0 = v0 * sc; v1 = v1 * sc; }
                    *(u32x4*)(rowp + bj * HALF) = pack8(v0, v1); } }
        if (mode == 3) {
#pragma unroll
            for (int bj = 0; bj < 2; ++bj)
#pragma unroll
                for (int n = 0; n < 2; ++n) { f32x4 s = (f32x4){0.f, 0.f, 0.f, 0.f};
#pragma unroll
                    for (int ai = 0; ai < 2; ++ai)
#pragma unroll
                        for (int m = 0; m < 4; ++m) s += acc[ai][bj][m][n];
#pragma unroll
                    for (int j = 0; j < 4; ++j) { float t = s[j]; t += __shfl_xor(t, 1); t += __shfl_xor(t, 2); t += __shfl_xor(t, 4); t += __shfl_xor(t, 8);
                        if (fr == 0) atomicAdd(ksum + (size_t)u.pm * 512 + col0 + bj * HALF + 4 * n + j, t); } }
        }
    }
};
struct EpiGlu {
    static constexpr bool PERM = true, AFTER_DRAIN = false;
    const bf16_t* VS; bf16_t* YA; const float* bias;
    __device__ __forceinline__ void operator()(const f32x4 (&acc)[2][2][4][2], const Unit& u, int wr, int wc, int fr, int fq) const {
        const int row0 = u.pm * BM + wr * 64 + fr, col0 = u.pn * BM + wc * 32 + 8 * fq;
        f32x4 bv[2][2];
#pragma unroll
        for (int bj = 0; bj < 2; ++bj)
#pragma unroll
            for (int n = 0; n < 2; ++n) bv[bj][n] = *(const f32x4*)(bias + col0 + bj * HALF + 4 * n);
#pragma unroll
        for (int ai = 0; ai < 2; ++ai)
#pragma unroll
            for (int m = 0; m < 4; ++m) { const size_t off = (size_t)(row0 + ai * HALF + m * 16) * 512 + col0;
#pragma unroll
                for (int bj = 0; bj < 2; ++bj) { f32x4 v0 = acc[ai][bj][m][0] + bv[bj][0], v1 = acc[ai][bj][m][1] + bv[bj][1];
                    f32x4 a0, a1; unpack8(*(const u32x4*)(VS + off + bj * HALF), a0, a1);
#pragma unroll
                    for (int j = 0; j < 4; ++j) { v0[j] = a0[j] * sigmoid_f(v0[j]); v1[j] = a1[j] * sigmoid_f(v1[j]); }
                    *(u32x4*)(YA + off + bj * HALF) = pack8(v0, v1); } }
    }
};
template <bool ADD> struct EpiGate {
    static constexpr bool PERM = true, AFTER_DRAIN = false;
    const bf16_t* G; bf16_t* O;
    __device__ __forceinline__ void operator()(const f32x4 (&acc)[2][2][4][2], const Unit& u, int wr, int wc, int fr, int fq) const {
        const int row0 = u.pm * BM + wr * 64 + fr, col0 = u.pn * BM + wc * 32 + 8 * fq;
#pragma unroll
        for (int ai = 0; ai < 2; ++ai)
#pragma unroll
            for (int m = 0; m < 4; ++m) { const size_t off = (size_t)(row0 + ai * HALF + m * 16) * 1024 + col0;
#pragma unroll
                for (int bj = 0; bj < 2; ++bj) { f32x4 g0, g1; unpack8(*(const u32x4*)(G + off + bj * HALF), g0, g1);
                    f32x4 v0 = acc[ai][bj][m][0] * g0, v1 = acc[ai][bj][m][1] * g1;
                    if (ADD) { f32x4 p0, p1; unpack8(*(const u32x4*)(O + off + bj * HALF), p0, p1); v0 += p0; v1 += p1; }
                    *(u32x4*)(O + off + bj * HALF) = pack8(v0, v1); } }
    }
};
struct EpiRelu2 {
    static constexpr bool PERM = true, AFTER_DRAIN = false;
    bf16_t* O; int ldc;
    __device__ __forceinline__ void operator()(const f32x4 (&acc)[2][2][4][2], const Unit& u, int wr, int wc, int fr, int fq) const {
        const int row0 = u.pm * BM + wr * 64 + fr, col0 = u.pn * BM + wc * 32 + 8 * fq;
#pragma unroll
        for (int ai = 0; ai < 2; ++ai)
#pragma unroll
            for (int m = 0; m < 4; ++m) { bf16_t* rowp = O + (size_t)(row0 + ai * HALF + m * 16) * ldc + col0;
#pragma unroll
                for (int bj = 0; bj < 2; ++bj) { f32x4 v0 = acc[ai][bj][m][0], v1 = acc[ai][bj][m][1];
#pragma unroll
                    for (int j = 0; j < 4; ++j) { const float a = fmaxf(v0[j], 0.f), b = fmaxf(v1[j], 0.f); v0[j] = a * a; v1[j] = b * b; }
                    *(u32x4*)(rowp + bj * HALF) = pack8(v0, v1); } }
    }
};
template <class Epi, class Sched, bool ALIGN_EPI = false, bool SP2 = false>
__device__ __forceinline__ void gemm_phase(PG8_LAS unsigned char* lds, const Gemm g, const Sched& S, const Epi& E) {
    const int tid = threadIdx.x, wid = __builtin_amdgcn_readfirstlane(tid >> 6), lane = tid & 63, wr = wid >> 2, wc = wid & 3, fr = lane & 15, fq = lane >> 4;
    const int K = g.K, nt = K / BK;
    unsigned voffA[2], voffB[2];
#pragma unroll
    for (int i = 0; i < 2; ++i) { int R, C; stage_rc(tid * 16 + i * 8192, R, C); const int Rb = Epi::PERM ? ((R & ~31) + perm32(R & 31)) : R;
        voffA[i] = (unsigned)(R * K + C) * 2u; voffB[i] = (unsigned)(Rb * K + C) * 2u; }
    const size_t kstep = (size_t)(BK * 2);
    const size_t hstep = (size_t)HALF * K * 2;
    const size_t tstep = 2 * hstep;
    const unsigned ldsw = (unsigned)wid * 1024u;
    const int aoff = lds_byte(wr * 64 + fr, fq * 8), boff = lds_byte(wc * 32 + fr, fq * 8);
#define PG8_SA(b, h) (((b) * 2 + (h)) * HTB)
#define PG8_SB(b, h) ((4 + (b) * 2 + (h)) * HTB)
#define PG8_STAGE(bufoff, gbase, voff) do { _Pragma("unroll") for (int _i = 0; _i < 2; ++_i) \
        __builtin_amdgcn_global_load_lds((const unsigned*)((const char*)(gbase) + (voff)[_i]), (PG8_LAS unsigned*)(lds + (bufoff) + ldsw + _i * 8192), 16, 0, 0); } while (0)
#define PG8_LDA(dst, b, h) do { _Pragma("unroll") for (int m = 0; m < 4; ++m) _Pragma("unroll") for (int k = 0; k < 2; ++k) dst[m][k] = *(const PG8_LAS bf16x8*)(lds + PG8_SA(b, h) + aoff + m * 2048 + k * 1024); } while (0)
#define PG8_LDB(dst, b, h) do { _Pragma("unroll") for (int n = 0; n < 2; ++n) _Pragma("unroll") for (int k = 0; k < 2; ++k) dst[n][k] = *(const PG8_LAS bf16x8*)(lds + PG8_SB(b, h) + boff + n * 2048 + k * 1024); } while (0)
#define PG8_MMA(ai, bj, At, Bt) do { __builtin_amdgcn_s_setprio(1); _Pragma("unroll") for (int m = 0; m < 4; ++m) _Pragma("unroll") for (int n = 0; n < 2; ++n) _Pragma("unroll") for (int k = 0; k < 2; ++k) \
        acc[ai][bj][m][n] = __builtin_amdgcn_mfma_f32_16x16x32_bf16(Bt[n][k], At[m][k], acc[ai][bj][m][n], 0, 0, 0); __builtin_amdgcn_s_setprio(0); } while (0)
#define PG8_WAIT_V(n) asm volatile("s_waitcnt vmcnt(" #n ")" ::: "memory")
#define PG8_WAIT_L(n) asm volatile("s_waitcnt lgkmcnt(" #n ")" ::: "memory")
#define PG8_BAR __builtin_amdgcn_s_barrier()
#define PG8_SCHED __builtin_amdgcn_sched_barrier(0)
    Unit cur, nxt; int ui = 0;
    if (!S.next(0, cur)) return;
    f32x4 acc[2][2][4][2];
#pragma unroll
    for (int a = 0; a < 2; ++a)
#pragma unroll
        for (int b = 0; b < 2; ++b)
#pragma unroll
            for (int m = 0; m < 4; ++m)
#pragma unroll
                for (int n = 0; n < 2; ++n) acc[a][b][m][n] = (f32x4){0.f, 0.f, 0.f, 0.f};
    bf16x8 At[4][2], B0[2][2], B1[2][2];
    const char* cA = (const char*)g.A + (size_t)cur.pm * tstep; const char* cB = (const char*)g.Bt + (size_t)cur.pn * tstep;
    S.a_ready(cur);
    if constexpr (SP2) {
        PG8_STAGE(PG8_SB(0, 0), cB, voffB); PG8_STAGE(PG8_SB(0, 1), cB + hstep, voffB); PG8_STAGE(PG8_SA(0, 0), cA, voffA); PG8_STAGE(PG8_SA(0, 1), cA + hstep, voffA);
        if (wr == 1) PG8_BAR;
        PG8_WAIT_V(2); PG8_BAR;
        PG8_STAGE(PG8_SB(1, 0), cB + kstep, voffB); PG8_STAGE(PG8_SA(1, 0), cA + kstep, voffA); PG8_STAGE(PG8_SB(1, 1), cB + hstep + kstep, voffB);
        PG8_WAIT_V(6); PG8_BAR;
    } else {
        PG8_STAGE(PG8_SB(0, 0), cB, voffB); PG8_STAGE(PG8_SA(0, 0), cA, voffA); PG8_STAGE(PG8_SB(0, 1), cB + hstep, voffB); PG8_STAGE(PG8_SA(0, 1), cA + hstep, voffA);
        if (wr == 1) PG8_BAR;
        PG8_WAIT_V(4); PG8_BAR;
        PG8_STAGE(PG8_SB(1, 0), cB + kstep, voffB); PG8_STAGE(PG8_SA(1, 0), cA + kstep, voffA); PG8_STAGE(PG8_SB(1, 1), cB + hstep + kstep, voffB);
        PG8_WAIT_V(6); PG8_BAR;
    }
    for (;;) {
        const bool has_next = S.next(ui + 1, nxt);
        const char* nA = has_next ? (const char*)g.A + (size_t)nxt.pm * tstep : cA; const char* nB = has_next ? (const char*)g.Bt + (size_t)nxt.pn * tstep : cB;
        for (int t = 0; t < nt; t += 2) {
            const bool last = (t == nt - 2);
            const char* a1 = cA + (size_t)(t + 1) * kstep;
            const char* a2 = last ? nA : cA + (size_t)(t + 2) * kstep; const char* b2 = last ? nB : cB + (size_t)(t + 2) * kstep;
            const char* a3 = a2 + kstep; const char* b3 = b2 + kstep;
            if (last && has_next) S.a_ready(nxt);
            if constexpr (SP2) {
            PG8_LDB(B0, 0, 0); PG8_LDB(B1, 0, 1); PG8_SCHED; PG8_LDA(At, 0, 0); PG8_STAGE(PG8_SA(1, 1), a1 + hstep, voffA);
            PG8_WAIT_V(8); PG8_WAIT_L(0); PG8_BAR; PG8_MMA(0, 0, At, B0); PG8_MMA(0, 1, At, B1); PG8_BAR; PG8_SCHED;
            PG8_LDA(At, 0, 1); PG8_STAGE(PG8_SB(0, 0), b2, voffB); PG8_STAGE(PG8_SB(0, 1), b2 + hstep, voffB); PG8_STAGE(PG8_SA(0, 0), a2, voffA);
            PG8_WAIT_V(8); PG8_WAIT_L(0); PG8_BAR; PG8_MMA(1, 0, At, B0); PG8_MMA(1, 1, At, B1); PG8_BAR; PG8_SCHED;
            PG8_LDB(B0, 1, 0); PG8_LDB(B1, 1, 1); PG8_SCHED; PG8_LDA(At, 1, 0); PG8_STAGE(PG8_SA(0, 1), a2 + hstep, voffA);
            PG8_WAIT_V(8); PG8_WAIT_L(0); PG8_BAR; PG8_MMA(0, 0, At, B0); PG8_MMA(0, 1, At, B1); PG8_BAR; PG8_SCHED;
            PG8_LDA(At, 1, 1); PG8_STAGE(PG8_SB(1, 0), b3, voffB); PG8_STAGE(PG8_SB(1, 1), b3 + hstep, voffB); PG8_STAGE(PG8_SA(1, 0), a3, voffA);
            PG8_WAIT_V(8); PG8_WAIT_L(0); PG8_BAR; PG8_MMA(1, 0, At, B0); PG8_MMA(1, 1, At, B1); PG8_BAR; PG8_SCHED;
            } else {
            PG8_LDB(B0, 0, 0); PG8_SCHED; PG8_LDA(At, 0, 0); PG8_STAGE(PG8_SA(1, 1), a1 + hstep, voffA);
            PG8_WAIT_L(8); PG8_BAR; PG8_WAIT_L(0); PG8_MMA(0, 0, At, B0); PG8_BAR; PG8_SCHED;
            PG8_LDB(B1, 0, 1); PG8_STAGE(PG8_SB(0, 0), b2, voffB);
            PG8_BAR; PG8_WAIT_L(0); PG8_MMA(0, 1, At, B1); PG8_BAR;
            PG8_LDA(At, 0, 1); PG8_STAGE(PG8_SA(0, 0), a2, voffA);
            PG8_BAR; PG8_WAIT_L(0); PG8_MMA(1, 0, At, B0); PG8_BAR; PG8_SCHED;
            PG8_STAGE(PG8_SB(0, 1), b2 + hstep, voffB);
            PG8_WAIT_V(6); PG8_BAR; PG8_MMA(1, 1, At, B1); PG8_BAR;
            PG8_LDB(B0, 1, 0); PG8_SCHED; PG8_LDA(At, 1, 0); PG8_STAGE(PG8_SA(0, 1), a2 + hstep, voffA);
            PG8_WAIT_L(8); PG8_BAR; PG8_WAIT_L(0); PG8_MMA(0, 0, At, B0); PG8_BAR; PG8_SCHED;
            PG8_LDB(B1, 1, 1); PG8_STAGE(PG8_SB(1, 0), b3, voffB);
            PG8_BAR; PG8_WAIT_L(0); PG8_MMA(0, 1, At, B1); PG8_BAR;
            PG8_LDA(At, 1, 1); PG8_STAGE(PG8_SA(1, 0), a3, voffA);
            PG8_BAR; PG8_WAIT_L(0); PG8_MMA(1, 0, At, B0); PG8_BAR; PG8_SCHED;
            PG8_STAGE(PG8_SB(1, 1), b3 + hstep, voffB);
            PG8_WAIT_V(6); PG8_BAR; PG8_MMA(1, 1, At, B1); PG8_BAR;
            }
        }
        if constexpr (ALIGN_EPI) { if (wr == 0) PG8_BAR; }
        if constexpr (!Epi::AFTER_DRAIN) { E(acc, cur, wr, wc, fr, fq); S.done(cur); }
        if (!has_next) break;
#pragma unroll
        for (int a = 0; a < 2; ++a)
#pragma unroll
            for (int b = 0; b < 2; ++b)
#pragma unroll
                for (int m = 0; m < 4; ++m)
#pragma unroll
                    for (int n = 0; n < 2; ++n) acc[a][b][m][n] = (f32x4){0.f, 0.f, 0.f, 0.f};
        cur = nxt; cA = nA; cB = nB; ++ui;
        if constexpr (ALIGN_EPI) { if (wr == 1) PG8_BAR; }
    }
    PG8_WAIT_V(0);
    if constexpr (!ALIGN_EPI) { if (wr == 0) PG8_BAR; }
    PG8_BAR;
    if constexpr (Epi::AFTER_DRAIN) { E.fused(acc, cur, wr, wc, fr, fq, lds, wid, lane); S.done(cur); }
#undef PG8_SA
#undef PG8_SB
#undef PG8_STAGE
#undef PG8_LDA
#undef PG8_LDB
#undef PG8_MMA
#undef PG8_WAIT_V
#undef PG8_WAIT_L
#undef PG8_BAR
#undef PG8_SCHED
}
}
#define GAS __attribute__((address_space(1)))
#define LAS __attribute__((address_space(3)))
typedef unsigned short bf16;
typedef unsigned v4u __attribute__((ext_vector_type(4)));
typedef float f32x4 __attribute__((ext_vector_type(4)));
typedef short bf16x8 __attribute__((ext_vector_type(8)));
typedef GAS unsigned gu32;
typedef GAS unsigned long long gu64;
#define RLX_AGENT __ATOMIC_RELAXED, __HIP_MEMORY_SCOPE_AGENT
#define LDS_WAIT() asm volatile("s_waitcnt lgkmcnt(0)" ::: "memory")
#define VM_WAIT() asm volatile("s_waitcnt vmcnt(0)" ::: "memory")
__device__ __forceinline__ unsigned long long rt() { return __builtin_amdgcn_s_memrealtime(); }
__device__ __forceinline__ unsigned f2bf(float f) { unsigned u = __builtin_bit_cast(unsigned, f); return (u + 0x7fffu + ((u >> 16) & 1u)) >> 16; }
__device__ __forceinline__ unsigned pk2(float lo, float hi) { return f2bf(lo) | (f2bf(hi) << 16); }
#define XB_TMO      128
#define XB_XCNT(j)  (256  + 64 * (j))
#define XB_XSUB(j)  (1280 + 64 * (j))
#define XB_XGEN(j)  (2304 + 64 * (j))
#define XB_TOP      3328
#define XB_TOPGEN   3392
#define XCD_BAR_WORDS 3456
#define XB_SPIN_CAP (1u << 18)

__device__ __forceinline__ unsigned xb_ld(unsigned* p)              { return __hip_atomic_load(p, __ATOMIC_RELAXED, __HIP_MEMORY_SCOPE_AGENT); }
__device__ __forceinline__ unsigned xb_add(unsigned* p, unsigned v) { return __hip_atomic_fetch_add(p, v, __ATOMIC_RELAXED, __HIP_MEMORY_SCOPE_AGENT); }
__device__ __forceinline__ unsigned xb_xcc_id() { return (unsigned)__builtin_amdgcn_s_getreg((3 << 11) | 20) & 0xFu; }
#define XB_SPIN(cond, bar) do { unsigned _sp = 0; while (cond) { __builtin_amdgcn_s_sleep(1); \
    if ((++_sp & 255u) == 0u) { if (xb_ld(&(bar)[XB_TMO])) break; if (_sp > XB_SPIN_CAP) { atomicAdd(&(bar)[XB_TMO], 1u); break; } } } } while (0)

struct XcdBarrier {
    unsigned* bar; unsigned x;
    volatile LAS unsigned* st;
};

__device__ __forceinline__ XcdBarrier xcd_barrier_post(unsigned* bar, volatile LAS unsigned* st) {
    XcdBarrier b; b.bar = bar; b.x = xb_xcc_id(); b.st = st;
    if (threadIdx.x == 0) (void)xb_add(&bar[XB_XCNT(b.x)], 1u);
    return b;
}
__device__ __forceinline__ void xcd_barrier_complete(unsigned* bar, unsigned x, unsigned& nloc, unsigned& nx) {
    const unsigned G = gridDim.x * gridDim.y * gridDim.z;
    unsigned sum, cnt, mine, sp = 0u;
    for (;;) {
        sum = 0u; cnt = 0u; mine = 0u;
#pragma unroll
        for (unsigned j = 0; j < 16; ++j) { const unsigned c = xb_ld(&bar[XB_XCNT(j)]); sum += c; cnt += (c > 0u) ? 1u : 0u; mine = (j == x) ? c : mine; }
        if (sum == G) break;
        __builtin_amdgcn_s_sleep(1);
        if ((++sp & 255u) == 0u) { if (xb_ld(&bar[XB_TMO])) break; if (sp > XB_SPIN_CAP) { atomicAdd(&bar[XB_TMO], 1u); break; } }
    }
    nloc = mine > 0u ? mine : 1u; nx = cnt > 0u ? cnt : 1u;
}

__device__ __forceinline__ void xcd_barrier(const XcdBarrier& b) {
    asm volatile("s_waitcnt vmcnt(0)" ::: "memory");
    __syncthreads();
    if (threadIdx.x == 0) {
        unsigned* bar = b.bar;
        __builtin_amdgcn_s_waitcnt(0);
        unsigned nloc = b.st[0], nx = b.st[1];
        if (nloc == 0u) { xcd_barrier_complete(bar, b.x, nloc, nx); b.st[0] = nloc; b.st[1] = nx; }
        const unsigned old = xb_add(&bar[XB_XSUB(b.x)], 1u);
        const unsigned gen = old / nloc;
        if (old + 1u == (gen + 1u) * nloc) {
            __builtin_amdgcn_fence(__ATOMIC_RELEASE, "agent");
            asm volatile("s_waitcnt vmcnt(0)" ::: "memory");
            const unsigned og = xb_add(&bar[XB_TOP], 1u);
            const unsigned tg = og / nx;
            if (og + 1u == (tg + 1u) * nx) xb_add(&bar[XB_TOPGEN], 1u);
            else XB_SPIN(xb_ld(&bar[XB_TOPGEN]) == tg, bar);
            __builtin_amdgcn_fence(__ATOMIC_ACQUIRE, "agent");
            xb_add(&bar[XB_XGEN(b.x)], 1u);
            asm volatile("s_waitcnt vmcnt(0)" ::: "memory");
        } else {
            XB_SPIN(xb_ld(&bar[XB_XGEN(b.x)]) == gen, bar);
            __builtin_amdgcn_fence(__ATOMIC_ACQUIRE, "agent");
            asm volatile("s_waitcnt vmcnt(0)" ::: "memory");
        }
    }
    __syncthreads();
}
__device__ __forceinline__ float wave_sum(float v) {
#pragma unroll
    for (int o = 1; o < 64; o <<= 1) v += __shfl_xor(v, o);
    return v;
}
__device__ __forceinline__ void p0_transpose_item(const float* W, int K, int N, bf16* WT, int row_off, LAS float* scr, int item, int lane) {
    const int nblk = N / 32, kb = item / nblk, nb = item % nblk, k0 = 64 * kb, n0 = 32 * nb;
#pragma unroll 8
    for (int i = 0; i < 32; ++i) { const int kk = 2 * i + (lane >> 5); scr[kk * 33 + (lane & 31)] = W[(size_t)(k0 + kk) * N + n0 + (lane & 31)]; }
    LDS_WAIT(); asm volatile("" ::: "memory");
    const int c = lane & 7;
#pragma unroll
    for (int j = 0; j < 4; ++j) { const int n = (lane >> 3) + 8 * j; const LAS float* s = scr + (8 * c) * 33 + n;
        v4u o; o.x = pk2(s[0 * 33], s[1 * 33]); o.y = pk2(s[2 * 33], s[3 * 33]); o.z = pk2(s[4 * 33], s[5 * 33]); o.w = pk2(s[6 * 33], s[7 * 33]);
        *(GAS v4u*)(WT + (size_t)(row_off + n0 + n) * K + k0 + 8 * c) = o; }
    LDS_WAIT(); asm volatile("" ::: "memory");
}
constexpr int NWAVES = 8;
#ifndef MK_PER_PHASE
#define MK_PER_PHASE 0
#endif
constexpr int NPHASES = 11;

constexpr int BATCH = 8, SEQ = 4096, D = 1024, M = BATCH * SEQ, NIN = 4096, SW = 512, AW = 512;
constexpr int NG = 32, GH = 16, NP = 64, NH = 8, HD = 64, FF = 4096, NBLK = 16, BLK = 256;
constexpr float RMS_EPS = 1e-6f;
constexpr float C2 = 0.125f * 1.4426950408889634f;

constexpr size_t MiB = 1u << 20;
constexpr size_t WS_CTL = 0, CTL_ZERO_BYTES = 1 * MiB;
constexpr size_t WS_KSUM = 512 * 1024;
constexpr size_t WS_TAB = 1 * MiB;
constexpr size_t WS_WIN = 2 * MiB, WS_WGLU = 10 * MiB, WS_WA = 11 * MiB, WS_WB = 12 * MiB, WS_WO = 13 * MiB, WS_W1 = 15 * MiB, WS_W2 = 23 * MiB;
constexpr size_t WS_U = 32 * MiB;
constexpr size_t WS_ZS = 96 * MiB, WS_Q = 128 * MiB, WS_K = 160 * MiB, WS_V = 192 * MiB;
constexpr size_t WS_SGA = 224 * MiB, WS_SGB = 288 * MiB;
constexpr size_t WS_VS = 352 * MiB, WS_YA = 384 * MiB;
constexpr size_t WS_MG = 416 * MiB;
constexpr size_t WS_MIX = 352 * MiB;
constexpr size_t WS_HM = 96 * MiB;
constexpr size_t WS_END = 480 * MiB;
constexpr int CW_TMO = 0, CW_CODE = 1, CW_BAR = 4096;

constexpr int RING_OFF = 0, RING_BYTES = 131072;
constexpr int LDSCTL_OFF = RING_BYTES, MISC_OFF = LDSCTL_OFF + 320;
constexpr int LDS_BYTES = 147456;

constexpr int TB_ABR = 0, TB_ABI = 2048, TB_BBR = 4096, TB_BBI = 4096 + 32768, TB_END = 4096 + 65536;

__device__ __forceinline__ float bf2f(bf16 v) { return __builtin_bit_cast(float, (unsigned)v << 16); }
__device__ __forceinline__ float gelu_tanh(float x) {
    const float u = 0.7978845608028654f * (x + 0.044715f * x * x * x);
    const float e = __builtin_amdgcn_exp2f(-2.0f * 1.4426950408889634f * fabsf(u));
    const float t = (1.0f - e) * __builtin_amdgcn_rcpf(1.0f + e);
    return 0.5f * x * (1.0f + (u < 0.f ? -t : t));
}

struct Args { const float* in[21]; float* out; unsigned char* ws; int ph_lo, ph_hi; };

__device__ __forceinline__ void rms_row_to_bf16(const float* xrow, const float* g, bf16* orow, int lane) {
    const GAS f32x4* xr = (const GAS f32x4*)xrow + lane; const GAS f32x4* gr = (const GAS f32x4*)g + lane;
    f32x4 v[4]; float s = 0.f;
#pragma unroll
    for (int j = 0; j < 4; ++j) { v[j] = xr[64 * j]; s += (v[j].x * v[j].x + v[j].y * v[j].y) + (v[j].z * v[j].z + v[j].w * v[j].w); }
    const float r = 1.0f / sqrtf(wave_sum(s) * (1.f / D) + RMS_EPS);
    GAS unsigned long long* o8 = (GAS unsigned long long*)orow + lane;
#pragma unroll
    for (int j = 0; j < 4; ++j) { const f32x4 gg = gr[64 * j];
        o8[64 * j] = (unsigned long long)pk2(v[j].x * r * gg.x, v[j].y * r * gg.y) | ((unsigned long long)pk2(v[j].z * r * gg.z, v[j].w * r * gg.w) << 32); }
}

__global__ void __launch_bounds__(NWAVES * 64, 2) fwd(Args args) {
    extern __shared__ __attribute__((aligned(16))) unsigned char lds[];
    LAS unsigned char* L = (LAS unsigned char*)lds;
    volatile LAS unsigned* MISC = (volatile LAS unsigned*)(L + MISC_OFF);
    const int tid = threadIdx.x, lane = tid & 63, wave = __builtin_amdgcn_readfirstlane(tid >> 6);
    const int G = gridDim.x; const int bx = blockIdx.x; const int vcu = (G % 8 == 0) ? (bx % 8) * (G / 8) + bx / 8 : bx;
    unsigned char* ws = args.ws;
    gu32* ctl = (gu32*)(ws + WS_CTL);
    const float* x = args.in[0];
    float* out = args.out;
    bf16 *Win_t = (bf16*)(ws + WS_WIN), *Wglu_t = (bf16*)(ws + WS_WGLU), *Wa_t = (bf16*)(ws + WS_WA), *Wb_t = (bf16*)(ws + WS_WB), *Wo_t = (bf16*)(ws + WS_WO), *W1_t = (bf16*)(ws + WS_W1), *W2_t = (bf16*)(ws + WS_W2);
    bf16 *U = (bf16*)(ws + WS_U), *ZS = (bf16*)(ws + WS_ZS), *Qb = (bf16*)(ws + WS_Q), *Kb = (bf16*)(ws + WS_K), *Vb = (bf16*)(ws + WS_V), *SGA = (bf16*)(ws + WS_SGA), *SGB = (bf16*)(ws + WS_SGB);
    bf16 *VS = (bf16*)(ws + WS_VS), *YA = (bf16*)(ws + WS_YA), *MG = (bf16*)(ws + WS_MG), *MIX = (bf16*)(ws + WS_MIX), *HM = (bf16*)(ws + WS_HM);
    float* ksum = (float*)(ws + WS_KSUM); float* tab = (float*)(ws + WS_TAB);
    for (int u = tid; u < (LDS_BYTES - LDSCTL_OFF) / 4; u += NWAVES * 64) ((LAS unsigned*)(L + LDSCTL_OFF))[u] = 0u;
    __syncthreads();
    XcdBarrier bar; bar.bar = (unsigned*)(ctl + CW_BAR); bar.x = 0; bar.st = nullptr;
    if (!MK_PER_PHASE) bar = xcd_barrier_post((unsigned*)(ctl + CW_BAR), MISC + 8);
#define GRID_BAR() do { if (MK_PER_PHASE) { if (tid == 0) __hip_atomic_store(ctl + CW_TMO, 0xBADBA0u, RLX_AGENT); } else { xcd_barrier(bar); } } while (0)
    const int lo = args.ph_lo, hi = args.ph_hi;
#define IN(k) (lo <= (k) && (k) < hi)
#define BOTH(k) (IN(k) && IN((k) + 1))
    const int gw = vcu * NWAVES + wave, NGW = G * NWAVES;

    if (IN(0)) {
        LAS float* scr = (LAS float*)(L + RING_OFF + wave * 16384);
        constexpr int I_IN = (D / 64) * (NIN / 32), I_GLU = (SW / 64) * (SW / 32), I_A = (SW / 64) * (D / 32), I_O = (D / 64) * (D / 32), I_1 = (D / 64) * (FF / 32), I_2 = (FF / 64) * (D / 32);
        constexpr int NITEMS = I_IN + I_GLU + 2 * I_A + I_O + I_1 + I_2;
        for (int it = gw; it < NITEMS; it += NGW) {
            int r = it;
            if (r < I_IN) { p0_transpose_item(args.in[2], D, NIN, Win_t, 0, scr, r, lane); continue; } r -= I_IN;
            if (r < I_GLU) { p0_transpose_item(args.in[11], SW, SW, Wglu_t, 0, scr, r, lane); continue; } r -= I_GLU;
            if (r < I_A) { p0_transpose_item(args.in[13], SW, D, Wa_t, 0, scr, r, lane); continue; } r -= I_A;
            if (r < I_A) { p0_transpose_item(args.in[14], AW, D, Wb_t, 0, scr, r, lane); continue; } r -= I_A;
            if (r < I_O) { p0_transpose_item(args.in[15], D, D, Wo_t, 0, scr, r, lane); continue; } r -= I_O;
            if (r < I_1) { p0_transpose_item(args.in[18], D, FF, W1_t, 0, scr, r, lane); continue; } r -= I_1;
            p0_transpose_item(args.in[19], FF, D, W2_t, 0, scr, r, lane);
        }
        for (int m = gw; m < M; m += NGW) rms_row_to_bf16(x + (size_t)m * D, args.in[1], U + (size_t)m * D, lane);
        { const int gt = vcu * (NWAVES * 64) + tid;
          if (gt < NG * NP) { const int g = gt / NP;
            const double lr = (double)args.in[3][gt], li = (double)args.in[4][gt], dt = exp((double)args.in[5][g]);
            const double mag = exp(lr * dt), abr = mag * cos(li * dt), abi = mag * sin(li * dt);
            const double nr = abr - 1.0, ni = abi, den = lr * lr + li * li;
            const double cr = (nr * lr + ni * li) / den, ci = (ni * lr - nr * li) / den;
            tab[TB_ABR + gt] = (float)abr; tab[TB_ABI + gt] = (float)abi;
            for (int h = 0; h < GH; ++h) { const double br = (double)args.in[6][gt * GH + h], bi = (double)args.in[7][gt * GH + h];
                tab[TB_BBR + gt * GH + h] = (float)(cr * br - ci * bi); tab[TB_BBI + gt * GH + h] = (float)(cr * bi + ci * br); } } }
        if (BOTH(0)) GRID_BAR();
    }

    if (IN(1)) {
        pg8::Gemm g{U, Win_t, M, NIN, D}; pg8::StaticOrder S; S.init(M, NIN, G, bx);
        pg8::EpiIn E{ZS, Qb, Kb, Vb, SGA, SGB, ksum, C2};
        pg8::gemm_phase<pg8::EpiIn, pg8::StaticOrder, true, true>(L + RING_OFF, g, S, E);
        if (BOTH(1)) GRID_BAR();
    }

    if (IN(2)) {
        if (wave == 0) {
            for (int item = vcu; item < BATCH * NG; item += G) {
                const int b = item / NG, g = item % NG, p = lane;
                const float abr = tab[TB_ABR + g * NP + p], abi = tab[TB_ABI + g * NP + p];
                float bbr[GH], bbi[GH], cr[GH], ci[GH];
#pragma unroll
                for (int h = 0; h < GH; ++h) { bbr[h] = tab[TB_BBR + (g * NP + p) * GH + h]; bbi[h] = tab[TB_BBI + (g * NP + p) * GH + h];
                    cr[h] = args.in[8][(g * GH + h) * NP + p]; ci[h] = args.in[9][(g * GH + h) * NP + p]; }
                const int hme = lane >> 2;
                const float dsk = args.in[10][g * GH + hme];
                float xr = 0.f, xi = 0.f;
                const bf16* zrow = ZS + (size_t)b * SEQ * SW + g * GH;
                bf16* vrow = VS + (size_t)b * SEQ * SW + g * GH;
                for (int t = 0; t < SEQ; ++t) {
                    const v4u w0 = *(const GAS v4u*)(zrow + (size_t)t * SW), w1 = *(const GAS v4u*)(zrow + (size_t)t * SW + 8);
                    float uu[GH];
                    uu[0] = pg8::bf_lo(w0.x); uu[1] = pg8::bf_hi(w0.x); uu[2] = pg8::bf_lo(w0.y); uu[3] = pg8::bf_hi(w0.y); uu[4] = pg8::bf_lo(w0.z); uu[5] = pg8::bf_hi(w0.z); uu[6] = pg8::bf_lo(w0.w); uu[7] = pg8::bf_hi(w0.w);
                    uu[8] = pg8::bf_lo(w1.x); uu[9] = pg8::bf_hi(w1.x); uu[10] = pg8::bf_lo(w1.y); uu[11] = pg8::bf_hi(w1.y); uu[12] = pg8::bf_lo(w1.z); uu[13] = pg8::bf_hi(w1.z); uu[14] = pg8::bf_lo(w1.w); uu[15] = pg8::bf_hi(w1.w);
                    float bur = 0.f, bui = 0.f;
#pragma unroll
                    for (int h = 0; h < GH; ++h) { bur += bbr[h] * uu[h]; bui += bbi[h] * uu[h]; }
                    const float nxr = abr * xr - abi * xi + bur, nxi = abr * xi + abi * xr + bui; xr = nxr; xi = nxi;
                    float v[GH];
#pragma unroll
                    for (int h = 0; h < GH; ++h) v[h] = cr[h] * xr - ci[h] * xi;
                    float a8[8];
                    { const bool up = (lane & 32) != 0;
#pragma unroll
                      for (int j = 0; j < 8; ++j) { const float send = up ? v[j] : v[j + 8]; const float keep = up ? v[j + 8] : v[j]; a8[j] = keep + __shfl_xor(send, 32); } }
                    float a4[4];
                    { const bool up = (lane & 16) != 0;
#pragma unroll
                      for (int j = 0; j < 4; ++j) { const float send = up ? a8[j] : a8[j + 4]; const float keep = up ? a8[j + 4] : a8[j]; a4[j] = keep + __shfl_xor(send, 16); } }
                    float a2[2];
                    { const bool up = (lane & 8) != 0;
#pragma unroll
                      for (int j = 0; j < 2; ++j) { const float send = up ? a4[j] : a4[j + 2]; const float keep = up ? a4[j + 2] : a4[j]; a2[j] = keep + __shfl_xor(send, 8); } }
                    float a1;
                    { const bool up = (lane & 4) != 0; const float send = up ? a2[0] : a2[1]; const float keep = up ? a2[1] : a2[0]; a1 = keep + __shfl_xor(send, 4); }
                    a1 += __shfl_xor(a1, 2); a1 += __shfl_xor(a1, 1);
                    float um = uu[0];
#pragma unroll
                    for (int h = 1; h < GH; ++h) um = (hme == h) ? uu[h] : um;
                    const float y = a1 + dsk * um;
                    if ((lane & 3) == 0) vrow[(size_t)t * SW + hme] = (bf16)f2bf(gelu_tanh(y));
                }
            }
        }
        for (int item = gw; item < BATCH * NH * (SEQ / 64); item += NGW) {
            const int qc = item % (SEQ / 64), h = (item / (SEQ / 64)) % NH, b = item / ((SEQ / 64) * NH);
            const int qpos = qc * 64 + lane, qb = qc / 4;
            const size_t rowq = (size_t)b * SEQ + qpos;
            float q[HD];
            { const GAS v4u* qp = (const GAS v4u*)(Qb + rowq * AW + h * HD);
#pragma unroll
              for (int c = 0; c < 8; ++c) { const v4u w = qp[c]; q[8 * c] = pg8::bf_lo(w.x); q[8 * c + 1] = pg8::bf_hi(w.x); q[8 * c + 2] = pg8::bf_lo(w.y); q[8 * c + 3] = pg8::bf_hi(w.y);
                  q[8 * c + 4] = pg8::bf_lo(w.z); q[8 * c + 5] = pg8::bf_hi(w.z); q[8 * c + 6] = pg8::bf_lo(w.w); q[8 * c + 7] = pg8::bf_hi(w.w); } }
            unsigned selmask = 1u << qb;
            { float g1 = -INFINITY, g2 = -INFINITY, g3 = -INFINITY; int i1 = -1, i2 = -1, i3 = -1;
              for (int j = 0; j < qb; ++j) { const float* ks = ksum + (size_t)(b * NBLK + j) * 512 + h * HD; float gt = 0.f;
#pragma unroll
                  for (int d = 0; d < HD; ++d) gt += q[d] * ks[d];
                  if (gt > g1) { g3 = g2; i3 = i2; g2 = g1; i2 = i1; g1 = gt; i1 = j; }
                  else if (gt > g2) { g3 = g2; i3 = i2; g2 = gt; i2 = j; }
                  else if (gt > g3) { g3 = gt; i3 = j; } }
              if (i1 >= 0) selmask |= 1u << i1; if (i2 >= 0) selmask |= 1u << i2; if (i3 >= 0) selmask |= 1u << i3; }
            float o[HD];
#pragma unroll
            for (int d = 0; d < HD; ++d) o[d] = 0.f;
            float mx = -1e30f, l = 0.f;
            for (int blk = 0; blk <= qb; ++blk) {
                const bool sel = (selmask >> blk) & 1u;
                if (!__any(sel)) continue;
                const bf16* kb = Kb + ((size_t)b * SEQ + blk * BLK) * AW + h * HD; const bf16* vb = Vb + ((size_t)b * SEQ + blk * BLK) * AW + h * HD;
                for (int key = 0; key < BLK; ++key) {
                    const int kpos = blk * BLK + key;
                    const bool valid = sel && (kpos <= qpos);
                    if (!__any(valid)) continue;
                    const GAS v4u* kp = (const GAS v4u*)(kb + (size_t)key * AW); const GAS v4u* vp = (const GAS v4u*)(vb + (size_t)key * AW);
                    float s = 0.f;
#pragma unroll
                    for (int c = 0; c < 8; ++c) { const v4u w = kp[c];
                        s += q[8 * c] * pg8::bf_lo(w.x) + q[8 * c + 1] * pg8::bf_hi(w.x) + q[8 * c + 2] * pg8::bf_lo(w.y) + q[8 * c + 3] * pg8::bf_hi(w.y)
                           + q[8 * c + 4] * pg8::bf_lo(w.z) + q[8 * c + 5] * pg8::bf_hi(w.z) + q[8 * c + 6] * pg8::bf_lo(w.w) + q[8 * c + 7] * pg8::bf_hi(w.w); }
                    const float mn = valid ? fmaxf(mx, s) : mx;
                    const float alpha = __builtin_amdgcn_exp2f(mx - mn), pp = valid ? __builtin_amdgcn_exp2f(s - mn) : 0.f;
                    mx = mn; l = l * alpha + pp;
#pragma unroll
                    for (int c = 0; c < 8; ++c) { const v4u w = vp[c];
                        o[8 * c] = o[8 * c] * alpha + pp * pg8::bf_lo(w.x); o[8 * c + 1] = o[8 * c + 1] * alpha + pp * pg8::bf_hi(w.x);
                        o[8 * c + 2] = o[8 * c + 2] * alpha + pp * pg8::bf_lo(w.y); o[8 * c + 3] = o[8 * c + 3] * alpha + pp * pg8::bf_hi(w.y);
                        o[8 * c + 4] = o[8 * c + 4] * alpha + pp * pg8::bf_lo(w.z); o[8 * c + 5] = o[8 * c + 5] * alpha + pp * pg8::bf_hi(w.z);
                        o[8 * c + 6] = o[8 * c + 6] * alpha + pp * pg8::bf_lo(w.w); o[8 * c + 7] = o[8 * c + 7] * alpha + pp * pg8::bf_hi(w.w); }
                }
            }
            const float rl = 1.0f / l;
            GAS v4u* op = (GAS v4u*)(Qb + rowq * AW + h * HD);
#pragma unroll
            for (int c = 0; c < 8; ++c) { v4u w; w.x = pk2(o[8 * c] * rl, o[8 * c + 1] * rl); w.y = pk2(o[8 * c + 2] * rl, o[8 * c + 3] * rl); w.z = pk2(o[8 * c + 4] * rl, o[8 * c + 5] * rl); w.w = pk2(o[8 * c + 6] * rl, o[8 * c + 7] * rl); op[c] = w; }
        }
        if (BOTH(2)) GRID_BAR();
    }

    if (IN(3)) {
        pg8::Gemm g{VS, Wglu_t, M, SW, SW}; pg8::StaticOrder S; S.init(M, SW, G, bx);
        pg8::EpiGlu E{VS, YA, args.in[12]};
        pg8::gemm_phase<pg8::EpiGlu, pg8::StaticOrder, true, true>(L + RING_OFF, g, S, E);
        if (BOTH(3)) GRID_BAR();
    }
    if (IN(4)) {
        pg8::Gemm g{YA, Wa_t, M, D, SW}; pg8::StaticOrder S; S.init(M, D, G, bx);
        pg8::EpiGate<false> E{SGA, MG};
        pg8::gemm_phase<pg8::EpiGate<false>, pg8::StaticOrder, true, true>(L + RING_OFF, g, S, E);
        if (BOTH(4)) GRID_BAR();
    }
    if (IN(5)) {
        pg8::Gemm g{Qb, Wb_t, M, D, AW}; pg8::StaticOrder S; S.init(M, D, G, bx);
        pg8::EpiGate<true> E{SGB, MG};
        pg8::gemm_phase<pg8::EpiGate<true>, pg8::StaticOrder, true, true>(L + RING_OFF, g, S, E);
        if (BOTH(5)) GRID_BAR();
    }
    if (IN(6)) {
        pg8::Gemm g{MG, Wo_t, M, D, D}; pg8::StaticOrder S; S.init(M, D, G, bx);
        pg8::EpiBf16<0> E{MIX, D, nullptr, 0, 0, 1.f};
        pg8::gemm_phase<pg8::EpiBf16<0>, pg8::StaticOrder, true, true>(L + RING_OFF, g, S, E);
        if (BOTH(6)) GRID_BAR();
    }
    if (IN(7)) {
        const float* gpost = args.in[16]; const float* gpre = args.in[17];
        for (int m = gw; m < M; m += NGW) {
            const GAS f32x4* xr = (const GAS f32x4*)(x + (size_t)m * D) + lane; const GAS unsigned long long* mr = (const GAS unsigned long long*)(MIX + (size_t)m * D) + lane;
            f32x4 xv[4], mv[4]; float s = 0.f;
#pragma unroll
            for (int j = 0; j < 4; ++j) { xv[j] = xr[64 * j]; const unsigned long long w = mr[64 * j]; const unsigned w0 = (unsigned)w, w1 = (unsigned)(w >> 32);
                mv[j] = (f32x4){pg8::bf_lo(w0), pg8::bf_hi(w0), pg8::bf_lo(w1), pg8::bf_hi(w1)}; s += (mv[j].x * mv[j].x + mv[j].y * mv[j].y) + (mv[j].z * mv[j].z + mv[j].w * mv[j].w); }
            const float r = 1.0f / sqrtf(wave_sum(s) * (1.f / D) + RMS_EPS); float s2 = 0.f;
            GAS f32x4* orow = (GAS f32x4*)(out + (size_t)m * D) + lane;
#pragma unroll
            for (int j = 0; j < 4; ++j) { const f32x4 gg = ((const GAS f32x4*)gpost + lane)[64 * j]; xv[j] = xv[j] + (mv[j] * r) * gg; orow[64 * j] = xv[j];
                s2 += (xv[j].x * xv[j].x + xv[j].y * xv[j].y) + (xv[j].z * xv[j].z + xv[j].w * xv[j].w); }
            const float r2 = 1.0f / sqrtf(wave_sum(s2) * (1.f / D) + RMS_EPS);
            GAS unsigned long long* o8 = (GAS unsigned long long*)(U + (size_t)m * D) + lane;
#pragma unroll
            for (int j = 0; j < 4; ++j) { const f32x4 gg = ((const GAS f32x4*)gpre + lane)[64 * j];
                o8[64 * j] = (unsigned long long)pk2(xv[j].x * r2 * gg.x, xv[j].y * r2 * gg.y) | ((unsigned long long)pk2(xv[j].z * r2 * gg.z, xv[j].w * r2 * gg.w) << 32); }
        }
        if (BOTH(7)) GRID_BAR();
    }
    if (IN(8)) {
        pg8::Gemm g{U, W1_t, M, FF, D}; pg8::StaticOrder S; S.init(M, FF, G, bx);
        pg8::EpiRelu2 E{HM, FF};
        pg8::gemm_phase<pg8::EpiRelu2, pg8::StaticOrder, true, true>(L + RING_OFF, g, S, E);
        if (BOTH(8)) GRID_BAR();
    }
    if (IN(9)) {
        pg8::Gemm g{HM, W2_t, M, D, FF}; pg8::StaticOrder S; S.init(M, D, G, bx);
        pg8::EpiBf16<0> E{U, D, nullptr, 0, 0, 1.f};
        pg8::gemm_phase<pg8::EpiBf16<0>, pg8::StaticOrder, true, true>(L + RING_OFF, g, S, E);
        if (BOTH(9)) GRID_BAR();
    }
    if (IN(10)) {
        const float* gp = args.in[20];
        for (int m = gw; m < M; m += NGW) {
            GAS f32x4* orow = (GAS f32x4*)(out + (size_t)m * D) + lane; const GAS unsigned long long* fr = (const GAS unsigned long long*)(U + (size_t)m * D) + lane;
            f32x4 hv[4], fv[4]; float s = 0.f;
#pragma unroll
            for (int j = 0; j < 4; ++j) { hv[j] = orow[64 * j]; const unsigned long long w = fr[64 * j]; const unsigned w0 = (unsigned)w, w1 = (unsigned)(w >> 32);
                fv[j] = (f32x4){pg8::bf_lo(w0), pg8::bf_hi(w0), pg8::bf_lo(w1), pg8::bf_hi(w1)}; s += (fv[j].x * fv[j].x + fv[j].y * fv[j].y) + (fv[j].z * fv[j].z + fv[j].w * fv[j].w); }
            const float r = 1.0f / sqrtf(wave_sum(s) * (1.f / D) + RMS_EPS);
#pragma unroll
            for (int j = 0; j < 4; ++j) { const f32x4 gg = ((const GAS f32x4*)gp + lane)[64 * j]; orow[64 * j] = hv[j] + (fv[j] * r) * gg; }
        }
    }
#undef IN
#undef BOTH
}

extern "C" void kernel_launch(void* const* d_in, const int* in_sizes, int n_in, void* d_out, int out_size, void* d_ws, size_t ws_size, hipStream_t stream) {
    static int grid = 0;
    if (grid == 0) {
        if (n_in != 21 || in_sizes[0] != M * D || out_size != M * D || ws_size < WS_END) { fprintf(stderr, "kernel_launch: unexpected shapes / workspace (n_in %d, ws %zu)\n", n_in, ws_size); grid = -1; return; }
        int dev = 0, cus = 0, per_cu = 0;
        if (hipGetDevice(&dev) != hipSuccess || hipDeviceGetAttribute(&cus, hipDeviceAttributeMultiprocessorCount, dev) != hipSuccess) { grid = -1; return; }
        if (hipFuncSetAttribute((const void*)fwd, hipFuncAttributeMaxDynamicSharedMemorySize, LDS_BYTES) != hipSuccess) { fprintf(stderr, "kernel_launch: hipFuncSetAttribute failed\n"); grid = -1; return; }
        if (hipOccupancyMaxActiveBlocksPerMultiprocessor(&per_cu, (const void*)fwd, NWAVES * 64, LDS_BYTES) != hipSuccess || per_cu < 1) { fprintf(stderr, "kernel_launch: occupancy query says %d\n", per_cu); }
        (void)hipGetLastError();
        grid = cus;
    }
    if (grid < 0) return;
    if (hipMemsetAsync((char*)d_ws + WS_CTL, 0, CTL_ZERO_BYTES, stream) != hipSuccess) return;
    Args a{};
    for (int i = 0; i < 21; ++i) a.in[i] = (const float*)d_in[i];
    a.out = (float*)d_out; a.ws = (unsigned char*)d_ws;
#if MK_PER_PHASE
    for (int p = 0; p < NPHASES; ++p) { a.ph_lo = p; a.ph_hi = p + 1; hipLaunchKernelGGL(fwd, dim3(grid), dim3(NWAVES * 64), LDS_BYTES, stream, a); }
#else
    a.ph_lo = 0; a.ph_hi = NPHASES;
    hipLaunchKernelGGL(fwd, dim3(grid), dim3(NWAVES * 64), LDS_BYTES, stream, a);
#endif
}
```

```cpp
#include <hip/hip_runtime.h>
#include <cstdio>
#include <cstdint>
#include <cmath>
namespace pg8 {
#define PG8_LAS __attribute__((address_space(3)))
typedef unsigned short bf16_t;
typedef short bf16x8 __attribute__((ext_vector_type(8)));
typedef float f32x4 __attribute__((ext_vector_type(4)));
typedef unsigned u32x4 __attribute__((ext_vector_type(4)));
constexpr int BM = 256, BK = 64, HALF = 128, HTB = HALF * BK * 2  , STAGE_BYTES = 8 * HTB, NXCD = 8, WGM = 8;

__host__ __device__ __forceinline__ int lds_byte(int r, int c) { const int st = (r >> 4) * 2 + (c >> 5), rr = r & 15, cc = c & 31, ob = rr * 64 + cc * 2; return st * 1024 + (ob ^ (((ob >> 9) & 1) << 5)); }
__host__ __device__ __forceinline__ void stage_rc(int b, int& R, int& C) { const int st = b / 1024, sb = b % 1024, swz = sb ^ (((sb >> 9) & 1) << 5); R = (st >> 1) * 16 + swz / 64; C = (st & 1) * 32 + (swz % 64) / 2; }
__host__ __device__ __forceinline__ int perm32(int rho) { const int n = rho >> 4, i = rho & 15; return 8 * (i >> 2) + 4 * n + (i & 3); }

struct Unit { int pm, pn; };
struct Gemm { const bf16_t* A; const bf16_t* Bt; int M, N, K, lda, ldb; };

struct StaticOrder {
    int nM, nN, nwg, G, c;
    __host__ __device__ void init(int M, int N, int G_, int c_) { nM = M / BM; nN = N / BM; nwg = nM * nN; G = G_; c = c_; }
    __host__ __device__ bool next(int i, Unit& u) const {
        const long L = (long)i * G + c; if (L >= nwg) return false;
        int wgid = (int)L; { const int q = nwg / NXCD, r = nwg % NXCD, xcd = wgid % NXCD, off = wgid / NXCD; wgid = (xcd < r ? xcd * (q + 1) : r * (q + 1) + (xcd - r) * q) + off; }
        const int nig = WGM * nN, gid = wgid / nig, fm = gid * WGM, gsz = (nM - fm) < WGM ? (nM - fm) : WGM;
        u.pm = fm + ((wgid % nig) % gsz); u.pn = (wgid % nig) / gsz; return true;
    }
    __device__ __forceinline__ void a_ready(const Unit&) const {}
    __device__ __forceinline__ void done(const Unit&) const {}
};

__device__ __forceinline__ unsigned cvt_pk_bf16(float lo, float hi) { unsigned r; asm volatile("v_cvt_pk_bf16_f32 %0, %1, %2" : "=v"(r) : "v"(lo), "v"(hi)); return r; }
typedef float f32x2 __attribute__((ext_vector_type(2)));
__device__ __forceinline__ f32x2 gelu_pk(f32x2 v) {
    const f32x2 av = __builtin_elementwise_abs(v), d = av * 0.2316418882f + 1.0f;
    f32x2 t; t.x = __builtin_amdgcn_rcpf(d.x); t.y = __builtin_amdgcn_rcpf(d.y);
    f32x2 q = t * 0.5307027145f + (-0.7265760135f); q = q * t + 0.7107068705f; q = q * t + (-0.142248368f); q = q * t + 0.127414796f; q = q * t;
    const f32x2 s = (v * v) * (-0.72134752044f);
    f32x2 e; e.x = __builtin_amdgcn_exp2f(s.x); e.y = __builtin_amdgcn_exp2f(s.y);
    const f32x2 m = v * (q * e), r = v - m;
    f32x2 o; o.x = v.x < 0.f ? m.x : r.x; o.y = v.y < 0.f ? m.y : r.y; return o;
}
template <int ACT  > struct EpiBf16 {
    static constexpr bool PERM = true, AFTER_DRAIN = false; static_assert(ACT == 0 || ACT == 1, "EpiBf16: ACT is 0 (none) or 1 (gelu_pk)");
    bf16_t* O; int ldc; const float* bias; int split_cols; size_t split_stride; float scale0;
    __device__ __forceinline__ void operator()(const f32x4 (&acc)[2][2][4][2], const Unit& u, int wr, int wc, int fr, int fq) const {
        const int row0 = u.pm * BM + wr * 64 + fr; int colt = u.pn * BM; bf16_t* base = O;
        float sc = 1.f; if (split_cols) { const int t = colt / split_cols; base += (size_t)t * split_stride; colt -= t * split_cols; if (t == 0) sc = scale0; }
        const int col0 = colt + wc * 32 + 8 * fq, bcol0 = u.pn * BM + wc * 32 + 8 * fq;
        f32x4 bv[2][2];
#pragma unroll
        for (int bj = 0; bj < 2; ++bj)
#pragma unroll
            for (int n = 0; n < 2; ++n) bv[bj][n] = bias ? *(const f32x4*)(bias + bcol0 + bj * HALF + 4 * n) : (f32x4){0.f, 0.f, 0.f, 0.f};
#pragma unroll
        for (int ai = 0; ai < 2; ++ai)
#pragma unroll
            for (int m = 0; m < 4; ++m) { bf16_t* rowp = base + (size_t)(row0 + ai * HALF + m * 16) * ldc + col0;
#pragma unroll
                for (int bj = 0; bj < 2; ++bj) { f32x4 v0 = acc[ai][bj][m][0] + bv[bj][0], v1 = acc[ai][bj][m][1] + bv[bj][1];
                    if (ACT == 1) { f32x2 a = gelu_pk((f32x2){v0[0], v0[1]}), b = gelu_pk((f32x2){v0[2], v0[3]}), c = gelu_pk((f32x2){v1[0], v1[1]}), d = gelu_pk((f32x2){v1[2], v1[3]});
                        v0 = (f32x4){a.x, a.y, b.x, b.y}; v1 = (f32x4){c.x, c.y, d.x, d.y}; }
                    v0 = v0 * sc; v1 = v1 * sc; u32x4 w; w.x = cvt_pk_bf16(v0[0], v0[1]); w.y = cvt_pk_bf16(v0[2], v0[3]); w.z = cvt_pk_bf16(v1[0], v1[1]); w.w = cvt_pk_bf16(v1[2], v1[3]);
                    *(u32x4*)(rowp + bj * HALF) = w; } }
    }
};
__device__ __forceinline__ float bf_lo(unsigned w) { return __builtin_bit_cast(float, w << 16); }
__device__ __forceinline__ float bf_hi(unsigned w) { return __builtin_bit_cast(float, w & 0xffff0000u); }
__device__ __forceinline__ float sigmoid_f(float x) { return __builtin_amdgcn_rcpf(1.0f + __builtin_amdgcn_exp2f(-1.4426950408889634f * x)); }
__device__ __forceinline__ u32x4 pack8(f32x4 v0, f32x4 v1) { u32x4 w; w.x = cvt_pk_bf16(v0[0], v0[1]); w.y = cvt_pk_bf16(v0[2], v0[3]); w.z = cvt_pk_bf16(v1[0], v1[1]); w.w = cvt_pk_bf16(v1[2], v1[3]); return w; }
__device__ __forceinline__ void unpack8(u32x4 w, f32x4& v0, f32x4& v1) { v0 = (f32x4){bf_lo(w.x), bf_hi(w.x), bf_lo(w.y), bf_hi(w.y)}; v1 = (f32x4){bf_lo(w.z), bf_hi(w.z), bf_lo(w.w), bf_hi(w.w)}; }

struct EpiIn {
    static constexpr bool PERM = true, AFTER_DRAIN = false;
    unsigned char* wsb; unsigned oZX, oQ, oK, oV, oSGA, oSGB; float* ksum; float qscale;
    __device__ __forceinline__ void operator()(const f32x4 (&acc)[2][2][4][2], const Unit& u, int wr, int wc, int fr, int fq) const {
        const int pn = u.pn, row0 = u.pm * BM + wr * 64 + fr;
        unsigned boff; int ldc, colt, mode;
        if (pn < 2) { boff = oZX; ldc = 0; colt = pn * 256; mode = 4; }
        else if (pn < 4) { boff = oQ; ldc = 512; colt = (pn - 2) * 256; mode = 1; }
        else if (pn < 6) { boff = oK; ldc = 512; colt = (pn - 4) * 256; mode = 3; }
        else if (pn < 8) { boff = oV; ldc = 512; colt = (pn - 6) * 256; mode = 0; }
        else if (pn < 12) { boff = oSGA; ldc = 1024; colt = (pn - 8) * 256; mode = 2; }
        else { boff = oSGB; ldc = 1024; colt = (pn - 12) * 256; mode = 2; }
        bf16_t* base = (bf16_t*)(wsb + boff); bf16_t* ZX = base;
        const int col0 = colt + wc * 32 + 8 * fq;
        const float sc = (mode == 1) ? qscale : 1.0f;
        if (mode == 4) {
#pragma unroll
            for (int ai = 0; ai < 2; ++ai)
#pragma unroll
                for (int m = 0; m < 4; ++m) { const int row = row0 + ai * HALF + m * 16, bb = row >> 12, l = row & 4095, c = l >> 4, s_ = l & 15;
#pragma unroll
                    for (int bj = 0; bj < 2; ++bj) { const int col = col0 + bj * HALF, g_ = col >> 4, h0 = col & 15;
                        *(u32x4*)(ZX + ((size_t)((g_ * 8 + bb) * 256 + c)) * 384 + s_ * 16 + h0) = pack8(acc[ai][bj][m][0], acc[ai][bj][m][1]); } }
            return;
        }
#pragma unroll
        for (int ai = 0; ai < 2; ++ai)
#pragma unroll
            for (int m = 0; m < 4; ++m) { bf16_t* rowp = base + (size_t)(row0 + ai * HALF + m * 16) * ldc + col0;
#pragma unroll
                for (int bj = 0; bj < 2; ++bj) { f32x4 v0 = acc[ai][bj][m][0], v1 = acc[ai][bj][m][1];
                    if (mode == 2) {
#pragma unroll
                        for (int j = 0; j < 4; ++j) { v0[j] = sigmoid_f(v0[j]); v1[j] = sigmoid_f(v1[j]); } }
                    else { v0 = v0 * sc; v1 = v1 * sc; }
                    *(u32x4*)(rowp + bj * HALF) = pack8(v0, v1); } }
        if (mode == 3) {
#pragma unroll
            for (int bj = 0; bj < 2; ++bj)
#pragma unroll
                for (int n = 0; n < 2; ++n) { f32x4 s = (f32x4){0.f, 0.f, 0.f, 0.f};
#pragma unroll
                    for (int ai = 0; ai < 2; ++ai)
#pragma unroll
                        for (int m = 0; m < 4; ++m) s += acc[ai][bj][m][n];
#pragma unroll
                    for (int j = 0; j < 4; ++j) { float t = s[j]; t += __shfl_xor(t, 1); t += __shfl_xor(t, 2); t += __shfl_xor(t, 4); t += __shfl_xor(t, 8);
                        if (fr == 0) atomicAdd(ksum + (size_t)u.pm * 512 + col0 + bj * HALF + 4 * n + j, t); } }
        }
    }
};
struct EpiGlu {
    static constexpr bool PERM = true, AFTER_DRAIN = false;
    const bf16_t* VS; bf16_t* YA; const float* bias;
    __device__ __forceinline__ void operator()(const f32x4 (&acc)[2][2][4][2], const Unit& u, int wr, int wc, int fr, int fq) const {
        const int row0 = u.pm * BM + wr * 64 + fr, col0 = u.pn * BM + wc * 32 + 8 * fq;
        f32x4 bv[2][2];
#pragma unroll
        for (int bj = 0; bj < 2; ++bj)
#pragma unroll
            for (int n = 0; n < 2; ++n) bv[bj][n] = *(const f32x4*)(bias + col0 + bj * HALF + 4 * n);
#pragma unroll
        for (int ai = 0; ai < 2; ++ai)
#pragma unroll
            for (int m = 0; m < 4; ++m) { const size_t off = (size_t)(row0 + ai * HALF + m * 16) * 512 + col0;
#pragma unroll
                for (int bj = 0; bj < 2; ++bj) { f32x4 v0 = acc[ai][bj][m][0] + bv[bj][0], v1 = acc[ai][bj][m][1] + bv[bj][1];
                    f32x4 a0, a1; unpack8(*(const u32x4*)(VS + off + bj * HALF), a0, a1);
#pragma unroll
                    for (int j = 0; j < 4; ++j) { v0[j] = a0[j] * sigmoid_f(v0[j]); v1[j] = a1[j] * sigmoid_f(v1[j]); }
                    *(u32x4*)(YA + off + bj * HALF) = pack8(v0, v1); } }
    }
};
template <bool ADD> struct EpiGate {
    static constexpr bool PERM = true, AFTER_DRAIN = false;
    const bf16_t* G; bf16_t* O;
    __device__ __forceinline__ void operator()(const f32x4 (&acc)[2][2][4][2], const Unit& u, int wr, int wc, int fr, int fq) const {
        const int row0 = u.pm * BM + wr * 64 + fr, col0 = u.pn * BM + wc * 32 + 8 * fq;
#pragma unroll
        for (int ai = 0; ai < 2; ++ai)
#pragma unroll
            for (int m = 0; m < 4; ++m) { const size_t off = (size_t)(row0 + ai * HALF + m * 16) * 1024 + col0;
#pragma unroll
                for (int bj = 0; bj < 2; ++bj) { f32x4 g0, g1; unpack8(*(const u32x4*)(G + off + bj * HALF), g0, g1);
                    f32x4 v0 = acc[ai][bj][m][0] * g0, v1 = acc[ai][bj][m][1] * g1;
                    if (ADD) { f32x4 p0, p1; unpack8(*(const u32x4*)(O + off + bj * HALF), p0, p1); v0 += p0; v1 += p1; }
                    *(u32x4*)(O + off + bj * HALF) = pack8(v0, v1); } }
    }
};
struct EpiRelu2 {
    static constexpr bool PERM = true, AFTER_DRAIN = false;
    bf16_t* O; int ldc;
    __device__ __forceinline__ void operator()(const f32x4 (&acc)[2][2][4][2], const Unit& u, int wr, int wc, int fr, int fq) const {
        const int row0 = u.pm * BM + wr * 64 + fr, col0 = u.pn * BM + wc * 32 + 8 * fq;
#pragma unroll
        for (int ai = 0; ai < 2; ++ai)
#pragma unroll
            for (int m = 0; m < 4; ++m) { bf16_t* rowp = O + (size_t)(row0 + ai * HALF + m * 16) * ldc + col0;
#pragma unroll
                for (int bj = 0; bj < 2; ++bj) { f32x4 v0 = acc[ai][bj][m][0], v1 = acc[ai][bj][m][1];
#pragma unroll
                    for (int j = 0; j < 4; ++j) { const float a = fmaxf(v0[j], 0.f), b = fmaxf(v1[j], 0.f); v0[j] = a * a; v1[j] = b * b; }
                    *(u32x4*)(rowp + bj * HALF) = pack8(v0, v1); } }
    }
};

struct OneUnit {
    int pm, pn;
    __device__ __forceinline__ bool next(int i, Unit& u) const { if (i) return false; u.pm = pm; u.pn = pn; return true; }
    __device__ __forceinline__ void a_ready(const Unit&) const {}
    __device__ __forceinline__ void done(const Unit&) const {}
};
struct EpiSsmState {
    static constexpr bool PERM = false, AFTER_DRAIN = true;
    bf16_t* ZXr;
    const float *a16r, *a16i, *a512r, *a512i;
    __device__ __forceinline__ void fused(f32x4 (&acc)[2][2][4][2], const Unit& u, int wr, int wc, int fr, int fq, PG8_LAS unsigned char* lds, int wid, int lane) const {
        PG8_LAS float* S = (PG8_LAS float*)lds;
        PG8_LAS float* E = (PG8_LAS float*)(lds + 132096);
        PG8_LAS float* CI = (PG8_LAS float*)(lds + 132096 + 4096);
#pragma unroll
        for (int ai = 0; ai < 2; ++ai)
#pragma unroll
            for (int m = 0; m < 4; ++m)
#pragma unroll
                for (int n = 0; n < 2; ++n) { const int row = ai * HALF + wr * 64 + m * 16 + fr, col = wc * 32 + n * 16 + 4 * fq;
                    *(PG8_LAS f32x4*)(S + row * 128 + ((col + 4 * row) & 127)) = acc[ai][0][m][n]; }
        asm volatile("s_waitcnt lgkmcnt(0)" ::: "memory"); __builtin_amdgcn_s_barrier(); asm volatile("" ::: "memory");
        const int p = lane, seg = wid;
        const float ar = a16r[p], ai_ = a16i[p];
        { float hr = 0.f, hi = 0.f;
          for (int c = seg * 32; c < seg * 32 + 32; ++c) { const int ir = c * 128 + ((p + 4 * c) & 127), ii = c * 128 + ((64 + p + 4 * c) & 127);
              const float sr = S[ir], si = S[ii]; S[ir] = hr; S[ii] = hi;
              const float nr = ar * hr - ai_ * hi + sr, ni = ar * hi + ai_ * hr + si; hr = nr; hi = ni; }
          E[seg * 128 + p] = hr; E[seg * 128 + 64 + p] = hi; }
        asm volatile("s_waitcnt lgkmcnt(0)" ::: "memory"); __builtin_amdgcn_s_barrier(); asm volatile("" ::: "memory");
        if (wid == 0) { const float br = a512r[p], bi = a512i[p]; float cr = 0.f, ci = 0.f;
#pragma unroll
            for (int sg = 0; sg < 8; ++sg) { CI[sg * 128 + p] = cr; CI[sg * 128 + 64 + p] = ci; const float er = E[sg * 128 + p], ei = E[sg * 128 + 64 + p];
                const float nr = br * cr - bi * ci + er, ni = br * ci + bi * cr + ei; cr = nr; ci = ni; } }
        asm volatile("s_waitcnt lgkmcnt(0)" ::: "memory"); __builtin_amdgcn_s_barrier(); asm volatile("" ::: "memory");
        { float wr_ = CI[seg * 128 + p], wi_ = CI[seg * 128 + 64 + p];
          for (int c = seg * 32; c < seg * 32 + 32; ++c) { const int ir = c * 128 + ((p + 4 * c) & 127), ii = c * 128 + ((64 + p + 4 * c) & 127);
              const float hr = S[ir] + wr_, hi = S[ii] + wi_;
              bf16_t* o = ZXr + (size_t)c * 384 + 256 + p;
              o[0] = (bf16_t)(cvt_pk_bf16(hr, hr) & 0xffffu); o[64] = (bf16_t)(cvt_pk_bf16(hi, hi) & 0xffffu);
              const float nr = ar * wr_ - ai_ * wi_, ni = ar * wi_ + ai_ * wr_; wr_ = nr; wi_ = ni; } }
    }
};
__device__ __forceinline__ float gelu_tanh_f(float x) {
    const float u = 0.7978845608028654f * (x + 0.044715f * x * x * x);
    const float e = __builtin_amdgcn_exp2f(-2.885390081777927f * fabsf(u));
    const float t = (1.0f - e) * __builtin_amdgcn_rcpf(1.0f + e);
    return 0.5f * x * (1.0f + (u < 0.f ? -t : t));
}
struct EpiSsmOut {
    static constexpr bool PERM = true, AFTER_DRAIN = false;
    const bf16_t* ZXr; bf16_t* VSb; const float* dsk;
    __device__ __forceinline__ void operator()(const f32x4 (&acc)[2][2][4][2], const Unit& u, int wr, int wc, int fr, int fq) const {
        const int r0 = wr * 64 + fr, c0 = wc * 32 + 8 * fq;
#pragma unroll
        for (int bj = 0; bj < 2; ++bj) { const int col = c0 + bj * HALF, t = col >> 4, h0 = col & 15;
            const f32x4 d0 = *(const f32x4*)(dsk + h0), d1 = *(const f32x4*)(dsk + h0 + 4);
#pragma unroll
            for (int ai = 0; ai < 2; ++ai)
#pragma unroll
                for (int m = 0; m < 4; ++m) { const int r = r0 + ai * HALF + m * 16;
                    f32x4 u0, u1; unpack8(*(const u32x4*)(ZXr + (size_t)r * 384 + col), u0, u1);
                    f32x4 v0 = acc[ai][bj][m][0] + d0 * u0, v1 = acc[ai][bj][m][1] + d1 * u1;
#pragma unroll
                    for (int j = 0; j < 4; ++j) { v0[j] = gelu_tanh_f(v0[j]); v1[j] = gelu_tanh_f(v1[j]); }
                    *(u32x4*)(VSb + (size_t)(r * 16 + t) * 512 + h0) = pack8(v0, v1); } }
    }
};
template <class Epi, class Sched, bool ALIGN_EPI = false, bool SP2 = false>
__device__ __forceinline__ void gemm_phase(PG8_LAS unsigned char* lds, const Gemm g, const Sched& S, const Epi& E) {
    const int tid = threadIdx.x, wid = __builtin_amdgcn_readfirstlane(tid >> 6), lane = tid & 63, wr = wid >> 2, wc = wid & 3, fr = lane & 15, fq = lane >> 4;
    const int K = g.K, nt = K / BK;
    unsigned voffA[2], voffB[2];
#pragma unroll
    for (int i = 0; i < 2; ++i) { int R, C; stage_rc(tid * 16 + i * 8192, R, C); const int Rb = Epi::PERM ? ((R & ~31) + perm32(R & 31)) : R;
        voffA[i] = (unsigned)(R * g.lda + C) * 2u; voffB[i] = (unsigned)(Rb * g.ldb + C) * 2u; }
    const size_t kstep = (size_t)(BK * 2);
    const size_t hsA = (size_t)HALF * g.lda * 2, hsB = (size_t)HALF * g.ldb * 2;
    const size_t tsA = 2 * hsA, tsB = 2 * hsB;
    const unsigned ldsw = (unsigned)wid * 1024u;
    const int aoff = lds_byte(wr * 64 + fr, fq * 8), boff = lds_byte(wc * 32 + fr, fq * 8);
#define PG8_SA(b, h) (((b) * 2 + (h)) * HTB)
#define PG8_SB(b, h) ((4 + (b) * 2 + (h)) * HTB)
#define PG8_STAGE(bufoff, gbase, voff) do { _Pragma("unroll") for (int _i = 0; _i < 2; ++_i) \
        __builtin_amdgcn_global_load_lds((const unsigned*)((const char*)(gbase) + (voff)[_i]), (PG8_LAS unsigned*)(lds + (bufoff) + ldsw + _i * 8192), 16, 0, 0); } while (0)
#define PG8_LDA(dst, b, h) do { _Pragma("unroll") for (int m = 0; m < 4; ++m) _Pragma("unroll") for (int k = 0; k < 2; ++k) dst[m][k] = *(const PG8_LAS bf16x8*)(lds + PG8_SA(b, h) + aoff + m * 2048 + k * 1024); } while (0)
#define PG8_LDB(dst, b, h) do { _Pragma("unroll") for (int n = 0; n < 2; ++n) _Pragma("unroll") for (int k = 0; k < 2; ++k) dst[n][k] = *(const PG8_LAS bf16x8*)(lds + PG8_SB(b, h) + boff + n * 2048 + k * 1024); } while (0)
#define PG8_MMA(ai, bj, At, Bt) do { __builtin_amdgcn_s_setprio(1); _Pragma("unroll") for (int m = 0; m < 4; ++m) _Pragma("unroll") for (int n = 0; n < 2; ++n) _Pragma("unroll") for (int k = 0; k < 2; ++k) \
        acc[ai][bj][m][n] = __builtin_amdgcn_mfma_f32_16x16x32_bf16(Bt[n][k], At[m][k], acc[ai][bj][m][n], 0, 0, 0); __builtin_amdgcn_s_setprio(0); } while (0)
#define PG8_WAIT_V(n) asm volatile("s_waitcnt vmcnt(" #n ")" ::: "memory")
#define PG8_WAIT_L(n) asm volatile("s_waitcnt lgkmcnt(" #n ")" ::: "memory")
#define PG8_BAR __builtin_amdgcn_s_barrier()
#define PG8_SCHED __builtin_amdgcn_sched_barrier(0)
    Unit cur, nxt; int ui = 0;
    if (!S.next(0, cur)) return;
    f32x4 acc[2][2][4][2];
#pragma unroll
    for (int a = 0; a < 2; ++a)
#pragma unroll
        for (int b = 0; b < 2; ++b)
#pragma unroll
            for (int m = 0; m < 4; ++m)
#pragma unroll
                for (int n = 0; n < 2; ++n) acc[a][b][m][n] = (f32x4){0.f, 0.f, 0.f, 0.f};
    bf16x8 At[4][2], B0[2][2], B1[2][2];
    const char* cA = (const char*)g.A + (size_t)cur.pm * tsA; const char* cB = (const char*)g.Bt + (size_t)cur.pn * tsB;
    S.a_ready(cur);
    if constexpr (SP2) {
        PG8_STAGE(PG8_SB(0, 0), cB, voffB); PG8_STAGE(PG8_SB(0, 1), cB + hsB, voffB); PG8_STAGE(PG8_SA(0, 0), cA, voffA); PG8_STAGE(PG8_SA(0, 1), cA + hsA, voffA);
        if (wr == 1) PG8_BAR;
        PG8_WAIT_V(2); PG8_BAR;
        PG8_STAGE(PG8_SB(1, 0), cB + kstep, voffB); PG8_STAGE(PG8_SA(1, 0), cA + kstep, voffA); PG8_STAGE(PG8_SB(1, 1), cB + hsB + kstep, voffB);
        PG8_WAIT_V(6); PG8_BAR;
    } else {
        PG8_STAGE(PG8_SB(0, 0), cB, voffB); PG8_STAGE(PG8_SA(0, 0), cA, voffA); PG8_STAGE(PG8_SB(0, 1), cB + hsB, voffB); PG8_STAGE(PG8_SA(0, 1), cA + hsA, voffA);
        if (wr == 1) PG8_BAR;
        PG8_WAIT_V(4); PG8_BAR;
        PG8_STAGE(PG8_SB(1, 0), cB + kstep, voffB); PG8_STAGE(PG8_SA(1, 0), cA + kstep, voffA); PG8_STAGE(PG8_SB(1, 1), cB + hsB + kstep, voffB);
        PG8_WAIT_V(6); PG8_BAR;
    }
    for (;;) {
        const bool has_next = S.next(ui + 1, nxt);
        const char* nA = has_next ? (const char*)g.A + (size_t)nxt.pm * tsA : cA; const char* nB = has_next ? (const char*)g.Bt + (size_t)nxt.pn * tsB : cB;
        for (int t = 0; t < nt; t += 2) {
            const bool last = (t == nt - 2);
            const char* a1 = cA + (size_t)(t + 1) * kstep;
            const char* a2 = last ? nA : cA + (size_t)(t + 2) * kstep; const char* b2 = last ? nB : cB + (size_t)(t + 2) * kstep;
            const char* a3 = a2 + kstep; const char* b3 = b2 + kstep;
            if (last && has_next) S.a_ready(nxt);
            if constexpr (SP2) {
            PG8_LDB(B0, 0, 0); PG8_LDB(B1, 0, 1); PG8_SCHED; PG8_LDA(At, 0, 0); PG8_STAGE(PG8_SA(1, 1), a1 + hsA, voffA);
            PG8_WAIT_V(8); PG8_WAIT_L(0); PG8_BAR; PG8_MMA(0, 0, At, B0); PG8_MMA(0, 1, At, B1); PG8_BAR; PG8_SCHED;
            PG8_LDA(At, 0, 1); PG8_STAGE(PG8_SB(0, 0), b2, voffB); PG8_STAGE(PG8_SB(0, 1), b2 + hsB, voffB); PG8_STAGE(PG8_SA(0, 0), a2, voffA);
            PG8_WAIT_V(8); PG8_WAIT_L(0); PG8_BAR; PG8_MMA(1, 0, At, B0); PG8_MMA(1, 1, At, B1); PG8_BAR; PG8_SCHED;
            PG8_LDB(B0, 1, 0); PG8_LDB(B1, 1, 1); PG8_SCHED; PG8_LDA(At, 1, 0); PG8_STAGE(PG8_SA(0, 1), a2 + hsA, voffA);
            PG8_WAIT_V(8); PG8_WAIT_L(0); PG8_BAR; PG8_MMA(0, 0, At, B0); PG8_MMA(0, 1, At, B1); PG8_BAR; PG8_SCHED;
            PG8_LDA(At, 1, 1); PG8_STAGE(PG8_SB(1, 0), b3, voffB); PG8_STAGE(PG8_SB(1, 1), b3 + hsB, voffB); PG8_STAGE(PG8_SA(1, 0), a3, voffA);
            PG8_WAIT_V(8); PG8_WAIT_L(0); PG8_BAR; PG8_MMA(1, 0, At, B0); PG8_MMA(1, 1, At, B1); PG8_BAR; PG8_SCHED;
            } else {
            PG8_LDB(B0, 0, 0); PG8_SCHED; PG8_LDA(At, 0, 0); PG8_STAGE(PG8_SA(1, 1), a1 + hsA, voffA);
            PG8_WAIT_L(8); PG8_BAR; PG8_WAIT_L(0); PG8_MMA(0, 0, At, B0); PG8_BAR; PG8_SCHED;
            PG8_LDB(B1, 0, 1); PG8_STAGE(PG8_SB(0, 0), b2, voffB);
            PG8_BAR; PG8_WAIT_L(0); PG8_MMA(0, 1, At, B1); PG8_BAR;
            PG8_LDA(At, 0, 1); PG8_STAGE(PG8_SA(0, 0), a2, voffA);
            PG8_BAR; PG8_WAIT_L(0); PG8_MMA(1, 0, At, B0); PG8_BAR; PG8_SCHED;
            PG8_STAGE(PG8_SB(0, 1), b2 + hsB, voffB);
            PG8_WAIT_V(6); PG8_BAR; PG8_MMA(1, 1, At, B1); PG8_BAR;
            PG8_LDB(B0, 1, 0); PG8_SCHED; PG8_LDA(At, 1, 0); PG8_STAGE(PG8_SA(0, 1), a2 + hsA, voffA);
            PG8_WAIT_L(8); PG8_BAR; PG8_WAIT_L(0); PG8_MMA(0, 0, At, B0); PG8_BAR; PG8_SCHED;
            PG8_LDB(B1, 1, 1); PG8_STAGE(PG8_SB(1, 0), b3, voffB);
            PG8_BAR; PG8_WAIT_L(0); PG8_MMA(0, 1, At, B1); PG8_BAR;
            PG8_LDA(At, 1, 1); PG8_STAGE(PG8_SA(1, 0), a3, voffA);
            PG8_BAR; PG8_WAIT_L(0); PG8_MMA(1, 0, At, B0); PG8_BAR; PG8_SCHED;
            PG8_STAGE(PG8_SB(1, 1), b3 + hsB, voffB);
            PG8_WAIT_V(6); PG8_BAR; PG8_MMA(1, 1, At, B1); PG8_BAR;
            }
        }
        if constexpr (ALIGN_EPI) { if (wr == 0) PG8_BAR; }
        if constexpr (!Epi::AFTER_DRAIN) { E(acc, cur, wr, wc, fr, fq); S.done(cur); }
        if (!has_next) break;
#pragma unroll
        for (int a = 0; a < 2; ++a)
#pragma unroll
            for (int b = 0; b < 2; ++b)
#pragma unroll
                for (int m = 0; m < 4; ++m)
#pragma unroll
                    for (int n = 0; n < 2; ++n) acc[a][b][m][n] = (f32x4){0.f, 0.f, 0.f, 0.f};
        cur = nxt; cA = nA; cB = nB; ++ui;
        if constexpr (ALIGN_EPI) { if (wr == 1) PG8_BAR; }
    }
    PG8_WAIT_V(0);
    if constexpr (!ALIGN_EPI) { if (wr == 0) PG8_BAR; }
    PG8_BAR;
    if constexpr (Epi::AFTER_DRAIN) { E.fused(acc, cur, wr, wc, fr, fq, lds, wid, lane); S.done(cur); }
#undef PG8_SA
#undef PG8_SB
#undef PG8_STAGE
#undef PG8_LDA
#undef PG8_LDB
#undef PG8_MMA
#undef PG8_WAIT_V
#undef PG8_WAIT_L
#undef PG8_BAR
#undef PG8_SCHED
}
}
#include <hip/hip_bf16.h>
#include <cmath>
namespace attn_body {
using bf16=__hip_bfloat16;
using bf16x8=__attribute__((ext_vector_type(8)))short;
using s16x4=__attribute__((ext_vector_type(4)))short;
using f32x16=__attribute__((ext_vector_type(16)))float;
using u32x4=__attribute__((ext_vector_type(4)))unsigned;
constexpr int BATCH=8,NHEAD=8,SEQ=4096,D=64,DM=NHEAD*D;
constexpr int NW=8,QBLK=32,QB=QBLK*NW,KVBLK=64,NQB=SEQ/QB;
constexpr int ATTN_PITCH=DM, ATTN_UNIT_ROWS=QB;
__device__ __forceinline__ int crow(int r,int hi){return (r&3)+8*(r>>2)+4*hi;}
#define SBAR() __builtin_amdgcn_sched_barrier(0)
__device__ __forceinline__ void cmask(f32x16&p0,f32x16&p1,int jb,int qrel,int hi){
  const float NEG=-INFINITY; int kb=64*jb+4*hi;
  #pragma unroll
  for(int r=0;r<16;++r){int kv=kb+(r&3)+8*(r>>2); if(kv>qrel)p0[r]=NEG; if(kv+32>qrel)p1[r]=NEG;}
}

constexpr int NSLOT=3, SLOTB=8192;
constexpr int LDS_K=0, LDS_V=NSLOT*SLOTB, LDS_WS=2*NSLOT*SLOTB, LDS_OST=LDS_WS+NW*64*4, LDS_BYTES=LDS_OST+NW*4096;
constexpr float C2=0.125f*1.4426950408889634f;
__device__ __forceinline__ void glds16s(const void*sbase,unsigned voff,unsigned lds_dst){unsigned keep;
  asm volatile("s_mov_b32 %0, m0\n\ts_mov_b32 m0, %2\n\ts_nop 0\n\tglobal_load_lds_dwordx4 %1, %3\n\ts_mov_b32 m0, %0":"=&s"(keep):"v"(voff),"s"(lds_dst),"s"(sbase):"memory");}
__device__ __forceinline__ void glds16(const void*gsrc,unsigned lds_dst){unsigned keep;
  asm volatile("s_mov_b32 %0, m0\n\ts_mov_b32 m0, %2\n\ts_nop 0\n\tglobal_load_lds_dwordx4 %1, off\n\ts_mov_b32 m0, %0":"=&s"(keep):"v"(gsrc),"s"(lds_dst):"memory");}
__device__ __forceinline__ float max3f(float a,float b,float c){float r;asm("v_max3_f32 %0, %1, %2, %3":"=v"(r):"v"(a),"v"(b),"v"(c));return r;}
__device__ __forceinline__ float max2f(float a,float b){float r;asm("v_max_f32_e32 %0, %1, %2":"=v"(r):"v"(a),"v"(b));return r;}
__device__ __forceinline__ float fadd_s(float a,float b){float r;asm("v_add_f32_e32 %0, %1, %2":"=v"(r):"v"(a),"v"(b));return r;}
__device__ __forceinline__ float fsub_s(float a,float b){float r;asm("v_sub_f32_e32 %0, %1, %2":"=v"(r):"v"(a),"v"(b));return r;}
typedef float f32x2_t __attribute__((ext_vector_type(2))); typedef __bf16 bf16x2_t __attribute__((ext_vector_type(2)));
__device__ __forceinline__ unsigned cvtpk_s(float lo,float hi){f32x2_t v={lo,hi};bf16x2_t b=__builtin_convertvector(v,bf16x2_t);return __builtin_bit_cast(unsigned,b);}
#define WAIT_BAR(N) asm volatile("s_waitcnt vmcnt(" #N ") lgkmcnt(0)\n\ts_barrier":::"memory")

__device__ __forceinline__ void qkt(f32x16&p0,f32x16&p1,const char*Kslot,const bf16x8*qr,const f32x16&negm,int r32,int hi){
  const char*kb=Kslot+hi*1024+r32*16;
  #pragma unroll
  for(int d0=0;d0<4;++d0){
    const bf16x8 b0=*reinterpret_cast<const bf16x8*>(kb+d0*2048);
    const bf16x8 b1=*reinterpret_cast<const bf16x8*>(kb+d0*2048+512);
    if(d0==0){p0=__builtin_amdgcn_mfma_f32_32x32x16_bf16(b0,qr[0],negm,0,0,0);p1=__builtin_amdgcn_mfma_f32_32x32x16_bf16(b1,qr[0],negm,0,0,0);}
    else{p0=__builtin_amdgcn_mfma_f32_32x32x16_bf16(b0,qr[d0],p0,0,0,0);p1=__builtin_amdgcn_mfma_f32_32x32x16_bf16(b1,qr[d0],p1,0,0,0);}}
}
typedef __attribute__((address_space(3))) const char* lds_cptr;
typedef short v4i16_t __attribute__((ext_vector_type(4)));
__device__ __forceinline__ void kload8(bf16x8*kf,lds_cptr kp){
  kf[0]=*(const __attribute__((address_space(3))) bf16x8*)(kp);      kf[1]=*(const __attribute__((address_space(3))) bf16x8*)(kp+512);
  kf[2]=*(const __attribute__((address_space(3))) bf16x8*)(kp+2048); kf[3]=*(const __attribute__((address_space(3))) bf16x8*)(kp+2560);
  kf[4]=*(const __attribute__((address_space(3))) bf16x8*)(kp+4096); kf[5]=*(const __attribute__((address_space(3))) bf16x8*)(kp+4608);
  kf[6]=*(const __attribute__((address_space(3))) bf16x8*)(kp+6144); kf[7]=*(const __attribute__((address_space(3))) bf16x8*)(kp+6656);
}
__device__ __forceinline__ void kload2(bf16x8*kf,lds_cptr kp,int j){ kf[2*j]=*(const __attribute__((address_space(3))) bf16x8*)(kp+j*2048); kf[2*j+1]=*(const __attribute__((address_space(3))) bf16x8*)(kp+j*2048+512); }
__device__ __forceinline__ s16x4 vtr(lds_cptr p){ return __builtin_bit_cast(s16x4,__builtin_amdgcn_ds_read_tr16_b64_v4i16((__attribute__((address_space(3))) v4i16_t*)p)); }
__device__ __forceinline__ float rowmax(const f32x16&p0,const f32x16&p1){
  float a=max3f(p0[0],p0[1],p1[0]),b=max3f(p0[2],p0[3],p1[1]);a=max3f(a,p1[2],p1[3]);
  #pragma unroll
  for(int r=4;r<16;r+=4){a=max3f(a,p0[r],p0[r+1]);b=max3f(b,p0[r+2],p0[r+3]);a=max3f(a,p1[r],p1[r+1]);b=max3f(b,p1[r+2],p1[r+3]);}
  const float m=max2f(a,b);
  auto rr=__builtin_amdgcn_permlane32_swap(__float_as_uint(m),__float_as_uint(m),false,false);
  return max2f(__uint_as_float(rr[0]),__uint_as_float(rr[1]));
}
__device__ __forceinline__ void pv(f32x16*o,int vb,bf16x8 pa0,bf16x8 pa1,bf16x8 pa2,bf16x8 pa3){
  #pragma unroll
  for(int d0=0;d0<2;++d0){s16x4 lo[4],hi[4];
    #pragma unroll
    for(int ks=0;ks<4;++ks){
      asm volatile("ds_read_b64_tr_b16 %0,%1 offset:%c2":"=&v"(lo[ks]):"v"(vb),"i"(d0*4096+ks*1024):"memory");
      asm volatile("ds_read_b64_tr_b16 %0,%1 offset:%c2":"=&v"(hi[ks]):"v"(vb),"i"(d0*4096+ks*1024+512):"memory");}
    asm volatile("s_waitcnt lgkmcnt(0)":::"memory");SBAR();
    #define PK(k) (bf16x8){lo[k][0],lo[k][1],lo[k][2],lo[k][3],hi[k][0],hi[k][1],hi[k][2],hi[k][3]}
    o[d0]=__builtin_amdgcn_mfma_f32_32x32x16_bf16(pa0,PK(0),o[d0],0,0,0);
    o[d0]=__builtin_amdgcn_mfma_f32_32x32x16_bf16(pa1,PK(1),o[d0],0,0,0);
    o[d0]=__builtin_amdgcn_mfma_f32_32x32x16_bf16(pa2,PK(2),o[d0],0,0,0);
    o[d0]=__builtin_amdgcn_mfma_f32_32x32x16_bf16(pa3,PK(3),o[d0],0,0,0);
    #undef PK
  }
}

#ifndef ATTN_STORE16
#define ATTN_STORE16(p,v) (*(u32x4*)(p)=(v))
#endif
template<int THRL> __device__ __forceinline__ void attn_unit(int b,int h,int qb,const bf16*Q,const bf16*__restrict__ K,const bf16*__restrict__ V,bf16*O,const float*__restrict__ ksum,char*shm){
  int tid; asm volatile("v_mov_b32 %0, %1":"=v"(tid):"v"(threadIdx.x));
  const int lane=tid&63,r32=lane&31,hi=lane>>5; const int wid=__builtin_amdgcn_readfirstlane(tid>>6);
  const long rowbase=(long)b*SEQ; const int q0=qb*QB;
  const bf16*Qw=Q+(rowbase+q0+wid*QBLK)*DM+h*D;
  const bf16*Kh=K+rowbase*DM+h*D,*Vh=V+rowbase*DM+h*D;
  const unsigned lds0=(unsigned)(uintptr_t)shm;
  float*wsf=(float*)(shm+LDS_WS)+wid*64;
  const unsigned koff=(unsigned)((lane*DM+wid*8)*2);
  const unsigned voffv=(unsigned)(((16*(wid&3)+(lane>>2))*DM+(wid>>2)*32+(lane&3)*8)*2);
  const unsigned kdst=lds0+LDS_K+wid*1024, vdst=lds0+LDS_V+wid*1024;
  #define DMA_K(t,slot) glds16s(Kh+(long)(t)*KVBLK*DM,koff,(unsigned)__builtin_amdgcn_readfirstlane(kdst+(slot)))
  #define DMA_V(t,slot) glds16s(Vh+(long)(t)*KVBLK*DM,voffv,(unsigned)__builtin_amdgcn_readfirstlane(vdst+(slot)))
  const int vb0=(int)(lds0+LDS_V)+((lane>>4)&1)*32+(lane&3)*8+(4*hi+((lane&15)>>2))*64;
  const char*Kbase=shm+LDS_K; bf16x8 kf[8];
  const lds_cptr shm3=(lds_cptr)shm; const lds_cptr kp0=shm3+LDS_K+hi*1024+r32*16; const lds_cptr vp0=shm3+LDS_V+((lane>>4)&1)*32+(lane&3)*8+(4*hi+((lane&15)>>2))*64;
  const int NT=(q0+QB)/KVBLK;
  DMA_K(0,0);DMA_V(0,0);DMA_K(1,SLOTB);
  bf16x8 qr[4];
  #pragma unroll
  for(int d0=0;d0<4;++d0)qr[d0]=*reinterpret_cast<const bf16x8*>(&Qw[(long)r32*DM+d0*16+hi*8]);
  unsigned selmask=1u<<qb;
  { float qf[32];
    #pragma unroll
    for(int d0=0;d0<4;++d0){
      #pragma unroll
      for(int i=0;i<8;++i)qf[d0*8+i]=__builtin_bit_cast(float,((unsigned)(unsigned short)qr[d0][i])<<16);}
    float g1=-INFINITY,g2=-INFINITY,g3=-INFINITY;int i1=-1,i2=-1,i3=-1;
    for(int j=0;j<qb;++j){
      const float*ks=ksum+((long)(b*(SEQ/QB)+j))*DM+h*D+hi*8; float gt=0.f;
      #pragma unroll
      for(int d0=0;d0<4;++d0){ const float4 k0=*reinterpret_cast<const float4*>(ks+d0*16),k1=*reinterpret_cast<const float4*>(ks+d0*16+4);
        gt+=qf[d0*8+0]*k0.x+qf[d0*8+1]*k0.y+qf[d0*8+2]*k0.z+qf[d0*8+3]*k0.w+qf[d0*8+4]*k1.x+qf[d0*8+5]*k1.y+qf[d0*8+6]*k1.z+qf[d0*8+7]*k1.w;}
      gt+=__shfl_xor(gt,32);
      if(gt>g1){g3=g2;i3=i2;g2=g1;i2=i1;g1=gt;i1=j;} else if(gt>g2){g3=g2;i3=i2;g2=gt;i2=j;} else if(gt>g3){g3=gt;i3=j;}
    }
    if(i1>=0)selmask|=1u<<i1; if(i2>=0)selmask|=1u<<i2; if(i3>=0)selmask|=1u<<i3; }
  float mhat=0.f,l_reg=0.f;f32x16 o[2];o[0]=f32x16{};o[1]=f32x16{};f32x16 negm=f32x16{};asm volatile("":"+v"(negm));
  const int qrel=wid*QBLK+r32;
  #define CMASK(P0,P1,t) do{int jb_=(t)-(NT-4); if(jb_>=0)cmask(P0,P1,jb_,qrel,hi);}while(0)
  bool resc=false;
  #define START(P0,P1) do{ float rm=rowmax(P0,P1); rm=(selmask&1u)?rm:-INFINITY; resc=false; \
    { const float dl=__builtin_fmaxf(rm,-64.f); mhat=fadd_s(mhat,dl); \
      _Pragma("unroll") for(int r=0;r<16;++r){P0[r]=fsub_s(P0[r],dl);P1[r]=fsub_s(P1[r],dl);} \
      _Pragma("unroll") for(int r=0;r<16;++r)negm[r]=-mhat; asm volatile("":"+v"(negm)); } \
    _Pragma("unroll") for(int r=0;r<16;++r)P0[r]=__builtin_amdgcn_exp2f(P0[r]); }while(0)
  #define RESC() do{ if(resc){ asm volatile("s_waitcnt lgkmcnt(0)":::"memory"); \
      _Pragma("unroll") for(int d_=0;d_<2;++d_) _Pragma("unroll") for(int r=0;r<16;++r)o[d_][r]*=wsf[crow(r,hi)]; } }while(0)
  f32x16 pA0,pA1,pB0,pB1;
  int sl_prev=0,sl_cur=0,sl_next=SLOTB;
  #define ROT() do{sl_prev=sl_cur;sl_cur=sl_next;sl_next=(sl_next==(NSLOT-1)*SLOTB)?0:sl_next+SLOTB;}while(0)
  DMA_K(2,2*SLOTB);
  WAIT_BAR(3);
  qkt(pA0,pA1,Kbase,qr,negm,r32,hi);asm volatile("s_nop 15\n\ts_nop 7":"+v"(pA0),"+v"(pA1));CMASK(pA0,pA1,0);
  START(pA0,pA1);
  _Pragma("unroll") for(int r=0;r<16;++r)pA1[r]=__builtin_amdgcn_exp2f(pA1[r]);
  WAIT_BAR(0);
  DMA_K(3,0);DMA_V(1,SLOTB);
  ROT();
  kload8(kf,kp0+sl_cur);
  WAIT_BAR(2);
  s16x4 vlo[8],vhi[8]; u32x4 pw0,pw1,pw2,pw3;
  #define PKW(P,B) cvtpk_s(P[B],P[B+1])
  #define PKWM(P,B) (cvtpk_s(P[B],P[B+1])&selw_)
  #define PAF(k) __builtin_bit_cast(bf16x8,pw##k)
  #define VFR(i) (bf16x8){vlo[i][0],vlo[i][1],vlo[i][2],vlo[i][3],vhi[i][0],vhi[i][1],vhi[i][2],vhi[i][3]}
  #define PIN(x) asm volatile("":"+v"(x))
  #define MX3(a,b,c) __builtin_fmaxf(__builtin_fmaxf((a),(b)),(c))
  #define GAPA(MF,A0,A1,A2,A3,W0,W1,PW) do{ MF; sacc+=A0; sacc+=A1; sacc+=A2; sacc+=A3; PIN(sacc); W0; W1; PIN(PW); SBAR(); }while(0)
  #define EX(v) __builtin_amdgcn_exp2f(v)
  #define GAPB(MF,X,B) do{ MF; X[B]=EX(X[B]); X[B+1]=EX(X[B+1]); X[B+2]=EX(X[B+2]); X[B+3]=EX(X[B+3]); PIN(X); SBAR(); }while(0)
  #define VRD(i) do{ vlo[i]=vtr(vp_+(((i)>>2)*4096+((i)&3)*1024)); vhi[i]=vtr(vp_+(((i)>>2)*4096+((i)&3)*1024+512)); }while(0)
  #define KRD(G,j) do{ if(G){ kload2(kf,kp0+sl_next,j); SBAR(); } }while(0)
  #define STEP(C0,C1,P0,P1,t,GK,GV,GL) do{ SBAR(); const unsigned selw_=0u-((selmask>>(((t)-1)>>2))&1u); \
    const lds_cptr vp_=vp0+sl_prev; \
    VRD(0); SBAR(); float sacc=(P0[0]+P0[1]); \
    GAPA(C0=__builtin_amdgcn_mfma_f32_32x32x16_bf16(kf[0],qr[0],negm,0,0,0), P0[2],P0[3],P0[4],P0[5],     pw0[0]=PKWM(P0,0), pw0[1]=PKWM(P0,2), pw0); \
    VRD(4); SBAR(); GAPA(C1=__builtin_amdgcn_mfma_f32_32x32x16_bf16(kf[1],qr[0],negm,0,0,0), P0[6],P0[7],P0[8],P0[9],     pw0[2]=PKWM(P0,4), pw0[3]=PKWM(P0,6), pw0); \
    VRD(1); SBAR(); GAPA(C0=__builtin_amdgcn_mfma_f32_32x32x16_bf16(kf[2],qr[1],C0,0,0,0),   P0[10],P0[11],P0[12],P0[13], pw1[0]=PKWM(P0,8), pw1[1]=PKWM(P0,10), pw1); \
    VRD(5); SBAR(); GAPA(C1=__builtin_amdgcn_mfma_f32_32x32x16_bf16(kf[3],qr[1],C1,0,0,0),   P0[14],P0[15],P1[0],P1[1],   pw1[2]=PKWM(P0,12),pw1[3]=PKWM(P0,14), pw1); \
    VRD(2); SBAR(); GAPA(C0=__builtin_amdgcn_mfma_f32_32x32x16_bf16(kf[4],qr[2],C0,0,0,0),   P1[2],P1[3],P1[4],P1[5],     pw2[0]=PKWM(P1,0), pw2[1]=PKWM(P1,2), pw2); \
    VRD(6); SBAR(); GAPA(C1=__builtin_amdgcn_mfma_f32_32x32x16_bf16(kf[5],qr[2],C1,0,0,0),   P1[6],P1[7],P1[8],P1[9],     pw2[2]=PKWM(P1,4), pw2[3]=PKWM(P1,6), pw2); \
    VRD(3); SBAR(); GAPA(C0=__builtin_amdgcn_mfma_f32_32x32x16_bf16(kf[6],qr[3],C0,0,0,0),   P1[10],P1[11],P1[12],P1[13], pw3[0]=PKWM(P1,8), pw3[1]=PKWM(P1,10), pw3); \
    VRD(7); SBAR(); GAPA(C1=__builtin_amdgcn_mfma_f32_32x32x16_bf16(kf[7],qr[3],C1,0,0,0),   P1[14],P1[15],0.f,0.f,       pw3[2]=PKWM(P1,12),pw3[3]=PKWM(P1,14), pw3); \
    l_reg+=(selw_?sacc:0.f); \
    if(GK){DMA_K((t)+3,sl_cur);} if(GV){DMA_V((t)+1,sl_next);} \
    CMASK(C0,C1,t); \
    { float a=MX3(C0[0],C0[1],C1[0]),b=MX3(C0[2],C0[3],C1[1]); a=MX3(a,C1[2],C1[3]); \
      _Pragma("unroll") for(int r=4;r<16;r+=4){a=MX3(a,C0[r],C0[r+1]);b=MX3(b,C0[r+2],C0[r+3]);a=MX3(a,C1[r],C1[r+1]);b=MX3(b,C1[r+2],C1[r+3]);} \
      float rm=__builtin_fmaxf(a,b); { auto rr=__builtin_amdgcn_permlane32_swap(__float_as_uint(rm),__float_as_uint(rm),false,false); rm=__builtin_fmaxf(__uint_as_float(rr[0]),__uint_as_float(rr[1])); } \
      rm=((selmask>>((t)>>2))&1u)?rm:-INFINITY; resc=false; \
      if(__builtin_expect(__any(rm>(float)THRL),0)){ const float dl=__builtin_fmaxf(rm,0.f); mhat+=dl; \
        _Pragma("unroll") for(int r=0;r<16;++r){C0[r]-=dl;C1[r]-=dl;} \
        _Pragma("unroll") for(int r=0;r<16;++r)negm[r]=-mhat; asm volatile("":"+v"(negm)); \
        const float f=__builtin_amdgcn_exp2f(-dl); l_reg*=f; if(hi==0)wsf[r32]=f; resc=true; } } \
    SBAR(); \
    GAPB(o[0]=__builtin_amdgcn_mfma_f32_32x32x16_bf16(PAF(0),VFR(0),o[0],0,0,0), C0,0); \
    GAPB(o[1]=__builtin_amdgcn_mfma_f32_32x32x16_bf16(PAF(0),VFR(4),o[1],0,0,0), C0,4); \
    KRD(GL,0); GAPB(o[0]=__builtin_amdgcn_mfma_f32_32x32x16_bf16(PAF(1),VFR(1),o[0],0,0,0), C0,8); \
    KRD(GL,1); GAPB(o[1]=__builtin_amdgcn_mfma_f32_32x32x16_bf16(PAF(1),VFR(5),o[1],0,0,0), C0,12); \
    KRD(GL,2); GAPB(o[0]=__builtin_amdgcn_mfma_f32_32x32x16_bf16(PAF(2),VFR(2),o[0],0,0,0), C1,0); \
    KRD(GL,3); GAPB(o[1]=__builtin_amdgcn_mfma_f32_32x32x16_bf16(PAF(2),VFR(6),o[1],0,0,0), C1,4); \
    GAPB(o[0]=__builtin_amdgcn_mfma_f32_32x32x16_bf16(PAF(3),VFR(3),o[0],0,0,0), C1,8); \
    GAPB(o[1]=__builtin_amdgcn_mfma_f32_32x32x16_bf16(PAF(3),VFR(7),o[1],0,0,0), C1,12); \
    }while(0)
  int t=1;
  #undef CMASK
  #define CMASK(P0,P1,t) do{}while(0)
  for(;t+5<NT;t+=2){
    STEP(pB0,pB1,pA0,pA1,t,true,true,true);     WAIT_BAR(2); RESC(); ROT();
    STEP(pA0,pA1,pB0,pB1,t+1,true,true,true);   WAIT_BAR(2); RESC(); ROT();
  }
  #undef CMASK
  #define CMASK(P0,P1,t) do{int jb_=(t)-(NT-4); if(jb_>=0)cmask(P0,P1,jb_,qrel,hi);}while(0)
  #define ENDW(tt) do{ if((tt)+3<NT){WAIT_BAR(2);} else if((tt)+2<NT){WAIT_BAR(1);} else {WAIT_BAR(0);} }while(0)
  for(;t+1<NT;t+=2){
    STEP(pB0,pB1,pA0,pA1,t,(t+3<NT),(t+1<NT),(t+1<NT));       ENDW(t);   RESC(); ROT();
    STEP(pA0,pA1,pB0,pB1,t+1,(t+4<NT),(t+2<NT),(t+2<NT));     ENDW(t+1); RESC(); ROT();
  }
  STEP(pB0,pB1,pA0,pA1,NT-1,false,false,false); RESC();
  { float sacc=pB0[0]+pB0[1]; _Pragma("unroll") for(int r=2;r<16;++r)sacc+=pB0[r]; _Pragma("unroll") for(int r=0;r<16;++r)sacc+=pB1[r]; l_reg+=sacc;
    pw0=(u32x4){PKW(pB0,0),PKW(pB0,2),PKW(pB0,4),PKW(pB0,6)};pw1=(u32x4){PKW(pB0,8),PKW(pB0,10),PKW(pB0,12),PKW(pB0,14)};pw2=(u32x4){PKW(pB1,0),PKW(pB1,2),PKW(pB1,4),PKW(pB1,6)};pw3=(u32x4){PKW(pB1,8),PKW(pB1,10),PKW(pB1,12),PKW(pB1,14)};
    SBAR(); pv(o,vb0+sl_cur,PAF(0),PAF(1),PAF(2),PAF(3)); }
  #undef PKW
  #undef PKWM
  #undef PAF
  #undef VFR
  #undef PIN
  #undef MX3
  #undef GAPA
  #undef GAPB
  #undef EX
  #undef VRD
  #undef KRD
  #undef STEP
  #undef ENDW
  {auto rr=__builtin_amdgcn_permlane32_swap(__float_as_uint(l_reg),__float_as_uint(l_reg),false,false);l_reg=__uint_as_float(rr[0])+__uint_as_float(rr[1]);}
  if(hi==0)wsf[32+r32]=l_reg;asm volatile("s_waitcnt lgkmcnt(0)":::"memory");
  float rli[16];
  #pragma unroll
  for(int r=0;r<16;++r)rli[r]=__builtin_amdgcn_rcpf(wsf[32+crow(r,hi)]);
  bf16*Ow=O+(rowbase+q0+wid*QBLK)*DM+h*D;
  { bf16*stg=(bf16*)(shm+LDS_OST)+wid*2048;
    #pragma unroll
    for(int r=0;r<16;++r){const int orow=crow(r,hi);
      #pragma unroll
      for(int d0=0;d0<2;++d0)stg[orow*64+d0*32+r32]=__float2bfloat16(o[d0][r]*rli[r]);}
    asm volatile("s_waitcnt lgkmcnt(0)":::"memory");
    #pragma unroll
    for(int i=0;i<4;++i){const int row=i*8+(lane>>3),ch=lane&7; const u32x4 v=*(const u32x4*)(stg+row*64+ch*8); ATTN_STORE16(Ow+(long)row*DM+ch*8,v);} }
  asm volatile("s_waitcnt lgkmcnt(0)\n\ts_barrier":::"memory");
  #undef DMA_K
  #undef DMA_V
  #undef CMASK
  #undef START
  #undef RESC
  #undef ROT
}
constexpr int ATTN_LDS_BYTES=LDS_BYTES;
struct AttnTensors { const bf16* Q; const bf16* K; const bf16* V; bf16* O; const float* ksum; };
struct AttnUnit { int bh; int qb; };
struct StaticOrder {
  int vcu,G;
  __device__ __forceinline__ explicit StaticOrder(int grid,int block):vcu((grid%8==0)?(block%8)*(grid/8)+block/8:block),G(grid){}
  __device__ __forceinline__ bool next(int i,AttnUnit&u)const{ if(G!=256){ const int id=i*G+vcu; if(id>=BATCH*NHEAD*NQB)return false; u.bh=id/NQB; u.qb=NQB-1-id%NQB; return true; }
    if(i>=4)return false; const int s=vcu&3; u.bh=vcu>>2; u.qb=(i==0)?15-s:(i==1)?s:(i==2)?11-s:4+s; return true; }
  __device__ __forceinline__ void a_ready(const AttnUnit&)const{}
  __device__ __forceinline__ void done(const AttnUnit&)const{}
};
template<class Sched,int THRL=8> __device__ __forceinline__ void attn_phase(char*lds,const AttnTensors&T,const Sched&S){
  AttnUnit u;
  for(int i=0;S.next(i,u);++i){ S.a_ready(u); attn_unit<THRL>(u.bh/NHEAD,u.bh%NHEAD,u.qb,T.Q,T.K,T.V,T.O,T.ksum,lds); S.done(u); }
}
#undef SBAR
#undef WAIT_BAR
}
#define GAS __attribute__((address_space(1)))
#define LAS __attribute__((address_space(3)))
typedef unsigned short bf16;
typedef unsigned v4u __attribute__((ext_vector_type(4)));
typedef float f32x4 __attribute__((ext_vector_type(4)));
typedef short bf16x8 __attribute__((ext_vector_type(8)));
typedef GAS unsigned gu32;
typedef GAS unsigned long long gu64;
#define RLX_AGENT __ATOMIC_RELAXED, __HIP_MEMORY_SCOPE_AGENT
#define LDS_WAIT() asm volatile("s_waitcnt lgkmcnt(0)" ::: "memory")
#define VM_WAIT() asm volatile("s_waitcnt vmcnt(0)" ::: "memory")
__device__ __forceinline__ unsigned long long rt() { return __builtin_amdgcn_s_memrealtime(); }
__device__ __forceinline__ unsigned f2bf(float f) { unsigned u = __builtin_bit_cast(unsigned, f); return (u + 0x7fffu + ((u >> 16) & 1u)) >> 16; }
__device__ __forceinline__ unsigned pk2(float lo, float hi) { return f2bf(lo) | (f2bf(hi) << 16); }
#define XB_TMO      128
#define XB_XCNT(j)  (256  + 64 * (j))
#define XB_XSUB(j)  (1280 + 64 * (j))
#define XB_XGEN(j)  (2304 + 64 * (j))
#define XB_TOP      3328
#define XB_TOPGEN   3392
#define XCD_BAR_WORDS 3456
#define XB_SPIN_CAP (1u << 18)

__device__ __forceinline__ unsigned xb_ld(unsigned* p)              { return __hip_atomic_load(p, __ATOMIC_RELAXED, __HIP_MEMORY_SCOPE_AGENT); }
__device__ __forceinline__ unsigned xb_add(unsigned* p, unsigned v) { return __hip_atomic_fetch_add(p, v, __ATOMIC_RELAXED, __HIP_MEMORY_SCOPE_AGENT); }
__device__ __forceinline__ unsigned xb_xcc_id() { return (unsigned)__builtin_amdgcn_s_getreg((3 << 11) | 20) & 0xFu; }
#define XB_SPIN(cond, bar) do { unsigned _sp = 0; while (cond) { __builtin_amdgcn_s_sleep(1); \
    if ((++_sp & 255u) == 0u) { if (xb_ld(&(bar)[XB_TMO])) break; if (_sp > XB_SPIN_CAP) { atomicAdd(&(bar)[XB_TMO], 1u); break; } } } } while (0)

struct XcdBarrier {
    unsigned* bar; unsigned x;
    volatile LAS unsigned* st;
};

__device__ __forceinline__ XcdBarrier xcd_barrier_post(unsigned* bar, volatile LAS unsigned* st) {
    XcdBarrier b; b.bar = bar; b.x = xb_xcc_id(); b.st = st;
    if (threadIdx.x == 0) (void)xb_add(&bar[XB_XCNT(b.x)], 1u);
    return b;
}
__device__ __forceinline__ void xcd_barrier_complete(unsigned* bar, unsigned x, unsigned& nloc, unsigned& nx) {
    const unsigned G = gridDim.x * gridDim.y * gridDim.z;
    unsigned sum, cnt, mine, sp = 0u;
    for (;;) {
        sum = 0u; cnt = 0u; mine = 0u;
#pragma unroll
        for (unsigned j = 0; j < 16; ++j) { const unsigned c = xb_ld(&bar[XB_XCNT(j)]); sum += c; cnt += (c > 0u) ? 1u : 0u; mine = (j == x) ? c : mine; }
        if (sum == G) break;
        __builtin_amdgcn_s_sleep(1);
        if ((++sp & 255u) == 0u) { if (xb_ld(&bar[XB_TMO])) break; if (sp > XB_SPIN_CAP) { atomicAdd(&bar[XB_TMO], 1u); break; } }
    }
    nloc = mine > 0u ? mine : 1u; nx = cnt > 0u ? cnt : 1u;
}

__device__ __forceinline__ void xcd_barrier(const XcdBarrier& b) {
    asm volatile("s_waitcnt vmcnt(0)" ::: "memory");
    __syncthreads();
    if (threadIdx.x == 0) {
        unsigned* bar = b.bar;
        __builtin_amdgcn_s_waitcnt(0);
        unsigned nloc = b.st[0], nx = b.st[1];
        if (nloc == 0u) { xcd_barrier_complete(bar, b.x, nloc, nx); b.st[0] = nloc; b.st[1] = nx; }
        const unsigned old = xb_add(&bar[XB_XSUB(b.x)], 1u);
        const unsigned gen = old / nloc;
        if (old + 1u == (gen + 1u) * nloc) {
            __builtin_amdgcn_fence(__ATOMIC_RELEASE, "agent");
            asm volatile("s_waitcnt vmcnt(0)" ::: "memory");
            const unsigned og = xb_add(&bar[XB_TOP], 1u);
            const unsigned tg = og / nx;
            if (og + 1u == (tg + 1u) * nx) xb_add(&bar[XB_TOPGEN], 1u);
            else XB_SPIN(xb_ld(&bar[XB_TOPGEN]) == tg, bar);
            __builtin_amdgcn_fence(__ATOMIC_ACQUIRE, "agent");
            xb_add(&bar[XB_XGEN(b.x)], 1u);
            asm volatile("s_waitcnt vmcnt(0)" ::: "memory");
        } else {
            XB_SPIN(xb_ld(&bar[XB_XGEN(b.x)]) == gen, bar);
            __builtin_amdgcn_fence(__ATOMIC_ACQUIRE, "agent");
            asm volatile("s_waitcnt vmcnt(0)" ::: "memory");
        }
    }
    __syncthreads();
}
__device__ __forceinline__ float wave_sum(float v) {
#pragma unroll
    for (int o = 1; o < 64; o <<= 1) v += __shfl_xor(v, o);
    return v;
}
__device__ __forceinline__ void p0_transpose_item(const float* W, int K, int N, bf16* WT, int row_off, LAS float* scr, int item, int lane) {
    const int nblk = N / 32, kb = item / nblk, nb = item % nblk, k0 = 64 * kb, n0 = 32 * nb;
#pragma unroll 8
    for (int i = 0; i < 32; ++i) { const int kk = 2 * i + (lane >> 5); scr[kk * 33 + (lane & 31)] = W[(size_t)(k0 + kk) * N + n0 + (lane & 31)]; }
    LDS_WAIT(); asm volatile("" ::: "memory");
    const int c = lane & 7;
#pragma unroll
    for (int j = 0; j < 4; ++j) { const int n = (lane >> 3) + 8 * j; const LAS float* s = scr + (8 * c) * 33 + n;
        v4u o; o.x = pk2(s[0 * 33], s[1 * 33]); o.y = pk2(s[2 * 33], s[3 * 33]); o.z = pk2(s[4 * 33], s[5 * 33]); o.w = pk2(s[6 * 33], s[7 * 33]);
        *(GAS v4u*)(WT + (size_t)(row_off + n0 + n) * K + k0 + 8 * c) = o; }
    LDS_WAIT(); asm volatile("" ::: "memory");
}
constexpr int NWAVES = 8;
#ifndef MK_PER_PHASE
#define MK_PER_PHASE 0
#endif
constexpr int NPHASES = 11;

constexpr int BATCH = 8, SEQ = 4096, D = 1024, M = BATCH * SEQ, NIN = 4096, SW = 512, AW = 512;
constexpr int NG = 32, GH = 16, NP = 64, NH = 8, HD = 64, FF = 4096, NBLK = 16, BLK = 256;
constexpr float RMS_EPS = 1e-6f;
constexpr float C2 = 0.125f * 1.4426950408889634f;

constexpr size_t MiB = 1u << 20;
constexpr size_t WS_CTL = 0, CTL_ZERO_BYTES = 1 * MiB;
constexpr size_t WS_KSUM = 512 * 1024;
constexpr size_t WS_TAB = 1 * MiB;
constexpr size_t WS_WIN = 2 * MiB, WS_WGLU = 10 * MiB, WS_WA = 11 * MiB, WS_WB = 12 * MiB, WS_WO = 13 * MiB, WS_W1 = 15 * MiB, WS_W2 = 23 * MiB;
constexpr size_t WS_U = 32 * MiB;
constexpr size_t WS_ZX = 96 * MiB;
constexpr size_t WS_Q = 144 * MiB, WS_K = 176 * MiB, WS_V = 208 * MiB;
constexpr size_t WS_SGA = 240 * MiB, WS_SGB = 304 * MiB;
constexpr size_t WS_VS = 368 * MiB, WS_YA = 400 * MiB;
constexpr size_t WS_MG = 432 * MiB;
constexpr size_t WS_MIX = 368 * MiB;
constexpr size_t WS_HM = 96 * MiB;
constexpr size_t WS_WS = 496 * MiB, WS_KG = 500 * MiB, WS_KM = 506 * MiB;
constexpr size_t WS_END = 507 * MiB;
constexpr int CW_TMO = 0, CW_CODE = 1, CW_BAR = 4096;

constexpr int RING_OFF = 0, RING_BYTES = 131072;
constexpr int LDSCTL_OFF = RING_BYTES, MISC_OFF = LDSCTL_OFF + 320;
constexpr int LDS_BYTES = 147456;

constexpr int TB_ABR = 0, TB_ABI = 2048, TB_BBR = 4096, TB_BBI = 4096 + 32768, TB_A16R = 4096 + 65536, TB_A16I = TB_A16R + 2048, TB_A512R = TB_A16I + 2048, TB_A512I = TB_A512R + 2048;
#ifndef SSM_NAIVE
#define SSM_NAIVE 0
#endif

__device__ __forceinline__ float bf2f(bf16 v) { return __builtin_bit_cast(float, (unsigned)v << 16); }
__device__ __forceinline__ float gelu_tanh(float x) {
    const float u = 0.7978845608028654f * (x + 0.044715f * x * x * x);
    const float e = __builtin_amdgcn_exp2f(-2.0f * 1.4426950408889634f * fabsf(u));
    const float t = (1.0f - e) * __builtin_amdgcn_rcpf(1.0f + e);
    return 0.5f * x * (1.0f + (u < 0.f ? -t : t));
}

__device__ __forceinline__ void cpowk(double lr, double li, double dt, double k, double& re, double& im) { const double mg = exp(k * lr * dt), an = k * li * dt; re = mg * cos(an); im = mg * sin(an); }
__device__ __forceinline__ void zoh_coef(double lr, double li, double dt, double& cr, double& ci) { double ar, ai; cpowk(lr, li, dt, 1.0, ar, ai); const double nr = ar - 1.0, ni = ai, den = lr * lr + li * li; cr = (nr * lr + ni * li) / den; ci = (ni * lr - nr * li) / den; }
__device__ __forceinline__ float reduce16(const float (&v)[16], int lane) {
    float a8[8], a4[4], a2[2], a1;
    { const bool up = (lane & 32) != 0;
#pragma unroll
      for (int j = 0; j < 8; ++j) { const float send = up ? v[j] : v[j + 8]; const float keep = up ? v[j + 8] : v[j]; a8[j] = keep + __shfl_xor(send, 32); } }
    { const bool up = (lane & 16) != 0;
#pragma unroll
      for (int j = 0; j < 4; ++j) { const float send = up ? a8[j] : a8[j + 4]; const float keep = up ? a8[j + 4] : a8[j]; a4[j] = keep + __shfl_xor(send, 16); } }
    { const bool up = (lane & 8) != 0;
#pragma unroll
      for (int j = 0; j < 2; ++j) { const float send = up ? a4[j] : a4[j + 2]; const float keep = up ? a4[j + 2] : a4[j]; a2[j] = keep + __shfl_xor(send, 8); } }
    { const bool up = (lane & 4) != 0; const float send = up ? a2[0] : a2[1]; const float keep = up ? a2[1] : a2[0]; a1 = keep + __shfl_xor(send, 4); }
    a1 += __shfl_xor(a1, 2); a1 += __shfl_xor(a1, 1);
    return a1;
}
#define PH_PTRS unsigned char* wsl = args.ws; asm volatile("" : "+s"(wsl));   \
    bf16 *Win_t = (bf16*)(wsl + WS_WIN), *Wglu_t = (bf16*)(wsl + WS_WGLU), *Wa_t = (bf16*)(wsl + WS_WA), *Wb_t = (bf16*)(wsl + WS_WB), *Wo_t = (bf16*)(wsl + WS_WO), *W1_t = (bf16*)(wsl + WS_W1), *W2_t = (bf16*)(wsl + WS_W2); \
    bf16 *U = (bf16*)(wsl + WS_U), *ZX = (bf16*)(wsl + WS_ZX), *Qb = (bf16*)(wsl + WS_Q), *Kb = (bf16*)(wsl + WS_K), *Vb = (bf16*)(wsl + WS_V), *SGA = (bf16*)(wsl + WS_SGA), *SGB = (bf16*)(wsl + WS_SGB); \
    bf16 *VS = (bf16*)(wsl + WS_VS), *YA = (bf16*)(wsl + WS_YA), *MG = (bf16*)(wsl + WS_MG), *MIX = (bf16*)(wsl + WS_MIX), *HM = (bf16*)(wsl + WS_HM); \
    float* ksum = (float*)(wsl + WS_KSUM); float* tab = (float*)(wsl + WS_TAB); bf16 *WsT = (bf16*)(wsl + WS_WS), *KG = (bf16*)(wsl + WS_KG); float* KM = (float*)(wsl + WS_KM); \
    const float* x = args.in[0]; float* out = args.out; \
    (void)Win_t; (void)Wglu_t; (void)Wa_t; (void)Wb_t; (void)Wo_t; (void)W1_t; (void)W2_t; (void)U; (void)ZX; (void)Qb; (void)Kb; (void)Vb; (void)SGA; (void)SGB; (void)VS; (void)YA; (void)MG; (void)MIX; (void)HM; (void)ksum; (void)tab; (void)WsT; (void)KG; (void)KM; (void)x; (void)out
struct Args { const float* in[21]; float* out; unsigned char* ws; int ph_lo, ph_hi; };

__device__ __forceinline__ void rms_row_to_bf16(const float* xrow, const float* g, bf16* orow, int lane) {
    const GAS f32x4* xr = (const GAS f32x4*)xrow + lane; const GAS f32x4* gr = (const GAS f32x4*)g + lane;
    f32x4 v[4]; float s = 0.f;
#pragma unroll
    for (int j = 0; j < 4; ++j) { v[j] = xr[64 * j]; s += (v[j].x * v[j].x + v[j].y * v[j].y) + (v[j].z * v[j].z + v[j].w * v[j].w); }
    const float r = 1.0f / sqrtf(wave_sum(s) * (1.f / D) + RMS_EPS);
    GAS unsigned long long* o8 = (GAS unsigned long long*)orow + lane;
#pragma unroll
    for (int j = 0; j < 4; ++j) { const f32x4 gg = gr[64 * j];
        o8[64 * j] = (unsigned long long)pk2(v[j].x * r * gg.x, v[j].y * r * gg.y) | ((unsigned long long)pk2(v[j].z * r * gg.z, v[j].w * r * gg.w) << 32); }
}

__global__ void __launch_bounds__(NWAVES * 64, 2) fwd(Args args) {
    extern __shared__ __attribute__((aligned(16))) unsigned char lds[];
    LAS unsigned char* L = (LAS unsigned char*)lds;
    volatile LAS unsigned* MISC = (volatile LAS unsigned*)(L + MISC_OFF);
    const int tid = threadIdx.x, lane = tid & 63, wave = __builtin_amdgcn_readfirstlane(tid >> 6);
    const int G = gridDim.x; const int bx = blockIdx.x; const int vcu = (G % 8 == 0) ? (bx % 8) * (G / 8) + bx / 8 : bx;
    unsigned char* ws = args.ws;
    gu32* ctl = (gu32*)(ws + WS_CTL);
    const int gtid = vcu * (NWAVES * 64) + tid, NTHR = G * NWAVES * 64;
    for (int u = tid; u < (LDS_BYTES - LDSCTL_OFF) / 4; u += NWAVES * 64) ((LAS unsigned*)(L + LDSCTL_OFF))[u] = 0u;
    __syncthreads();
    XcdBarrier bar; bar.bar = (unsigned*)(ctl + CW_BAR); bar.x = 0; bar.st = nullptr;
    if (!MK_PER_PHASE) bar = xcd_barrier_post((unsigned*)(ctl + CW_BAR), MISC + 8);
#define GRID_BAR() do { if (MK_PER_PHASE) { if (tid == 0) __hip_atomic_store(ctl + CW_TMO, 0xBADBA0u, RLX_AGENT); } else { xcd_barrier(bar); } } while (0)
    const int lo = args.ph_lo, hi = args.ph_hi;
#define IN(k) (lo <= (k) && (k) < hi)
#define BOTH(k) (IN(k) && IN((k) + 1))
    const int gw = vcu * NWAVES + wave, NGW = G * NWAVES;

    if (IN(0)) { PH_PTRS;
        LAS float* scr = (LAS float*)(L + RING_OFF + wave * 16384);
        constexpr int I_IN = (D / 64) * (NIN / 32), I_GLU = (SW / 64) * (SW / 32), I_A = (SW / 64) * (D / 32), I_O = (D / 64) * (D / 32), I_1 = (D / 64) * (FF / 32), I_2 = (FF / 64) * (D / 32);
        constexpr int NITEMS = I_IN + I_GLU + 2 * I_A + I_O + I_1 + I_2;
        for (int it = gw; it < NITEMS; it += NGW) {
            int r = it;
            if (r < I_IN) { p0_transpose_item(args.in[2], D, NIN, Win_t, 0, scr, r, lane); continue; } r -= I_IN;
            if (r < I_GLU) { p0_transpose_item(args.in[11], SW, SW, Wglu_t, 0, scr, r, lane); continue; } r -= I_GLU;
            if (r < I_A) { p0_transpose_item(args.in[13], SW, D, Wa_t, 0, scr, r, lane); continue; } r -= I_A;
            if (r < I_A) { p0_transpose_item(args.in[14], AW, D, Wb_t, 0, scr, r, lane); continue; } r -= I_A;
            if (r < I_O) { p0_transpose_item(args.in[15], D, D, Wo_t, 0, scr, r, lane); continue; } r -= I_O;
            if (r < I_1) { p0_transpose_item(args.in[18], D, FF, W1_t, 0, scr, r, lane); continue; } r -= I_1;
            p0_transpose_item(args.in[19], FF, D, W2_t, 0, scr, r, lane);
        }
        for (int m = gw; m < M; m += NGW) rms_row_to_bf16(x + (size_t)m * D, args.in[1], U + (size_t)m * D, lane);
        const float *lam_re = args.in[3], *lam_im = args.in[4], *log_dt = args.in[5], *b_re = args.in[6], *b_im = args.in[7], *c_re = args.in[8], *c_im = args.in[9];
        if (gtid < NG * NP) { const int gp = gtid, g = gp / NP;
            const double lr = (double)lam_re[gp], li = (double)lam_im[gp], dt = exp((double)log_dt[g]);
            double ar, ai, cr, ci; cpowk(lr, li, dt, 1.0, ar, ai); zoh_coef(lr, li, dt, cr, ci);
            tab[TB_ABR + gp] = (float)ar; tab[TB_ABI + gp] = (float)ai;
            cpowk(lr, li, dt, 16.0, ar, ai); tab[TB_A16R + gp] = (float)ar; tab[TB_A16I + gp] = (float)ai;
            cpowk(lr, li, dt, 512.0, ar, ai); tab[TB_A512R + gp] = (float)ar; tab[TB_A512I + gp] = (float)ai;
            for (int h = 0; h < GH; ++h) { const double br = (double)b_re[gp * GH + h], bi = (double)b_im[gp * GH + h];
                tab[TB_BBR + gp * GH + h] = (float)(cr * br - ci * bi); tab[TB_BBI + gp * GH + h] = (float)(cr * bi + ci * br); } }
        for (int e = gtid; e < NG * NP * 16; e += NTHR) {
            const int p = e % NP, s_ = (e / NP) % 16, g = e / (NP * 16), gp = g * NP + p;
            const double lr = (double)lam_re[gp], li = (double)lam_im[gp], dt = exp((double)log_dt[g]);
            double wr_, wi_, cr, ci; cpowk(lr, li, dt, (double)(15 - s_), wr_, wi_); zoh_coef(lr, li, dt, cr, ci);
            float vr[GH], vi[GH];
#pragma unroll
            for (int h = 0; h < GH; ++h) { const double br = (double)b_re[gp * GH + h], bi = (double)b_im[gp * GH + h], Br = cr * br - ci * bi, Bi = cr * bi + ci * br;
                vr[h] = (float)(wr_ * Br - wi_ * Bi); vi[h] = (float)(wr_ * Bi + wi_ * Br); }
            GAS v4u* o_r = (GAS v4u*)(WsT + ((size_t)(g * 256 + p)) * 256 + s_ * 16); GAS v4u* o_i = (GAS v4u*)(WsT + ((size_t)(g * 256 + 64 + p)) * 256 + s_ * 16);
            o_r[0] = (v4u){pk2(vr[0], vr[1]), pk2(vr[2], vr[3]), pk2(vr[4], vr[5]), pk2(vr[6], vr[7])}; o_r[1] = (v4u){pk2(vr[8], vr[9]), pk2(vr[10], vr[11]), pk2(vr[12], vr[13]), pk2(vr[14], vr[15])};
            o_i[0] = (v4u){pk2(vi[0], vi[1]), pk2(vi[2], vi[3]), pk2(vi[4], vi[5]), pk2(vi[6], vi[7])}; o_i[1] = (v4u){pk2(vi[8], vi[9]), pk2(vi[10], vi[11]), pk2(vi[12], vi[13]), pk2(vi[14], vi[15])}; }
        for (int e = gtid; e < NG * 4096; e += NTHR) {
            const int g = e / 4096, r = e % 4096; ((GAS v4u*)(WsT + ((size_t)(g * 256 + 128)) * 256))[r] = (v4u){0u, 0u, 0u, 0u}; }
        for (int e = gtid; e < NG * NP * 16; e += NTHR) {
            const int p = e % NP, t = (e / NP) % 16, g = e / (NP * 16), gp = g * NP + p;
            const double lr = (double)lam_re[gp], li = (double)lam_im[gp], dt = exp((double)log_dt[g]);
            double wr_, wi_; cpowk(lr, li, dt, (double)(t + 1), wr_, wi_);
            for (int h = 0; h < GH; ++h) { const double cr = (double)c_re[(g * GH + h) * NP + p], ci = (double)c_im[(g * GH + h) * NP + p];
                bf16* o = KG + ((size_t)(g * 256 + t * 16 + h)) * 384 + 256 + p;
                o[0] = (bf16)f2bf((float)(cr * wr_ - ci * wi_)); o[64] = (bf16)f2bf((float)(-(cr * wi_ + ci * wr_))); } }
        for (int wt = gw; wt < NG * 16; wt += NGW) {
            const int g = wt / 16, j = wt % 16, p = lane, gp = g * NP + p;
            const double lr = (double)lam_re[gp], li = (double)lam_im[gp], dt = exp((double)log_dt[g]);
            double wr_, wi_, cr, ci; cpowk(lr, li, dt, (double)j, wr_, wi_); zoh_coef(lr, li, dt, cr, ci);
            float Br[GH], Bi[GH];
#pragma unroll
            for (int h = 0; h < GH; ++h) { const double br = (double)b_re[gp * GH + h], bi = (double)b_im[gp * GH + h]; Br[h] = (float)(cr * br - ci * bi); Bi[h] = (float)(cr * bi + ci * br); }
            for (int hp = 0; hp < GH; ++hp) { const double c1 = (double)c_re[(g * GH + hp) * NP + p], c2 = (double)c_im[(g * GH + hp) * NP + p];
                const float cwr = (float)(c1 * wr_ - c2 * wi_), cwi = (float)(c1 * wi_ + c2 * wr_);
                float v[GH];
#pragma unroll
                for (int h = 0; h < GH; ++h) v[h] = cwr * Br[h] - cwi * Bi[h];
                const float tot = reduce16(v, lane);
                if ((lane & 3) == 0) KM[((g * 16 + j) * 16 + hp) * 16 + (lane >> 2)] = tot; } }
        if (BOTH(0)) GRID_BAR();
    }

    if (IN(1)) { PH_PTRS;
        for (int e = gtid; e < NG * 256 * 32; e += NTHR) {
            const int kc = e % 32, n = (e / 32) % 256, g_ = e / (32 * 256), s_ = kc >> 1, h0 = (kc & 1) * 8, t = n >> 4, hp = n & 15;
            v4u w = (v4u){0u, 0u, 0u, 0u};
            if (s_ <= t) { const float* k8 = KM + ((g_ * 16 + (t - s_)) * 16 + hp) * 16 + h0; w = (v4u){pk2(k8[0], k8[1]), pk2(k8[2], k8[3]), pk2(k8[4], k8[5]), pk2(k8[6], k8[7])}; }
            *(GAS v4u*)(KG + ((size_t)(g_ * 256 + n)) * 384 + kc * 8) = w; }
        pg8::Gemm g{U, Win_t, M, NIN, D, D, D}; pg8::StaticOrder S; S.init(M, NIN, G, bx);
        pg8::EpiIn E{wsl, (unsigned)WS_ZX, (unsigned)WS_Q, (unsigned)WS_K, (unsigned)WS_V, (unsigned)WS_SGA, (unsigned)WS_SGB, ksum, C2};
        pg8::gemm_phase<pg8::EpiIn, pg8::StaticOrder, true, true>(L + RING_OFF, g, S, E);
        if (BOTH(1)) GRID_BAR();
    }

    if (IN(2)) { PH_PTRS;
#if SSM_NAIVE
        if (wave == 0) {
            for (int item = vcu; item < BATCH * NG; item += G) {
                const int b = item / NG, g = item % NG, p = lane;
                const float abr = tab[TB_ABR + g * NP + p], abi = tab[TB_ABI + g * NP + p];
                float bbr[GH], bbi[GH], cr[GH], ci[GH];
#pragma unroll
                for (int h = 0; h < GH; ++h) { bbr[h] = tab[TB_BBR + (g * NP + p) * GH + h]; bbi[h] = tab[TB_BBI + (g * NP + p) * GH + h];
                    cr[h] = args.in[8][(g * GH + h) * NP + p]; ci[h] = args.in[9][(g * GH + h) * NP + p]; }
                const int hme = lane >> 2;
                const float dsk = args.in[10][g * GH + hme];
                float xr = 0.f, xi = 0.f;
                const bf16* zrow = ZX + (size_t)((g * 8 + b) * 256) * 384;
                bf16* vrow = VS + (size_t)b * SEQ * SW + g * GH;
                for (int t = 0; t < SEQ; ++t) {
                    const v4u w0 = *(const GAS v4u*)(zrow + (size_t)(t >> 4) * 384 + (t & 15) * 16), w1 = *(const GAS v4u*)(zrow + (size_t)(t >> 4) * 384 + (t & 15) * 16 + 8);
                    float uu[GH];
                    uu[0] = pg8::bf_lo(w0.x); uu[1] = pg8::bf_hi(w0.x); uu[2] = pg8::bf_lo(w0.y); uu[3] = pg8::bf_hi(w0.y); uu[4] = pg8::bf_lo(w0.z); uu[5] = pg8::bf_hi(w0.z); uu[6] = pg8::bf_lo(w0.w); uu[7] = pg8::bf_hi(w0.w);
                    uu[8] = pg8::bf_lo(w1.x); uu[9] = pg8::bf_hi(w1.x); uu[10] = pg8::bf_lo(w1.y); uu[11] = pg8::bf_hi(w1.y); uu[12] = pg8::bf_lo(w1.z); uu[13] = pg8::bf_hi(w1.z); uu[14] = pg8::bf_lo(w1.w); uu[15] = pg8::bf_hi(w1.w);
                    float bur = 0.f, bui = 0.f;
#pragma unroll
                    for (int h = 0; h < GH; ++h) { bur += bbr[h] * uu[h]; bui += bbi[h] * uu[h]; }
                    const float nxr = abr * xr - abi * xi + bur, nxi = abr * xi + abi * xr + bui; xr = nxr; xi = nxi;
                    float v[GH];
#pragma unroll
                    for (int h = 0; h < GH; ++h) v[h] = cr[h] * xr - ci[h] * xi;
                    const float a1 = reduce16(v, lane);
                    float um = uu[0];
#pragma unroll
                    for (int h = 1; h < GH; ++h) um = (hme == h) ? uu[h] : um;
                    const float y = a1 + dsk * um;
                    if ((lane & 3) == 0) vrow[(size_t)t * SW + hme] = (bf16)f2bf(gelu_tanh(y));
                }
            }
        }
#else
        if (vcu < NG * BATCH) { const int item = vcu;
            const int g_ = item >> 3, b_ = item & 7;
            { pg8::Gemm gm{ZX, WsT + (size_t)g_ * 256 * 256, NG * BATCH * 256, 256, 256, 384, 256}; pg8::OneUnit S{item, 0};
              pg8::EpiSsmState E{ZX + (size_t)item * 256 * 384, tab + TB_A16R + g_ * NP, tab + TB_A16I + g_ * NP, tab + TB_A512R + g_ * NP, tab + TB_A512I + g_ * NP};
              pg8::gemm_phase<pg8::EpiSsmState, pg8::OneUnit, false, true>(L + RING_OFF, gm, S, E); }
            VM_WAIT(); __syncthreads();
            { pg8::Gemm gm{ZX, KG + (size_t)g_ * 256 * 384, NG * BATCH * 256, 256, 384, 384, 384}; pg8::OneUnit S{item, 0};
              pg8::EpiSsmOut E{ZX + (size_t)item * 256 * 384, VS + (size_t)b_ * SEQ * SW + g_ * GH, args.in[10] + g_ * GH};
              pg8::gemm_phase<pg8::EpiSsmOut, pg8::OneUnit, true, true>(L + RING_OFF, gm, S, E); }
            __syncthreads();
        }
#endif
        __syncthreads();
        { const attn_body::AttnTensors AT{(const attn_body::bf16*)Qb, (const attn_body::bf16*)Kb, (const attn_body::bf16*)Vb, (attn_body::bf16*)Qb, ksum};
          const attn_body::StaticOrder S(G, bx);
          attn_body::attn_phase<attn_body::StaticOrder>((char*)lds + RING_OFF, AT, S); }
        if (BOTH(2)) GRID_BAR();
    }

    if (IN(3)) { PH_PTRS;
        pg8::Gemm g{VS, Wglu_t, M, SW, SW, SW, SW}; pg8::StaticOrder S; S.init(M, SW, G, bx);
        pg8::EpiGlu E{VS, YA, args.in[12]};
        pg8::gemm_phase<pg8::EpiGlu, pg8::StaticOrder, true, true>(L + RING_OFF, g, S, E);
        if (BOTH(3)) GRID_BAR();
    }
    if (IN(4)) { PH_PTRS;
        pg8::Gemm g{YA, Wa_t, M, D, SW, SW, SW}; pg8::StaticOrder S; S.init(M, D, G, bx);
        pg8::EpiGate<false> E{SGA, MG};
        pg8::gemm_phase<pg8::EpiGate<false>, pg8::StaticOrder, true, true>(L + RING_OFF, g, S, E);
        if (BOTH(4)) GRID_BAR();
    }
    if (IN(5)) { PH_PTRS;
        pg8::Gemm g{Qb, Wb_t, M, D, AW, AW, AW}; pg8::StaticOrder S; S.init(M, D, G, bx);
        pg8::EpiGate<true> E{SGB, MG};
        pg8::gemm_phase<pg8::EpiGate<true>, pg8::StaticOrder, true, true>(L + RING_OFF, g, S, E);
        if (BOTH(5)) GRID_BAR();
    }
    if (IN(6)) { PH_PTRS;
        pg8::Gemm g{MG, Wo_t, M, D, D, D, D}; pg8::StaticOrder S; S.init(M, D, G, bx);
        pg8::EpiBf16<0> E{MIX, D, nullptr, 0, 0, 1.f};
        pg8::gemm_phase<pg8::EpiBf16<0>, pg8::StaticOrder, true, true>(L + RING_OFF, g, S, E);
        if (BOTH(6)) GRID_BAR();
    }
    if (IN(7)) { PH_PTRS;
        const float* gpost = args.in[16]; const float* gpre = args.in[17];
        for (int m = gw; m < M; m += NGW) {
            const GAS f32x4* xr = (const GAS f32x4*)(x + (size_t)m * D) + lane; const GAS unsigned long long* mr = (const GAS unsigned long long*)(MIX + (size_t)m * D) + lane;
            f32x4 xv[4], mv[4]; float s = 0.f;
#pragma unroll
            for (int j = 0; j < 4; ++j) { xv[j] = xr[64 * j]; const unsigned long long w = mr[64 * j]; const unsigned w0 = (unsigned)w, w1 = (unsigned)(w >> 32);
                mv[j] = (f32x4){pg8::bf_lo(w0), pg8::bf_hi(w0), pg8::bf_lo(w1), pg8::bf_hi(w1)}; s += (mv[j].x * mv[j].x + mv[j].y * mv[j].y) + (mv[j].z * mv[j].z + mv[j].w * mv[j].w); }
            const float r = 1.0f / sqrtf(wave_sum(s) * (1.f / D) + RMS_EPS); float s2 = 0.f;
            GAS f32x4* orow = (GAS f32x4*)(out + (size_t)m * D) + lane;
#pragma unroll
            for (int j = 0; j < 4; ++j) { const f32x4 gg = ((const GAS f32x4*)gpost + lane)[64 * j]; xv[j] = xv[j] + (mv[j] * r) * gg; orow[64 * j] = xv[j];
                s2 += (xv[j].x * xv[j].x + xv[j].y * xv[j].y) + (xv[j].z * xv[j].z + xv[j].w * xv[j].w); }
            const float r2 = 1.0f / sqrtf(wave_sum(s2) * (1.f / D) + RMS_EPS);
            GAS unsigned long long* o8 = (GAS unsigned long long*)(U + (size_t)m * D) + lane;
#pragma unroll
            for (int j = 0; j < 4; ++j) { const f32x4 gg = ((const GAS f32x4*)gpre + lane)[64 * j];
                o8[64 * j] = (unsigned long long)pk2(xv[j].x * r2 * gg.x, xv[j].y * r2 * gg.y) | ((unsigned long long)pk2(xv[j].z * r2 * gg.z, xv[j].w * r2 * gg.w) << 32); }
        }
        if (BOTH(7)) GRID_BAR();
    }
    if (IN(8)) { PH_PTRS;
        pg8::Gemm g{U, W1_t, M, FF, D, D, D}; pg8::StaticOrder S; S.init(M, FF, G, bx);
        pg8::EpiRelu2 E{HM, FF};
        pg8::gemm_phase<pg8::EpiRelu2, pg8::StaticOrder, true, true>(L + RING_OFF, g, S, E);
        if (BOTH(8)) GRID_BAR();
    }
    if (IN(9)) { PH_PTRS;
        pg8::Gemm g{HM, W2_t, M, D, FF, FF, FF}; pg8::StaticOrder S; S.init(M, D, G, bx);
        pg8::EpiBf16<0> E{U, D, nullptr, 0, 0, 1.f};
        pg8::gemm_phase<pg8::EpiBf16<0>, pg8::StaticOrder, true, true>(L + RING_OFF, g, S, E);
        if (BOTH(9)) GRID_BAR();
    }
    if (IN(10)) { PH_PTRS;
        const float* gp = args.in[20];
        for (int m = gw; m < M; m += NGW) {
            GAS f32x4* orow = (GAS f32x4*)(out + (size_t)m * D) + lane; const GAS unsigned long long* fr = (const GAS unsigned long long*)(U + (size_t)m * D) + lane;
            f32x4 hv[4], fv[4]; float s = 0.f;
#pragma unroll
            for (int j = 0; j < 4; ++j) { hv[j] = orow[64 * j]; const unsigned long long w = fr[64 * j]; const unsigned w0 = (unsigned)w, w1 = (unsigned)(w >> 32);
                fv[j] = (f32x4){pg8::bf_lo(w0), pg8::bf_hi(w0), pg8::bf_lo(w1), pg8::bf_hi(w1)}; s += (fv[j].x * fv[j].x + fv[j].y * fv[j].y) + (fv[j].z * fv[j].z + fv[j].w * fv[j].w); }
            const float r = 1.0f / sqrtf(wave_sum(s) * (1.f / D) + RMS_EPS);
#pragma unroll
            for (int j = 0; j < 4; ++j) { const f32x4 gg = ((const GAS f32x4*)gp + lane)[64 * j]; orow[64 * j] = hv[j] + (fv[j] * r) * gg; }
        }
    }
#undef IN
#undef BOTH
}

extern "C" void kernel_launch(void* const* d_in, const int* in_sizes, int n_in, void* d_out, int out_size, void* d_ws, size_t ws_size, hipStream_t stream) {
    static int grid = 0;
    if (grid == 0) {
        if (n_in != 21 || in_sizes[0] != M * D || out_size != M * D || ws_size < WS_END) { fprintf(stderr, "kernel_launch: unexpected shapes / workspace (n_in %d, ws %zu)\n", n_in, ws_size); grid = -1; return; }
        int dev = 0, cus = 0, per_cu = 0;
        if (hipGetDevice(&dev) != hipSuccess || hipDeviceGetAttribute(&cus, hipDeviceAttributeMultiprocessorCount, dev) != hipSuccess) { grid = -1; return; }
        if (hipFuncSetAttribute((const void*)fwd, hipFuncAttributeMaxDynamicSharedMemorySize, LDS_BYTES) != hipSuccess) { fprintf(stderr, "kernel_launch: hipFuncSetAttribute failed\n"); grid = -1; return; }
        if (hipOccupancyMaxActiveBlocksPerMultiprocessor(&per_cu, (const void*)fwd, NWAVES * 64, LDS_BYTES) != hipSuccess || per_cu < 1) { fprintf(stderr, "kernel_launch: occupancy query says %d\n", per_cu); }
        (void)hipGetLastError();
        grid = cus;
    }
    if (grid < 0) return;
    if (hipMemsetAsync((char*)d_ws + WS_CTL, 0, CTL_ZERO_BYTES, stream) != hipSuccess) return;
    Args a{};
    for (int i = 0; i < 21; ++i) a.in[i] = (const float*)d_in[i];
    a.out = (float*)d_out; a.ws = (unsigned char*)d_ws;
#if MK_PER_PHASE
    for (int p = 0; p < NPHASES; ++p) { a.ph_lo = p; a.ph_hi = p + 1; hipLaunchKernelGGL(fwd, dim3(grid), dim3(NWAVES * 64), LDS_BYTES, stream, a); }
#else
    a.ph_lo = 0; a.ph_hi = NPHASES;
    hipLaunchKernelGGL(fwd, dim3(grid), dim3(NWAVES * 64), LDS_BYTES, stream, a);
#endif
}
```

```cpp
#include <hip/hip_runtime.h>
#include <cstdio>
#include <cstdint>
#include <cmath>
namespace pg8 {
#define PG8_LAS __attribute__((address_space(3)))
typedef unsigned short bf16_t;
typedef short bf16x8 __attribute__((ext_vector_type(8)));
typedef float f32x4 __attribute__((ext_vector_type(4)));
typedef unsigned u32x4 __attribute__((ext_vector_type(4)));
constexpr int BM = 256, BK = 64, HALF = 128, HTB = HALF * BK * 2  , STAGE_BYTES = 8 * HTB, NXCD = 8, WGM = 8;

__host__ __device__ __forceinline__ int lds_byte(int r, int c) { const int st = (r >> 4) * 2 + (c >> 5), rr = r & 15, cc = c & 31, ob = rr * 64 + cc * 2; return st * 1024 + (ob ^ (((ob >> 9) & 1) << 5)); }
__host__ __device__ __forceinline__ void stage_rc(int b, int& R, int& C) { const int st = b / 1024, sb = b % 1024, swz = sb ^ (((sb >> 9) & 1) << 5); R = (st >> 1) * 16 + swz / 64; C = (st & 1) * 32 + (swz % 64) / 2; }
__host__ __device__ __forceinline__ int perm32(int rho) { const int n = rho >> 4, i = rho & 15; return 8 * (i >> 2) + 4 * n + (i & 3); }

struct Unit { int pm, pn; };
struct Gemm { const bf16_t* A; const bf16_t* Bt; int M, N, K, lda, ldb; };

struct StaticOrder {
    int nM, nN, nwg, G, c;
    __host__ __device__ void init(int M, int N, int G_, int c_) { nM = M / BM; nN = N / BM; nwg = nM * nN; G = G_; c = c_; }
    __host__ __device__ bool next(int i, Unit& u) const {
        const long L = (long)i * G + c; if (L >= nwg) return false;
        int wgid = (int)L; { const int q = nwg / NXCD, r = nwg % NXCD, xcd = wgid % NXCD, off = wgid / NXCD; wgid = (xcd < r ? xcd * (q + 1) : r * (q + 1) + (xcd - r) * q) + off; }
        const int nig = WGM * nN, gid = wgid / nig, fm = gid * WGM, gsz = (nM - fm) < WGM ? (nM - fm) : WGM;
        u.pm = fm + ((wgid % nig) % gsz); u.pn = (wgid % nig) / gsz; return true;
    }
    __device__ __forceinline__ void a_ready(const Unit&) const {}
    __device__ __forceinline__ void done(const Unit&) const {}
};

__device__ __forceinline__ unsigned cvt_pk_bf16(float lo, float hi) { unsigned r; asm volatile("v_cvt_pk_bf16_f32 %0, %1, %2" : "=v"(r) : "v"(lo), "v"(hi)); return r; }
typedef float f32x2 __attribute__((ext_vector_type(2)));
__device__ __forceinline__ f32x2 gelu_pk(f32x2 v) {
    const f32x2 av = __builtin_elementwise_abs(v), d = av * 0.2316418882f + 1.0f;
    f32x2 t; t.x = __builtin_amdgcn_rcpf(d.x); t.y = __builtin_amdgcn_rcpf(d.y);
    f32x2 q = t * 0.5307027145f + (-0.7265760135f); q = q * t + 0.7107068705f; q = q * t + (-0.142248368f); q = q * t + 0.127414796f; q = q * t;
    const f32x2 s = (v * v) * (-0.72134752044f);
    f32x2 e; e.x = __builtin_amdgcn_exp2f(s.x); e.y = __builtin_amdgcn_exp2f(s.y);
    const f32x2 m = v * (q * e), r = v - m;
    f32x2 o; o.x = v.x < 0.f ? m.x : r.x; o.y = v.y < 0.f ? m.y : r.y; return o;
}
template <int ACT  > struct EpiBf16 {
    static constexpr bool PERM = true, AFTER_DRAIN = false; static_assert(ACT == 0 || ACT == 1, "EpiBf16: ACT is 0 (none) or 1 (gelu_pk)");
    bf16_t* O; int ldc; const float* bias; int split_cols; size_t split_stride; float scale0;
    __device__ __forceinline__ void operator()(const f32x4 (&acc)[2][2][4][2], const Unit& u, int wr, int wc, int fr, int fq) const {
        const int row0 = u.pm * BM + wr * 64 + fr; int colt = u.pn * BM; bf16_t* base = O;
        float sc = 1.f; if (split_cols) { const int t = colt / split_cols; base += (size_t)t * split_stride; colt -= t * split_cols; if (t == 0) sc = scale0; }
        const int col0 = colt + wc * 32 + 8 * fq, bcol0 = u.pn * BM + wc * 32 + 8 * fq;
        f32x4 bv[2][2];
#pragma unroll
        for (int bj = 0; bj < 2; ++bj)
#pragma unroll
            for (int n = 0; n < 2; ++n) bv[bj][n] = bias ? *(const f32x4*)(bias + bcol0 + bj * HALF + 4 * n) : (f32x4){0.f, 0.f, 0.f, 0.f};
#pragma unroll
        for (int ai = 0; ai < 2; ++ai)
#pragma unroll
            for (int m = 0; m < 4; ++m) { bf16_t* rowp = base + (size_t)(row0 + ai * HALF + m * 16) * ldc + col0;
#pragma unroll
                for (int bj = 0; bj < 2; ++bj) { f32x4 v0 = acc[ai][bj][m][0] + bv[bj][0], v1 = acc[ai][bj][m][1] + bv[bj][1];
                    if (ACT == 1) { f32x2 a = gelu_pk((f32x2){v0[0], v0[1]}), b = gelu_pk((f32x2){v0[2], v0[3]}), c = gelu_pk((f32x2){v1[0], v1[1]}), d = gelu_pk((f32x2){v1[2], v1[3]});
                        v0 = (f32x4){a.x, a.y, b.x, b.y}; v1 = (f32x4){c.x, c.y, d.x, d.y}; }
                    v0 = v0 * sc; v1 = v1 * sc; u32x4 w; w.x = cvt_pk_bf16(v0[0], v0[1]); w.y = cvt_pk_bf16(v0[2], v0[3]); w.z = cvt_pk_bf16(v1[0], v1[1]); w.w = cvt_pk_bf16(v1[2], v1[3]);
                    *(u32x4*)(rowp + bj * HALF) = w; } }
    }
};
__device__ __forceinline__ float bf_lo(unsigned w) { return __builtin_bit_cast(float, w << 16); }
__device__ __forceinline__ float bf_hi(unsigned w) { return __builtin_bit_cast(float, w & 0xffff0000u); }
__device__ __forceinline__ float sigmoid_f(float x) { return __builtin_amdgcn_rcpf(1.0f + __builtin_amdgcn_exp2f(-1.4426950408889634f * x)); }
__device__ __forceinline__ u32x4 pack8(f32x4 v0, f32x4 v1) { u32x4 w; w.x = cvt_pk_bf16(v0[0], v0[1]); w.y = cvt_pk_bf16(v0[2], v0[3]); w.z = cvt_pk_bf16(v1[0], v1[1]); w.w = cvt_pk_bf16(v1[2], v1[3]); return w; }
__device__ __forceinline__ void unpack8(u32x4 w, f32x4& v0, f32x4& v1) { v0 = (f32x4){bf_lo(w.x), bf_hi(w.x), bf_lo(w.y), bf_hi(w.y)}; v1 = (f32x4){bf_lo(w.z), bf_hi(w.z), bf_lo(w.w), bf_hi(w.w)}; }

struct EpiIn {
    static constexpr bool PERM = true, AFTER_DRAIN = false;
    unsigned char* wsb; unsigned oZX, oQ, oK, oV, oSGA, oSGB; float* ksum; float qscale;
    __device__ __forceinline__ void operator()(const f32x4 (&acc)[2][2][4][2], const Unit& u, int wr, int wc, int fr, int fq) const {
        const int pn = u.pn, row0 = u.pm * BM + wr * 64 + fr;
        unsigned boff; int ldc, colt, mode;
        if (pn < 2) { boff = oZX; ldc = 0; colt = pn * 256; mode = 4; }
        else if (pn < 4) { boff = oQ; ldc = 512; colt = (pn - 2) * 256; mode = 1; }
        else if (pn < 6) { boff = oK; ldc = 512; colt = (pn - 4) * 256; mode = 3; }
        else if (pn < 8) { boff = oV; ldc = 512; colt = (pn - 6) * 256; mode = 0; }
        else if (pn < 12) { boff = oSGA; ldc = 1024; colt = (pn - 8) * 256; mode = 2; }
        else { boff = oSGB; ldc = 1024; colt = (pn - 12) * 256; mode = 2; }
        bf16_t* base = (bf16_t*)(wsb + boff); bf16_t* ZX = base;
        const int col0 = colt + wc * 32 + 8 * fq;
        const float sc = (mode == 1) ? qscale : 1.0f;
        if (mode == 4) {
#pragma unroll
            for (int ai = 0; ai < 2; ++ai)
#pragma unroll
                for (int m = 0; m < 4; ++m) { const int row = row0 + ai * HALF + m * 16, bb = row >> 12, l = row & 4095, c = l >> 4, s_ = l & 15;
#pragma unroll
                    for (int bj = 0; bj < 2; ++bj) { const int col = col0 + bj * HALF, g_ = col >> 4, h0 = col & 15;
                        *(u32x4*)(ZX + ((size_t)((g_ * 8 + bb) * 256 + c)) * 384 + s_ * 16 + h0) = pack8(acc[ai][bj][m][0], acc[ai][bj][m][1]); } }
            return;
        }
#pragma unroll
        for (int ai = 0; ai < 2; ++ai)
#pragma unroll
            for (int m = 0; m < 4; ++m) { bf16_t* rowp = base + (size_t)(row0 + ai * HALF + m * 16) * ldc + col0;
#pragma unroll
                for (int bj = 0; bj < 2; ++bj) { f32x4 v0 = acc[ai][bj][m][0], v1 = acc[ai][bj][m][1];
                    if (mode == 2) {
#pragma unroll
                        for (int j = 0; j < 4; ++j) { v0[j] = sigmoid_f(v0[j]); v1[j] = sigmoid_f(v1[j]); } }
                    else { v0 = v0 * sc; v1 = v1 * sc; }
                    *(u32x4*)(rowp + bj * HALF) = pack8(v0, v1); } }
        if (mode == 3) {
#pragma unroll
            for (int bj = 0; bj < 2; ++bj)
#pragma unroll
                for (int n = 0; n < 2; ++n) { f32x4 s = (f32x4){0.f, 0.f, 0.f, 0.f};
#pragma unroll
                    for (int ai = 0; ai < 2; ++ai)
#pragma unroll
                        for (int m = 0; m < 4; ++m) s += acc[ai][bj][m][n];
#pragma unroll
                    for (int j = 0; j < 4; ++j) { float t = s[j]; t += __shfl_xor(t, 1); t += __shfl_xor(t, 2); t += __shfl_xor(t, 4); t += __shfl_xor(t, 8);
                        if (fr == 0) atomicAdd(ksum + (size_t)u.pm * 512 + col0 + bj * HALF + 4 * n + j, t); } }
        }
    }
};
struct EpiGlu {
    static constexpr bool PERM = true, AFTER_DRAIN = false;
    const bf16_t* VS; bf16_t* YA; const float* bias;
    __device__ __forceinline__ void operator()(const f32x4 (&acc)[2][2][4][2], const Unit& u, int wr, int wc, int fr, int fq) const {
        const int row0 = u.pm * BM + wr * 64 + fr, col0 = u.pn * BM + wc * 32 + 8 * fq;
        f32x4 bv[2][2];
#pragma unroll
        for (int bj = 0; bj < 2; ++bj)
#pragma unroll
            for (int n = 0; n < 2; ++n) bv[bj][n] = *(const f32x4*)(bias + col0 + bj * HALF + 4 * n);
#pragma unroll
        for (int ai = 0; ai < 2; ++ai)
#pragma unroll
            for (int m = 0; m < 4; ++m) { const size_t off = (size_t)(row0 + ai * HALF + m * 16) * 512 + col0;
#pragma unroll
                for (int bj = 0; bj < 2; ++bj) { f32x4 v0 = acc[ai][bj][m][0] + bv[bj][0], v1 = acc[ai][bj][m][1] + bv[bj][1];
                    f32x4 a0, a1; unpack8(*(const u32x4*)(VS + off + bj * HALF), a0, a1);
#pragma unroll
                    for (int j = 0; j < 4; ++j) { v0[j] = a0[j] * sigmoid_f(v0[j]); v1[j] = a1[j] * sigmoid_f(v1[j]); }
                    *(u32x4*)(YA + off + bj * HALF) = pack8(v0, v1); } }
    }
};
template <bool ADD> struct EpiGate {
    static constexpr bool PERM = true, AFTER_DRAIN = false;
    const bf16_t* G; bf16_t* O;
    __device__ __forceinline__ void operator()(const f32x4 (&acc)[2][2][4][2], const Unit& u, int wr, int wc, int fr, int fq) const {
        const int row0 = u.pm * BM + wr * 64 + fr, col0 = u.pn * BM + wc * 32 + 8 * fq;
#pragma unroll
        for (int ai = 0; ai < 2; ++ai)
#pragma unroll
            for (int m = 0; m < 4; ++m) { const size_t off = (size_t)(row0 + ai * HALF + m * 16) * 1024 + col0;
#pragma unroll
                for (int bj = 0; bj < 2; ++bj) { f32x4 g0, g1; unpack8(*(const u32x4*)(G + off + bj * HALF), g0, g1);
                    f32x4 v0 = acc[ai][bj][m][0] * g0, v1 = acc[ai][bj][m][1] * g1;
                    if (ADD) { f32x4 p0, p1; unpack8(*(const u32x4*)(O + off + bj * HALF), p0, p1); v0 += p0; v1 += p1; }
                    *(u32x4*)(O + off + bj * HALF) = pack8(v0, v1); } }
    }
};
struct EpiRelu2 {
    static constexpr bool PERM = true, AFTER_DRAIN = false;
    bf16_t* O; int ldc;
    __device__ __forceinline__ void operator()(const f32x4 (&acc)[2][2][4][2], const Unit& u, int wr, int wc, int fr, int fq) const {
        const int row0 = u.pm * BM + wr * 64 + fr, col0 = u.pn * BM + wc * 32 + 8 * fq;
#pragma unroll
        for (int ai = 0; ai < 2; ++ai)
#pragma unroll
            for (int m = 0; m < 4; ++m) { bf16_t* rowp = O + (size_t)(row0 + ai * HALF + m * 16) * ldc + col0;
#pragma unroll
                for (int bj = 0; bj < 2; ++bj) { f32x4 v0 = acc[ai][bj][m][0], v1 = acc[ai][bj][m][1];
#pragma unroll
                    for (int j = 0; j < 4; ++j) { const float a = fmaxf(v0[j], 0.f), b = fmaxf(v1[j], 0.f); v0[j] = a * a; v1[j] = b * b; }
                    *(u32x4*)(rowp + bj * HALF) = pack8(v0, v1); } }
    }
};

struct OneUnit {
    int pm, pn;
    __device__ __forceinline__ bool next(int i, Unit& u) const { if (i) return false; u.pm = pm; u.pn = pn; return true; }
    __device__ __forceinline__ void a_ready(const Unit&) const {}
    __device__ __forceinline__ void done(const Unit&) const {}
};
struct EpiSsmState {
    static constexpr bool PERM = false, AFTER_DRAIN = true;
    bf16_t* ZXr;
    const float *a16r, *a16i, *a512r, *a512i;
    __device__ __forceinline__ void fused(f32x4 (&acc)[2][2][4][2], const Unit& u, int wr, int wc, int fr, int fq, PG8_LAS unsigned char* lds, int wid, int lane) const {
        PG8_LAS float* S = (PG8_LAS float*)lds;
        PG8_LAS float* E = (PG8_LAS float*)(lds + 132096);
        PG8_LAS float* CI = (PG8_LAS float*)(lds + 132096 + 4096);
#pragma unroll
        for (int ai = 0; ai < 2; ++ai)
#pragma unroll
            for (int m = 0; m < 4; ++m)
#pragma unroll
                for (int n = 0; n < 2; ++n) { const int row = ai * HALF + wr * 64 + m * 16 + fr, col = wc * 32 + n * 16 + 4 * fq;
                    *(PG8_LAS f32x4*)(S + row * 128 + ((col + 4 * row) & 127)) = acc[ai][0][m][n]; }
        asm volatile("s_waitcnt lgkmcnt(0)" ::: "memory"); __builtin_amdgcn_s_barrier(); asm volatile("" ::: "memory");
        const int p = lane, seg = wid;
        const float ar = a16r[p], ai_ = a16i[p];
        { float hr = 0.f, hi = 0.f;
          for (int c = seg * 32; c < seg * 32 + 32; ++c) { const int ir = c * 128 + ((p + 4 * c) & 127), ii = c * 128 + ((64 + p + 4 * c) & 127);
              const float sr = S[ir], si = S[ii]; S[ir] = hr; S[ii] = hi;
              const float nr = ar * hr - ai_ * hi + sr, ni = ar * hi + ai_ * hr + si; hr = nr; hi = ni; }
          E[seg * 128 + p] = hr; E[seg * 128 + 64 + p] = hi; }
        asm volatile("s_waitcnt lgkmcnt(0)" ::: "memory"); __builtin_amdgcn_s_barrier(); asm volatile("" ::: "memory");
        if (wid == 0) { const float br = a512r[p], bi = a512i[p]; float cr = 0.f, ci = 0.f;
#pragma unroll
            for (int sg = 0; sg < 8; ++sg) { CI[sg * 128 + p] = cr; CI[sg * 128 + 64 + p] = ci; const float er = E[sg * 128 + p], ei = E[sg * 128 + 64 + p];
                const float nr = br * cr - bi * ci + er, ni = br * ci + bi * cr + ei; cr = nr; ci = ni; } }
        asm volatile("s_waitcnt lgkmcnt(0)" ::: "memory"); __builtin_amdgcn_s_barrier(); asm volatile("" ::: "memory");
        { float wr_ = CI[seg * 128 + p], wi_ = CI[seg * 128 + 64 + p];
          for (int c = seg * 32; c < seg * 32 + 32; ++c) { const int ir = c * 128 + ((p + 4 * c) & 127), ii = c * 128 + ((64 + p + 4 * c) & 127);
              const float hr = S[ir] + wr_, hi = S[ii] + wi_;
              bf16_t* o = ZXr + (size_t)c * 384 + 256 + p;
              o[0] = (bf16_t)(cvt_pk_bf16(hr, hr) & 0xffffu); o[64] = (bf16_t)(cvt_pk_bf16(hi, hi) & 0xffffu);
              const float nr = ar * wr_ - ai_ * wi_, ni = ar * wi_ + ai_ * wr_; wr_ = nr; wi_ = ni; } }
    }
};
__device__ __forceinline__ float gelu_tanh_f(float x) {
    const float u = 0.7978845608028654f * (x + 0.044715f * x * x * x);
    const float e = __builtin_amdgcn_exp2f(-2.885390081777927f * fabsf(u));
    const float t = (1.0f - e) * __builtin_amdgcn_rcpf(1.0f + e);
    return 0.5f * x * (1.0f + (u < 0.f ? -t : t));
}
struct EpiSsmOut {
    static constexpr bool PERM = true, AFTER_DRAIN = false;
    const bf16_t* ZXr; bf16_t* VSb; const float* dsk;
    __device__ __forceinline__ void operator()(const f32x4 (&acc)[2][2][4][2], const Unit& u, int wr, int wc, int fr, int fq) const {
        const int r0 = wr * 64 + fr, c0 = wc * 32 + 8 * fq;
#pragma unroll
        for (int bj = 0; bj < 2; ++bj) { const int col = c0 + bj * HALF, t = col >> 4, h0 = col & 15;
            const f32x4 d0 = *(const f32x4*)(dsk + h0), d1 = *(const f32x4*)(dsk + h0 + 4);
#pragma unroll
            for (int ai = 0; ai < 2; ++ai)
#pragma unroll
                for (int m = 0; m < 4; ++m) { const int r = r0 + ai * HALF + m * 16;
                    f32x4 u0, u1; unpack8(*(const u32x4*)(ZXr + (size_t)r * 384 + col), u0, u1);
                    f32x4 v0 = acc[ai][bj][m][0] + d0 * u0, v1 = acc[ai][bj][m][1] + d1 * u1;
#pragma unroll
                    for (int j = 0; j < 4; ++j) { v0[j] = gelu_tanh_f(v0[j]); v1[j] = gelu_tanh_f(v1[j]); }
                    *(u32x4*)(VSb + (size_t)(r * 16 + t) * 512 + h0) = pack8(v0, v1); } }
    }
};
template <class Epi, class Sched, bool ALIGN_EPI = false, bool SP2 = false>
__device__ __forceinline__ void gemm_phase(PG8_LAS unsigned char* lds, const Gemm g, const Sched& S, const Epi& E) {
    const int tid = threadIdx.x, wid = __builtin_amdgcn_readfirstlane(tid >> 6), lane = tid & 63, wr = wid >> 2, wc = wid & 3, fr = lane & 15, fq = lane >> 4;
    const int K = g.K, nt = K / BK;
    unsigned voffA[2], voffB[2];
#pragma unroll
    for (int i = 0; i < 2; ++i) { int R, C; stage_rc(tid * 16 + i * 8192, R, C); const int Rb = Epi::PERM ? ((R & ~31) + perm32(R & 31)) : R;
        voffA[i] = (unsigned)(R * g.lda + C) * 2u; voffB[i] = (unsigned)(Rb * g.ldb + C) * 2u; }
    const size_t kstep = (size_t)(BK * 2);
    const size_t hsA = (size_t)HALF * g.lda * 2, hsB = (size_t)HALF * g.ldb * 2;
    const size_t tsA = 2 * hsA, tsB = 2 * hsB;
    const unsigned ldsw = (unsigned)wid * 1024u;
    const int aoff = lds_byte(wr * 64 + fr, fq * 8), boff = lds_byte(wc * 32 + fr, fq * 8);
#define PG8_SA(b, h) (((b) * 2 + (h)) * HTB)
#define PG8_SB(b, h) ((4 + (b) * 2 + (h)) * HTB)
#define PG8_STAGE(bufoff, gbase, voff) do { _Pragma("unroll") for (int _i = 0; _i < 2; ++_i) \
        __builtin_amdgcn_global_load_lds((const unsigned*)((const char*)(gbase) + (voff)[_i]), (PG8_LAS unsigned*)(lds + (bufoff) + ldsw + _i * 8192), 16, 0, 0); } while (0)
#define PG8_LDA(dst, b, h) do { _Pragma("unroll") for (int m = 0; m < 4; ++m) _Pragma("unroll") for (int k = 0; k < 2; ++k) dst[m][k] = *(const PG8_LAS bf16x8*)(lds + PG8_SA(b, h) + aoff + m * 2048 + k * 1024); } while (0)
#define PG8_LDB(dst, b, h) do { _Pragma("unroll") for (int n = 0; n < 2; ++n) _Pragma("unroll") for (int k = 0; k < 2; ++k) dst[n][k] = *(const PG8_LAS bf16x8*)(lds + PG8_SB(b, h) + boff + n * 2048 + k * 1024); } while (0)
#define PG8_MMA(ai, bj, At, Bt) do { __builtin_amdgcn_s_setprio(1); _Pragma("unroll") for (int m = 0; m < 4; ++m) _Pragma("unroll") for (int n = 0; n < 2; ++n) _Pragma("unroll") for (int k = 0; k < 2; ++k) \
        acc[ai][bj][m][n] = __builtin_amdgcn_mfma_f32_16x16x32_bf16(Bt[n][k], At[m][k], acc[ai][bj][m][n], 0, 0, 0); __builtin_amdgcn_s_setprio(0); } while (0)
#define PG8_WAIT_V(n) asm volatile("s_waitcnt vmcnt(" #n ")" ::: "memory")
#define PG8_WAIT_L(n) asm volatile("s_waitcnt lgkmcnt(" #n ")" ::: "memory")
#define PG8_BAR __builtin_amdgcn_s_barrier()
#define PG8_SCHED __builtin_amdgcn_sched_barrier(0)
    Unit cur, nxt; int ui = 0;
    if (!S.next(0, cur)) return;
    f32x4 acc[2][2][4][2];
#pragma unroll
    for (int a = 0; a < 2; ++a)
#pragma unroll
        for (int b = 0; b < 2; ++b)
#pragma unroll
            for (int m = 0; m < 4; ++m)
#pragma unroll
                for (int n = 0; n < 2; ++n) acc[a][b][m][n] = (f32x4){0.f, 0.f, 0.f, 0.f};
    bf16x8 At[4][2], B0[2][2], B1[2][2];
    const char* cA = (const char*)g.A + (size_t)cur.pm * tsA; const char* cB = (const char*)g.Bt + (size_t)cur.pn * tsB;
    S.a_ready(cur);
    if constexpr (SP2) {
        PG8_STAGE(PG8_SB(0, 0), cB, voffB); PG8_STAGE(PG8_SB(0, 1), cB + hsB, voffB); PG8_STAGE(PG8_SA(0, 0), cA, voffA); PG8_STAGE(PG8_SA(0, 1), cA + hsA, voffA);
        if (wr == 1) PG8_BAR;
        PG8_WAIT_V(2); PG8_BAR;
        PG8_STAGE(PG8_SB(1, 0), cB + kstep, voffB); PG8_STAGE(PG8_SA(1, 0), cA + kstep, voffA); PG8_STAGE(PG8_SB(1, 1), cB + hsB + kstep, voffB);
        PG8_WAIT_V(6); PG8_BAR;
    } else {
        PG8_STAGE(PG8_SB(0, 0), cB, voffB); PG8_STAGE(PG8_SA(0, 0), cA, voffA); PG8_STAGE(PG8_SB(0, 1), cB + hsB, voffB); PG8_STAGE(PG8_SA(0, 1), cA + hsA, voffA);
        if (wr == 1) PG8_BAR;
        PG8_WAIT_V(4); PG8_BAR;
        PG8_STAGE(PG8_SB(1, 0), cB + kstep, voffB); PG8_STAGE(PG8_SA(1, 0), cA + kstep, voffA); PG8_STAGE(PG8_SB(1, 1), cB + hsB + kstep, voffB);
        PG8_WAIT_V(6); PG8_BAR;
    }
    for (;;) {
        const bool has_next = S.next(ui + 1, nxt);
        const char* nA = has_next ? (const char*)g.A + (size_t)nxt.pm * tsA : cA; const char* nB = has_next ? (const char*)g.Bt + (size_t)nxt.pn * tsB : cB;
        for (int t = 0; t < nt; t += 2) {
            const bool last = (t == nt - 2);
            const char* a1 = cA + (size_t)(t + 1) * kstep;
            const char* a2 = last ? nA : cA + (size_t)(t + 2) * kstep; const char* b2 = last ? nB : cB + (size_t)(t + 2) * kstep;
            const char* a3 = a2 + kstep; const char* b3 = b2 + kstep;
            if (last && has_next) S.a_ready(nxt);
            if constexpr (SP2) {
            PG8_LDB(B0, 0, 0); PG8_LDB(B1, 0, 1); PG8_SCHED; PG8_LDA(At, 0, 0); PG8_STAGE(PG8_SA(1, 1), a1 + hsA, voffA);
            PG8_WAIT_V(8); PG8_WAIT_L(0); PG8_BAR; PG8_MMA(0, 0, At, B0); PG8_MMA(0, 1, At, B1); PG8_BAR; PG8_SCHED;
            PG8_LDA(At, 0, 1); PG8_STAGE(PG8_SB(0, 0), b2, voffB); PG8_STAGE(PG8_SB(0, 1), b2 + hsB, voffB); PG8_STAGE(PG8_SA(0, 0), a2, voffA);
            PG8_WAIT_V(8); PG8_WAIT_L(0); PG8_BAR; PG8_MMA(1, 0, At, B0); PG8_MMA(1, 1, At, B1); PG8_BAR; PG8_SCHED;
            PG8_LDB(B0, 1, 0); PG8_LDB(B1, 1, 1); PG8_SCHED; PG8_LDA(At, 1, 0); PG8_STAGE(PG8_SA(0, 1), a2 + hsA, voffA);
            PG8_WAIT_V(8); PG8_WAIT_L(0); PG8_BAR; PG8_MMA(0, 0, At, B0); PG8_MMA(0, 1, At, B1); PG8_BAR; PG8_SCHED;
            PG8_LDA(At, 1, 1); PG8_STAGE(PG8_SB(1, 0), b3, voffB); PG8_STAGE(PG8_SB(1, 1), b3 + hsB, voffB); PG8_STAGE(PG8_SA(1, 0), a3, voffA);
            PG8_WAIT_V(8); PG8_WAIT_L(0); PG8_BAR; PG8_MMA(1, 0, At, B0); PG8_MMA(1, 1, At, B1); PG8_BAR; PG8_SCHED;
            } else {
            PG8_LDB(B0, 0, 0); PG8_SCHED; PG8_LDA(At, 0, 0); PG8_STAGE(PG8_SA(1, 1), a1 + hsA, voffA);
            PG8_WAIT_L(8); PG8_BAR; PG8_WAIT_L(0); PG8_MMA(0, 0, At, B0); PG8_BAR; PG8_SCHED;
            PG8_LDB(B1, 0, 1); PG8_STAGE(PG8_SB(0, 0), b2, voffB);
            PG8_BAR; PG8_WAIT_L(0); PG8_MMA(0, 1, At, B1); PG8_BAR;
            PG8_LDA(At, 0, 1); PG8_STAGE(PG8_SA(0, 0), a2, voffA);
            PG8_BAR; PG8_WAIT_L(0); PG8_MMA(1, 0, At, B0); PG8_BAR; PG8_SCHED;
            PG8_STAGE(PG8_SB(0, 1), b2 + hsB, voffB);
            PG8_WAIT_V(6); PG8_BAR; PG8_MMA(1, 1, At, B1); PG8_BAR;
            PG8_LDB(B0, 1, 0); PG8_SCHED; PG8_LDA(At, 1, 0); PG8_STAGE(PG8_SA(0, 1), a2 + hsA, voffA);
            PG8_WAIT_L(8); PG8_BAR; PG8_WAIT_L(0); PG8_MMA(0, 0, At, B0); PG8_BAR; PG8_SCHED;
            PG8_LDB(B1, 1, 1); PG8_STAGE(PG8_SB(1, 0), b3, voffB);
            PG8_BAR; PG8_WAIT_L(0); PG8_MMA(0, 1, At, B1); PG8_BAR;
            PG8_LDA(At, 1, 1); PG8_STAGE(PG8_SA(1, 0), a3, voffA);
            PG8_BAR; PG8_WAIT_L(0); PG8_MMA(1, 0, At, B0); PG8_BAR; PG8_SCHED;
            PG8_STAGE(PG8_SB(1, 1), b3 + hsB, voffB);
            PG8_WAIT_V(6); PG8_BAR; PG8_MMA(1, 1, At, B1); PG8_BAR;
            }
        }
        if constexpr (ALIGN_EPI) { if (wr == 0) PG8_BAR; }
        if constexpr (!Epi::AFTER_DRAIN) { E(acc, cur, wr, wc, fr, fq); S.done(cur); }
        if (!has_next) break;
#pragma unroll
        for (int a = 0; a < 2; ++a)
#pragma unroll
            for (int b = 0; b < 2; ++b)
#pragma unroll
                for (int m = 0; m < 4; ++m)
#pragma unroll
                    for (int n = 0; n < 2; ++n) acc[a][b][m][n] = (f32x4){0.f, 0.f, 0.f, 0.f};
        cur = nxt; cA = nA; cB = nB; ++ui;
        if constexpr (ALIGN_EPI) { if (wr == 1) PG8_BAR; }
    }
    PG8_WAIT_V(0);
    if constexpr (!ALIGN_EPI) { if (wr == 0) PG8_BAR; }
    PG8_BAR;
    if constexpr (Epi::AFTER_DRAIN) { E.fused(acc, cur, wr, wc, fr, fq, lds, wid, lane); S.done(cur); }
#undef PG8_SA
#undef PG8_SB
#undef PG8_STAGE
#undef PG8_LDA
#undef PG8_LDB
#undef PG8_MMA
#undef PG8_WAIT_V
#undef PG8_WAIT_L
#undef PG8_BAR
#undef PG8_SCHED
}
}
#include <hip/hip_bf16.h>
#include <cmath>
namespace attn_body {
using bf16=__hip_bfloat16;
using bf16x8=__attribute__((ext_vector_type(8)))short;
using s16x4=__attribute__((ext_vector_type(4)))short;
using f32x16=__attribute__((ext_vector_type(16)))float;
using u32x4=__attribute__((ext_vector_type(4)))unsigned;
constexpr int BATCH=8,NHEAD=8,SEQ=4096,D=64,DM=NHEAD*D;
constexpr int NW=8,QBLK=32,QB=QBLK*NW,KVBLK=64,NQB=SEQ/QB;
constexpr int ATTN_PITCH=DM, ATTN_UNIT_ROWS=QB;
__device__ __forceinline__ int crow(int r,int hi){return (r&3)+8*(r>>2)+4*hi;}
#define SBAR() __builtin_amdgcn_sched_barrier(0)
__device__ __forceinline__ void cmask(f32x16&p0,f32x16&p1,int jb,int qrel,int hi){
  const float NEG=-INFINITY; int kb=64*jb+4*hi;
  #pragma unroll
  for(int r=0;r<16;++r){int kv=kb+(r&3)+8*(r>>2); if(kv>qrel)p0[r]=NEG; if(kv+32>qrel)p1[r]=NEG;}
}

constexpr int NSLOT=3, SLOTB=8192;
constexpr int LDS_K=0, LDS_V=NSLOT*SLOTB, LDS_WS=2*NSLOT*SLOTB, LDS_OST=LDS_WS+NW*64*4, LDS_BYTES=LDS_OST+NW*4096;
constexpr float C2=0.125f*1.4426950408889634f;
__device__ __forceinline__ void glds16s(const void*sbase,unsigned voff,unsigned lds_dst){unsigned keep;
  asm volatile("s_mov_b32 %0, m0\n\ts_mov_b32 m0, %2\n\ts_nop 0\n\tglobal_load_lds_dwordx4 %1, %3\n\ts_mov_b32 m0, %0":"=&s"(keep):"v"(voff),"s"(lds_dst),"s"(sbase):"memory");}
__device__ __forceinline__ void glds16(const void*gsrc,unsigned lds_dst){unsigned keep;
  asm volatile("s_mov_b32 %0, m0\n\ts_mov_b32 m0, %2\n\ts_nop 0\n\tglobal_load_lds_dwordx4 %1, off\n\ts_mov_b32 m0, %0":"=&s"(keep):"v"(gsrc),"s"(lds_dst):"memory");}
__device__ __forceinline__ float max3f(float a,float b,float c){float r;asm("v_max3_f32 %0, %1, %2, %3":"=v"(r):"v"(a),"v"(b),"v"(c));return r;}
__device__ __forceinline__ float max2f(float a,float b){float r;asm("v_max_f32_e32 %0, %1, %2":"=v"(r):"v"(a),"v"(b));return r;}
__device__ __forceinline__ float fadd_s(float a,float b){float r;asm("v_add_f32_e32 %0, %1, %2":"=v"(r):"v"(a),"v"(b));return r;}
__device__ __forceinline__ float fsub_s(float a,float b){float r;asm("v_sub_f32_e32 %0, %1, %2":"=v"(r):"v"(a),"v"(b));return r;}
typedef float f32x2_t __attribute__((ext_vector_type(2))); typedef float fv4_t __attribute__((ext_vector_type(4))); typedef __bf16 bf16x2_t __attribute__((ext_vector_type(2)));
__device__ __forceinline__ unsigned cvtpk_s(float lo,float hi){f32x2_t v={lo,hi};bf16x2_t b=__builtin_convertvector(v,bf16x2_t);return __builtin_bit_cast(unsigned,b);}
#define WAIT_BAR(N) asm volatile("s_waitcnt vmcnt(" #N ") lgkmcnt(0)\n\ts_barrier":::"memory")

__device__ __forceinline__ void qkt(f32x16&p0,f32x16&p1,const char*Kslot,const bf16x8*qr,const f32x16&negm,int r32,int hi){
  const char*kb=Kslot+hi*1024+r32*16;
  #pragma unroll
  for(int d0=0;d0<4;++d0){
    const bf16x8 b0=*reinterpret_cast<const bf16x8*>(kb+d0*2048);
    const bf16x8 b1=*reinterpret_cast<const bf16x8*>(kb+d0*2048+512);
    if(d0==0){p0=__builtin_amdgcn_mfma_f32_32x32x16_bf16(b0,qr[0],negm,0,0,0);p1=__builtin_amdgcn_mfma_f32_32x32x16_bf16(b1,qr[0],negm,0,0,0);}
    else{p0=__builtin_amdgcn_mfma_f32_32x32x16_bf16(b0,qr[d0],p0,0,0,0);p1=__builtin_amdgcn_mfma_f32_32x32x16_bf16(b1,qr[d0],p1,0,0,0);}}
}
typedef __attribute__((address_space(3))) const char* lds_cptr;
typedef short v4i16_t __attribute__((ext_vector_type(4)));
__device__ __forceinline__ void kload8(bf16x8*kf,lds_cptr kp){
  kf[0]=*(const __attribute__((address_space(3))) bf16x8*)(kp);      kf[1]=*(const __attribute__((address_space(3))) bf16x8*)(kp+512);
  kf[2]=*(const __attribute__((address_space(3))) bf16x8*)(kp+2048); kf[3]=*(const __attribute__((address_space(3))) bf16x8*)(kp+2560);
  kf[4]=*(const __attribute__((address_space(3))) bf16x8*)(kp+4096); kf[5]=*(const __attribute__((address_space(3))) bf16x8*)(kp+4608);
  kf[6]=*(const __attribute__((address_space(3))) bf16x8*)(kp+6144); kf[7]=*(const __attribute__((address_space(3))) bf16x8*)(kp+6656);
}
__device__ __forceinline__ void kload2(bf16x8*kf,lds_cptr kp,int j){ kf[2*j]=*(const __attribute__((address_space(3))) bf16x8*)(kp+j*2048); kf[2*j+1]=*(const __attribute__((address_space(3))) bf16x8*)(kp+j*2048+512); }
__device__ __forceinline__ s16x4 vtr(lds_cptr p){ return __builtin_bit_cast(s16x4,__builtin_amdgcn_ds_read_tr16_b64_v4i16((__attribute__((address_space(3))) v4i16_t*)p)); }
__device__ __forceinline__ float rowmax(const f32x16&p0,const f32x16&p1){
  float a=max3f(p0[0],p0[1],p1[0]),b=max3f(p0[2],p0[3],p1[1]);a=max3f(a,p1[2],p1[3]);
  #pragma unroll
  for(int r=4;r<16;r+=4){a=max3f(a,p0[r],p0[r+1]);b=max3f(b,p0[r+2],p0[r+3]);a=max3f(a,p1[r],p1[r+1]);b=max3f(b,p1[r+2],p1[r+3]);}
  const float m=max2f(a,b);
  auto rr=__builtin_amdgcn_permlane32_swap(__float_as_uint(m),__float_as_uint(m),false,false);
  return max2f(__uint_as_float(rr[0]),__uint_as_float(rr[1]));
}
__device__ __forceinline__ void pv(f32x16*o,int vb,bf16x8 pa0,bf16x8 pa1,bf16x8 pa2,bf16x8 pa3){
  #pragma unroll
  for(int d0=0;d0<2;++d0){s16x4 lo[4],hi[4];
    #pragma unroll
    for(int ks=0;ks<4;++ks){
      asm volatile("ds_read_b64_tr_b16 %0,%1 offset:%c2":"=&v"(lo[ks]):"v"(vb),"i"(d0*4096+ks*1024):"memory");
      asm volatile("ds_read_b64_tr_b16 %0,%1 offset:%c2":"=&v"(hi[ks]):"v"(vb),"i"(d0*4096+ks*1024+512):"memory");}
    asm volatile("s_waitcnt lgkmcnt(0)":::"memory");SBAR();
    #define PK(k) (bf16x8){lo[k][0],lo[k][1],lo[k][2],lo[k][3],hi[k][0],hi[k][1],hi[k][2],hi[k][3]}
    o[d0]=__builtin_amdgcn_mfma_f32_32x32x16_bf16(pa0,PK(0),o[d0],0,0,0);
    o[d0]=__builtin_amdgcn_mfma_f32_32x32x16_bf16(pa1,PK(1),o[d0],0,0,0);
    o[d0]=__builtin_amdgcn_mfma_f32_32x32x16_bf16(pa2,PK(2),o[d0],0,0,0);
    o[d0]=__builtin_amdgcn_mfma_f32_32x32x16_bf16(pa3,PK(3),o[d0],0,0,0);
    #undef PK
  }
}

#ifndef ATTN_STORE16
#define ATTN_STORE16(p,v) (*(u32x4*)(p)=(v))
#endif
template<int THRL> __device__ __forceinline__ void attn_unit(int b,int h,int qb,const bf16*Q,const bf16*__restrict__ K,const bf16*__restrict__ V,bf16*O,const float*__restrict__ ksum,char*shm){
  int tid; asm volatile("v_mov_b32 %0, %1":"=v"(tid):"v"(threadIdx.x));
  const int lane=tid&63,r32=lane&31,hi=lane>>5; const int wid=__builtin_amdgcn_readfirstlane(tid>>6);
  const long rowbase=(long)b*SEQ; const int q0=qb*QB;
  const bf16*Qw=Q+(rowbase+q0+wid*QBLK)*DM+h*D;
  const bf16*Kh=K+rowbase*DM+h*D,*Vh=V+rowbase*DM+h*D;
  const unsigned lds0=(unsigned)(uintptr_t)shm;
  float*wsf=(float*)(shm+LDS_WS)+wid*64;
  const unsigned koff=(unsigned)((lane*DM+wid*8)*2);
  const unsigned voffv=(unsigned)(((16*(wid&3)+(lane>>2))*DM+(wid>>2)*32+(lane&3)*8)*2);
  const unsigned kdst=lds0+LDS_K+wid*1024, vdst=lds0+LDS_V+wid*1024;
  #define DMA_K(t,slot) glds16s(Kh+(long)(t)*KVBLK*DM,koff,(unsigned)__builtin_amdgcn_readfirstlane(kdst+(slot)))
  #define DMA_V(t,slot) glds16s(Vh+(long)(t)*KVBLK*DM,voffv,(unsigned)__builtin_amdgcn_readfirstlane(vdst+(slot)))
  const int vb0=(int)(lds0+LDS_V)+((lane>>4)&1)*32+(lane&3)*8+(4*hi+((lane&15)>>2))*64;
  const char*Kbase=shm+LDS_K; bf16x8 kf[8];
  const lds_cptr shm3=(lds_cptr)shm; const lds_cptr kp0=shm3+LDS_K+hi*1024+r32*16; const lds_cptr vp0=shm3+LDS_V+((lane>>4)&1)*32+(lane&3)*8+(4*hi+((lane&15)>>2))*64;
  const int NT=(q0+QB)/KVBLK;
  DMA_K(0,0);DMA_V(0,0);DMA_K(1,SLOTB);
  bf16x8 qr[4];
  #pragma unroll
  for(int d0=0;d0<4;++d0)qr[d0]=*reinterpret_cast<const bf16x8*>(&Qw[(long)r32*DM+d0*16+hi*8]);
  unsigned selmask=1u<<qb;
  { float qf[32];
    #pragma unroll
    for(int d0=0;d0<4;++d0){
      #pragma unroll
      for(int i=0;i<8;++i)qf[d0*8+i]=__builtin_bit_cast(float,((unsigned)(unsigned short)qr[d0][i])<<16);}
    float g1=-INFINITY,g2=-INFINITY,g3=-INFINITY;int i1=-1,i2=-1,i3=-1;
    { const float*kbase=ksum+((long)(b*(SEQ/QB)))*DM+h*D; fv4_t kv[4];
      #pragma unroll
      for(int i=0;i<4;++i){ const int idx=i*64+lane; kv[i]=*reinterpret_cast<const fv4_t*>(kbase+(long)(idx>>4)*DM+(idx&15)*4); }
      __attribute__((address_space(3))) fv4_t*st=(__attribute__((address_space(3))) fv4_t*)((__attribute__((address_space(3))) char*)shm+LDS_OST+wid*4096);
      #pragma unroll
      for(int i=0;i<4;++i)st[i*64+lane]=kv[i];
      asm volatile("s_waitcnt lgkmcnt(0)":::"memory"); }
    const __attribute__((address_space(3))) float*kst=(const __attribute__((address_space(3))) float*)((__attribute__((address_space(3))) char*)shm+LDS_OST+wid*4096)+hi*8;
    for(int j=0;j<qb;++j){
      const __attribute__((address_space(3))) float*ks=kst+j*64; float gt=0.f;
      #pragma unroll
      for(int d0=0;d0<4;++d0){ const fv4_t k0=*reinterpret_cast<const __attribute__((address_space(3))) fv4_t*>(ks+d0*16),k1=*reinterpret_cast<const __attribute__((address_space(3))) fv4_t*>(ks+d0*16+4);
        gt+=qf[d0*8+0]*k0[0]+qf[d0*8+1]*k0[1]+qf[d0*8+2]*k0[2]+qf[d0*8+3]*k0[3]+qf[d0*8+4]*k1[0]+qf[d0*8+5]*k1[1]+qf[d0*8+6]*k1[2]+qf[d0*8+7]*k1[3];}
      gt+=__shfl_xor(gt,32);
      if(gt>g1){g3=g2;i3=i2;g2=g1;i2=i1;g1=gt;i1=j;} else if(gt>g2){g3=g2;i3=i2;g2=gt;i2=j;} else if(gt>g3){g3=gt;i3=j;}
    }
    if(i1>=0)selmask|=1u<<i1; if(i2>=0)selmask|=1u<<i2; if(i3>=0)selmask|=1u<<i3; }
  float mhat=0.f,l_reg=0.f;f32x16 o[2];o[0]=f32x16{};o[1]=f32x16{};f32x16 negm=f32x16{};asm volatile("":"+v"(negm));
  const int qrel=wid*QBLK+r32;
  #define CMASK(P0,P1,t) do{int jb_=(t)-(NT-4); if(jb_>=0)cmask(P0,P1,jb_,qrel,hi);}while(0)
  bool resc=false;
  #define START(P0,P1) do{ float rm=rowmax(P0,P1); rm=(selmask&1u)?rm:-INFINITY; resc=false; \
    { const float dl=__builtin_fmaxf(rm,-64.f); mhat=fadd_s(mhat,dl); \
      _Pragma("unroll") for(int r=0;r<16;++r){P0[r]=fsub_s(P0[r],dl);P1[r]=fsub_s(P1[r],dl);} \
      _Pragma("unroll") for(int r=0;r<16;++r)negm[r]=-mhat; asm volatile("":"+v"(negm)); } \
    _Pragma("unroll") for(int r=0;r<16;++r)P0[r]=__builtin_amdgcn_exp2f(P0[r]); }while(0)
  #define RESC() do{ if(resc){ asm volatile("s_waitcnt lgkmcnt(0)":::"memory"); \
      _Pragma("unroll") for(int d_=0;d_<2;++d_) _Pragma("unroll") for(int r=0;r<16;++r)o[d_][r]*=wsf[crow(r,hi)]; } }while(0)
  f32x16 pA0,pA1,pB0,pB1;
  int sl_prev=0,sl_cur=0,sl_next=SLOTB;
  #define ROT() do{sl_prev=sl_cur;sl_cur=sl_next;sl_next=(sl_next==(NSLOT-1)*SLOTB)?0:sl_next+SLOTB;}while(0)
  DMA_K(2,2*SLOTB);
  WAIT_BAR(3);
  qkt(pA0,pA1,Kbase,qr,negm,r32,hi);asm volatile("s_nop 15\n\ts_nop 7":"+v"(pA0),"+v"(pA1));CMASK(pA0,pA1,0);
  START(pA0,pA1);
  _Pragma("unroll") for(int r=0;r<16;++r)pA1[r]=__builtin_amdgcn_exp2f(pA1[r]);
  WAIT_BAR(0);
  DMA_K(3,0);DMA_V(1,SLOTB);
  ROT();
  kload8(kf,kp0+sl_cur);
  WAIT_BAR(2);
  s16x4 vlo[8],vhi[8]; u32x4 pw0,pw1,pw2,pw3;
  #define PKW(P,B) cvtpk_s(P[B],P[B+1])
  #define PKWM(P,B) (cvtpk_s(P[B],P[B+1])&selw_)
  #define PAF(k) __builtin_bit_cast(bf16x8,pw##k)
  #define VFR(i) (bf16x8){vlo[i][0],vlo[i][1],vlo[i][2],vlo[i][3],vhi[i][0],vhi[i][1],vhi[i][2],vhi[i][3]}
  #define PIN(x) asm volatile("":"+v"(x))
  #define MX3(a,b,c) __builtin_fmaxf(__builtin_fmaxf((a),(b)),(c))
  #define GAPA(MF,A0,A1,A2,A3,W0,W1,PW) do{ MF; sacc+=A0; sacc+=A1; sacc+=A2; sacc+=A3; PIN(sacc); W0; W1; PIN(PW); SBAR(); }while(0)
  #define EX(v) __builtin_amdgcn_exp2f(v)
  #define GAPB(MF,X,B) do{ MF; X[B]=EX(X[B]); X[B+1]=EX(X[B+1]); X[B+2]=EX(X[B+2]); X[B+3]=EX(X[B+3]); PIN(X); SBAR(); }while(0)
  #define VRD(i) do{ vlo[i]=vtr(vp_+(((i)>>2)*4096+((i)&3)*1024)); vhi[i]=vtr(vp_+(((i)>>2)*4096+((i)&3)*1024+512)); }while(0)
  #define KRD(G,j) do{ if(G){ kload2(kf,kp0+sl_next,j); SBAR(); } }while(0)
  #define STEP(C0,C1,P0,P1,t,GK,GV,GL) do{ SBAR(); const unsigned selw_=0u-((selmask>>(((t)-1)>>2))&1u); \
    const lds_cptr vp_=vp0+sl_prev; \
    VRD(0); SBAR(); float sacc=(P0[0]+P0[1]); \
    GAPA(C0=__builtin_amdgcn_mfma_f32_32x32x16_bf16(kf[0],qr[0],negm,0,0,0), P0[2],P0[3],P0[4],P0[5],     pw0[0]=PKWM(P0,0), pw0[1]=PKWM(P0,2), pw0); \
    VRD(4); SBAR(); GAPA(C1=__builtin_amdgcn_mfma_f32_32x32x16_bf16(kf[1],qr[0],negm,0,0,0), P0[6],P0[7],P0[8],P0[9],     pw0[2]=PKWM(P0,4), pw0[3]=PKWM(P0,6), pw0); \
    VRD(1); SBAR(); GAPA(C0=__builtin_amdgcn_mfma_f32_32x32x16_bf16(kf[2],qr[1],C0,0,0,0),   P0[10],P0[11],P0[12],P0[13], pw1[0]=PKWM(P0,8), pw1[1]=PKWM(P0,10), pw1); \
    VRD(5); SBAR(); GAPA(C1=__builtin_amdgcn_mfma_f32_32x32x16_bf16(kf[3],qr[1],C1,0,0,0),   P0[14],P0[15],P1[0],P1[1],   pw1[2]=PKWM(P0,12),pw1[3]=PKWM(P0,14), pw1); \
    VRD(2); SBAR(); GAPA(C0=__builtin_amdgcn_mfma_f32_32x32x16_bf16(kf[4],qr[2],C0,0,0,0),   P1[2],P1[3],P1[4],P1[5],     pw2[0]=PKWM(P1,0), pw2[1]=PKWM(P1,2), pw2); \
    VRD(6); SBAR(); GAPA(C1=__builtin_amdgcn_mfma_f32_32x32x16_bf16(kf[5],qr[2],C1,0,0,0),   P1[6],P1[7],P1[8],P1[9],     pw2[2]=PKWM(P1,4), pw2[3]=PKWM(P1,6), pw2); \
    VRD(3); SBAR(); GAPA(C0=__builtin_amdgcn_mfma_f32_32x32x16_bf16(kf[6],qr[3],C0,0,0,0),   P1[10],P1[11],P1[12],P1[13], pw3[0]=PKWM(P1,8), pw3[1]=PKWM(P1,10), pw3); \
    VRD(7); SBAR(); GAPA(C1=__builtin_amdgcn_mfma_f32_32x32x16_bf16(kf[7],qr[3],C1,0,0,0),   P1[14],P1[15],0.f,0.f,       pw3[2]=PKWM(P1,12),pw3[3]=PKWM(P1,14), pw3); \
    l_reg+=(selw_?sacc:0.f); \
    if(GK){DMA_K((t)+3,sl_cur);} if(GV){DMA_V((t)+1,sl_next);} \
    CMASK(C0,C1,t); \
    { float a=MX3(C0[0],C0[1],C1[0]),b=MX3(C0[2],C0[3],C1[1]); a=MX3(a,C1[2],C1[3]); \
      _Pragma("unroll") for(int r=4;r<16;r+=4){a=MX3(a,C0[r],C0[r+1]);b=MX3(b,C0[r+2],C0[r+3]);a=MX3(a,C1[r],C1[r+1]);b=MX3(b,C1[r+2],C1[r+3]);} \
      float rm=__builtin_fmaxf(a,b); { auto rr=__builtin_amdgcn_permlane32_swap(__float_as_uint(rm),__float_as_uint(rm),false,false); rm=__builtin_fmaxf(__uint_as_float(rr[0]),__uint_as_float(rr[1])); } \
      rm=((selmask>>((t)>>2))&1u)?rm:-INFINITY; resc=false; \
      if(__builtin_expect(__any(rm>(float)THRL),0)){ const float dl=__builtin_fmaxf(rm,0.f); mhat+=dl; \
        _Pragma("unroll") for(int r=0;r<16;++r){C0[r]-=dl;C1[r]-=dl;} \
        _Pragma("unroll") for(int r=0;r<16;++r)negm[r]=-mhat; asm volatile("":"+v"(negm)); \
        const float f=__builtin_amdgcn_exp2f(-dl); l_reg*=f; if(hi==0)wsf[r32]=f; resc=true; } } \
    SBAR(); \
    GAPB(o[0]=__builtin_amdgcn_mfma_f32_32x32x16_bf16(PAF(0),VFR(0),o[0],0,0,0), C0,0); \
    GAPB(o[1]=__builtin_amdgcn_mfma_f32_32x32x16_bf16(PAF(0),VFR(4),o[1],0,0,0), C0,4); \
    KRD(GL,0); GAPB(o[0]=__builtin_amdgcn_mfma_f32_32x32x16_bf16(PAF(1),VFR(1),o[0],0,0,0), C0,8); \
    KRD(GL,1); GAPB(o[1]=__builtin_amdgcn_mfma_f32_32x32x16_bf16(PAF(1),VFR(5),o[1],0,0,0), C0,12); \
    KRD(GL,2); GAPB(o[0]=__builtin_amdgcn_mfma_f32_32x32x16_bf16(PAF(2),VFR(2),o[0],0,0,0), C1,0); \
    KRD(GL,3); GAPB(o[1]=__builtin_amdgcn_mfma_f32_32x32x16_bf16(PAF(2),VFR(6),o[1],0,0,0), C1,4); \
    GAPB(o[0]=__builtin_amdgcn_mfma_f32_32x32x16_bf16(PAF(3),VFR(3),o[0],0,0,0), C1,8); \
    GAPB(o[1]=__builtin_amdgcn_mfma_f32_32x32x16_bf16(PAF(3),VFR(7),o[1],0,0,0), C1,12); \
    }while(0)
  int t=1;
  #undef CMASK
  #define CMASK(P0,P1,t) do{}while(0)
  for(;t+5<NT;t+=2){
    STEP(pB0,pB1,pA0,pA1,t,true,true,true);     WAIT_BAR(2); RESC(); ROT();
    STEP(pA0,pA1,pB0,pB1,t+1,true,true,true);   WAIT_BAR(2); RESC(); ROT();
  }
  #undef CMASK
  #define CMASK(P0,P1,t) do{int jb_=(t)-(NT-4); if(jb_>=0)cmask(P0,P1,jb_,qrel,hi);}while(0)
  #define ENDW(tt) do{ if((tt)+3<NT){WAIT_BAR(2);} else if((tt)+2<NT){WAIT_BAR(1);} else {WAIT_BAR(0);} }while(0)
  for(;t+1<NT;t+=2){
    STEP(pB0,pB1,pA0,pA1,t,(t+3<NT),(t+1<NT),(t+1<NT));       ENDW(t);   RESC(); ROT();
    STEP(pA0,pA1,pB0,pB1,t+1,(t+4<NT),(t+2<NT),(t+2<NT));     ENDW(t+1); RESC(); ROT();
  }
  STEP(pB0,pB1,pA0,pA1,NT-1,false,false,false); RESC();
  { float sacc=pB0[0]+pB0[1]; _Pragma("unroll") for(int r=2;r<16;++r)sacc+=pB0[r]; _Pragma("unroll") for(int r=0;r<16;++r)sacc+=pB1[r]; l_reg+=sacc;
    pw0=(u32x4){PKW(pB0,0),PKW(pB0,2),PKW(pB0,4),PKW(pB0,6)};pw1=(u32x4){PKW(pB0,8),PKW(pB0,10),PKW(pB0,12),PKW(pB0,14)};pw2=(u32x4){PKW(pB1,0),PKW(pB1,2),PKW(pB1,4),PKW(pB1,6)};pw3=(u32x4){PKW(pB1,8),PKW(pB1,10),PKW(pB1,12),PKW(pB1,14)};
    SBAR(); pv(o,vb0+sl_cur,PAF(0),PAF(1),PAF(2),PAF(3)); }
  #undef PKW
  #undef PKWM
  #undef PAF
  #undef VFR
  #undef PIN
  #undef MX3
  #undef GAPA
  #undef GAPB
  #undef EX
  #undef VRD
  #undef KRD
  #undef STEP
  #undef ENDW
  {auto rr=__builtin_amdgcn_permlane32_swap(__float_as_uint(l_reg),__float_as_uint(l_reg),false,false);l_reg=__uint_as_float(rr[0])+__uint_as_float(rr[1]);}
  if(hi==0)wsf[32+r32]=l_reg;asm volatile("s_waitcnt lgkmcnt(0)":::"memory");
  float rli[16];
  #pragma unroll
  for(int r=0;r<16;++r)rli[r]=__builtin_amdgcn_rcpf(wsf[32+crow(r,hi)]);
  bf16*Ow=O+(rowbase+q0+wid*QBLK)*DM+h*D;
  { bf16*stg=(bf16*)(shm+LDS_OST)+wid*2048;
    #pragma unroll
    for(int r=0;r<16;++r){const int orow=crow(r,hi);
      #pragma unroll
      for(int d0=0;d0<2;++d0)stg[orow*64+d0*32+r32]=__float2bfloat16(o[d0][r]*rli[r]);}
    asm volatile("s_waitcnt lgkmcnt(0)":::"memory");
    #pragma unroll
    for(int i=0;i<4;++i){const int row=i*8+(lane>>3),ch=lane&7; const u32x4 v=*(const u32x4*)(stg+row*64+ch*8); ATTN_STORE16(Ow+(long)row*DM+ch*8,v);} }
  asm volatile("s_waitcnt lgkmcnt(0)\n\ts_barrier":::"memory");
  #undef DMA_K
  #undef DMA_V
  #undef CMASK
  #undef START
  #undef RESC
  #undef ROT
}
constexpr int ATTN_LDS_BYTES=LDS_BYTES;
struct AttnTensors { const bf16* Q; const bf16* K; const bf16* V; bf16* O; const float* ksum; };
struct AttnUnit { int bh; int qb; };
struct StaticOrder {
  int vcu,G;
  __device__ __forceinline__ explicit StaticOrder(int grid,int block):vcu((grid%8==0)?(block%8)*(grid/8)+block/8:block),G(grid){}
  __device__ __forceinline__ bool next(int i,AttnUnit&u)const{ if(G!=256){ const int id=i*G+vcu; if(id>=BATCH*NHEAD*NQB)return false; u.bh=id/NQB; u.qb=NQB-1-id%NQB; return true; }
    if(i>=4)return false; const int s=vcu&3; u.bh=vcu>>2; u.qb=(i==0)?15-s:(i==1)?s:(i==2)?11-s:4+s; return true; }
  __device__ __forceinline__ void a_ready(const AttnUnit&)const{}
  __device__ __forceinline__ void done(const AttnUnit&)const{}
};
template<class Sched,int THRL=8> __device__ __forceinline__ void attn_phase(char*lds,const AttnTensors&T,const Sched&S){
  AttnUnit u;
  for(int i=0;S.next(i,u);++i){ S.a_ready(u); attn_unit<THRL>(u.bh/NHEAD,u.bh%NHEAD,u.qb,T.Q,T.K,T.V,T.O,T.ksum,lds); S.done(u); }
}
#undef SBAR
#undef WAIT_BAR
}
#define GAS __attribute__((address_space(1)))
#define LAS __attribute__((address_space(3)))
typedef unsigned short bf16;
typedef unsigned v4u __attribute__((ext_vector_type(4)));
typedef float f32x4 __attribute__((ext_vector_type(4)));
typedef short bf16x8 __attribute__((ext_vector_type(8)));
typedef GAS unsigned gu32;
typedef GAS unsigned long long gu64;
#define RLX_AGENT __ATOMIC_RELAXED, __HIP_MEMORY_SCOPE_AGENT
#define LDS_WAIT() asm volatile("s_waitcnt lgkmcnt(0)" ::: "memory")
#define VM_WAIT() asm volatile("s_waitcnt vmcnt(0)" ::: "memory")
__device__ __forceinline__ unsigned long long rt() { return __builtin_amdgcn_s_memrealtime(); }
__device__ __forceinline__ unsigned f2bf(float f) { unsigned u = __builtin_bit_cast(unsigned, f); return (u + 0x7fffu + ((u >> 16) & 1u)) >> 16; }
__device__ __forceinline__ unsigned pk2(float lo, float hi) { return f2bf(lo) | (f2bf(hi) << 16); }
#define XB_TMO      128
#define XB_XCNT(j)  (256  + 64 * (j))
#define XB_XSUB(j)  (1280 + 64 * (j))
#define XB_XGEN(j)  (2304 + 64 * (j))
#define XB_TOP      3328
#define XB_TOPGEN   3392
#define XCD_BAR_WORDS 3456
#define XB_SPIN_CAP (1u << 18)

__device__ __forceinline__ unsigned xb_ld(unsigned* p)              { return __hip_atomic_load(p, __ATOMIC_RELAXED, __HIP_MEMORY_SCOPE_AGENT); }
__device__ __forceinline__ unsigned xb_add(unsigned* p, unsigned v) { return __hip_atomic_fetch_add(p, v, __ATOMIC_RELAXED, __HIP_MEMORY_SCOPE_AGENT); }
__device__ __forceinline__ unsigned xb_xcc_id() { return (unsigned)__builtin_amdgcn_s_getreg((3 << 11) | 20) & 0xFu; }
#define XB_SPIN(cond, bar) do { unsigned _sp = 0; while (cond) { __builtin_amdgcn_s_sleep(1); \
    if ((++_sp & 255u) == 0u) { if (xb_ld(&(bar)[XB_TMO])) break; if (_sp > XB_SPIN_CAP) { atomicAdd(&(bar)[XB_TMO], 1u); break; } } } } while (0)

struct XcdBarrier {
    unsigned* bar; unsigned x;
    volatile LAS unsigned* st;
};

__device__ __forceinline__ XcdBarrier xcd_barrier_post(unsigned* bar, volatile LAS unsigned* st) {
    XcdBarrier b; b.bar = bar; b.x = xb_xcc_id(); b.st = st;
    if (threadIdx.x == 0) (void)xb_add(&bar[XB_XCNT(b.x)], 1u);
    return b;
}
__device__ __forceinline__ void xcd_barrier_complete(unsigned* bar, unsigned x, unsigned& nloc, unsigned& nx) {
    const unsigned G = gridDim.x * gridDim.y * gridDim.z;
    unsigned sum, cnt, mine, sp = 0u;
    for (;;) {
        sum = 0u; cnt = 0u; mine = 0u;
#pragma unroll
        for (unsigned j = 0; j < 16; ++j) { const unsigned c = xb_ld(&bar[XB_XCNT(j)]); sum += c; cnt += (c > 0u) ? 1u : 0u; mine = (j == x) ? c : mine; }
        if (sum == G) break;
        __builtin_amdgcn_s_sleep(1);
        if ((++sp & 255u) == 0u) { if (xb_ld(&bar[XB_TMO])) break; if (sp > XB_SPIN_CAP) { atomicAdd(&bar[XB_TMO], 1u); break; } }
    }
    nloc = mine > 0u ? mine : 1u; nx = cnt > 0u ? cnt : 1u;
}

__device__ __forceinline__ void xcd_barrier(const XcdBarrier& b) {
    asm volatile("s_waitcnt vmcnt(0)" ::: "memory");
    __syncthreads();
    if (threadIdx.x == 0) {
        unsigned* bar = b.bar;
        __builtin_amdgcn_s_waitcnt(0);
        unsigned nloc = b.st[0], nx = b.st[1];
        if (nloc == 0u) { xcd_barrier_complete(bar, b.x, nloc, nx); b.st[0] = nloc; b.st[1] = nx; }
        const unsigned old = xb_add(&bar[XB_XSUB(b.x)], 1u);
        const unsigned gen = old / nloc;
        if (old + 1u == (gen + 1u) * nloc) {
            __builtin_amdgcn_fence(__ATOMIC_RELEASE, "agent");
            asm volatile("s_waitcnt vmcnt(0)" ::: "memory");
            const unsigned og = xb_add(&bar[XB_TOP], 1u);
            const unsigned tg = og / nx;
            if (og + 1u == (tg + 1u) * nx) xb_add(&bar[XB_TOPGEN], 1u);
            else XB_SPIN(xb_ld(&bar[XB_TOPGEN]) == tg, bar);
            __builtin_amdgcn_fence(__ATOMIC_ACQUIRE, "agent");
            xb_add(&bar[XB_XGEN(b.x)], 1u);
            asm volatile("s_waitcnt vmcnt(0)" ::: "memory");
        } else {
            XB_SPIN(xb_ld(&bar[XB_XGEN(b.x)]) == gen, bar);
            __builtin_amdgcn_fence(__ATOMIC_ACQUIRE, "agent");
            asm volatile("s_waitcnt vmcnt(0)" ::: "memory");
        }
    }
    __syncthreads();
}
__device__ __forceinline__ float wave_sum(float v) {
#pragma unroll
    for (int o = 1; o < 64; o <<= 1) v += __shfl_xor(v, o);
    return v;
}
__device__ __forceinline__ void p0_transpose_item(const float* W, int K, int N, bf16* WT, int row_off, LAS float* scr, int item, int lane) {
    const int nblk = N / 32, kb = item / nblk, nb = item % nblk, k0 = 64 * kb, n0 = 32 * nb;
    float tv[32];
#pragma unroll
    for (int i = 0; i < 32; ++i) { const int kk = 2 * i + (lane >> 5); tv[i] = W[(size_t)(k0 + kk) * N + n0 + (lane & 31)]; }
#pragma unroll
    for (int i = 0; i < 32; ++i) { const int kk = 2 * i + (lane >> 5); scr[kk * 33 + (lane & 31)] = tv[i]; }
    LDS_WAIT(); asm volatile("" ::: "memory");
    const int c = lane & 7;
#pragma unroll
    for (int j = 0; j < 4; ++j) { const int n = (lane >> 3) + 8 * j; const LAS float* s = scr + (8 * c) * 33 + n;
        v4u o; o.x = pk2(s[0 * 33], s[1 * 33]); o.y = pk2(s[2 * 33], s[3 * 33]); o.z = pk2(s[4 * 33], s[5 * 33]); o.w = pk2(s[6 * 33], s[7 * 33]);
        *(GAS v4u*)(WT + (size_t)(row_off + n0 + n) * K + k0 + 8 * c) = o; }
    LDS_WAIT(); asm volatile("" ::: "memory");
}
constexpr int NWAVES = 8;
#ifndef MK_PER_PHASE
#define MK_PER_PHASE 0
#endif
constexpr int NPHASES = 12;

constexpr int BATCH = 8, SEQ = 4096, D = 1024, M = BATCH * SEQ, NIN = 4096, SW = 512, AW = 512;
constexpr int NG = 32, GH = 16, NP = 64, NH = 8, HD = 64, FF = 4096, NBLK = 16, BLK = 256;
constexpr float RMS_EPS = 1e-6f;
constexpr float C2 = 0.125f * 1.4426950408889634f;

constexpr size_t MiB = 1u << 20;
constexpr size_t WS_CTL = 0, CTL_ZERO_BYTES = 1 * MiB;
constexpr size_t WS_KSUM = 512 * 1024;
constexpr size_t WS_TAB = 1 * MiB;
constexpr size_t WS_WIN = 2 * MiB, WS_WGLU = 10 * MiB, WS_WA = 11 * MiB, WS_WB = 12 * MiB, WS_WO = 13 * MiB, WS_W1 = 15 * MiB, WS_W2 = 23 * MiB;
constexpr size_t WS_U = 32 * MiB;
constexpr size_t WS_ZX = 96 * MiB;
constexpr size_t WS_Q = 144 * MiB, WS_K = 176 * MiB, WS_V = 208 * MiB;
constexpr size_t WS_SGA = 240 * MiB, WS_SGB = 304 * MiB;
constexpr size_t WS_VS = 368 * MiB, WS_YA = 400 * MiB;
constexpr size_t WS_MG = 432 * MiB;
constexpr size_t WS_MIX = 368 * MiB;
constexpr size_t WS_HM = 96 * MiB;
constexpr size_t WS_WS = 496 * MiB, WS_KG = 500 * MiB, WS_KM = 506 * MiB;
constexpr size_t WS_END = 507 * MiB;
constexpr int CW_TMO = 0, CW_CODE = 1, CW_BAR = 4096;

constexpr int RING_OFF = 0, RING_BYTES = 131072;
constexpr int LDSCTL_OFF = RING_BYTES, MISC_OFF = LDSCTL_OFF + 320;
constexpr int LDS_BYTES = 147456;

constexpr int TB_ABR = 0, TB_ABI = 2048, TB_BBR = 4096, TB_BBI = 4096 + 32768, TB_A16R = 4096 + 65536, TB_A16I = TB_A16R + 2048, TB_A512R = TB_A16I + 2048, TB_A512I = TB_A512R + 2048;
#ifndef SKEW_TICKS
#define SKEW_TICKS 0
#endif
#ifndef SSM_NAIVE
#define SSM_NAIVE 0
#endif

__device__ __forceinline__ float bf2f(bf16 v) { return __builtin_bit_cast(float, (unsigned)v << 16); }
__device__ __forceinline__ float gelu_tanh(float x) {
    const float u = 0.7978845608028654f * (x + 0.044715f * x * x * x);
    const float e = __builtin_amdgcn_exp2f(-2.0f * 1.4426950408889634f * fabsf(u));
    const float t = (1.0f - e) * __builtin_amdgcn_rcpf(1.0f + e);
    return 0.5f * x * (1.0f + (u < 0.f ? -t : t));
}

__device__ __forceinline__ void cpowk(double lr, double li, double dt, double k, double& re, double& im) { const double mg = exp(k * lr * dt), an = k * li * dt; re = mg * cos(an); im = mg * sin(an); }
__device__ __forceinline__ void zoh_coef(double lr, double li, double dt, double& cr, double& ci) { double ar, ai; cpowk(lr, li, dt, 1.0, ar, ai); const double nr = ar - 1.0, ni = ai, den = lr * lr + li * li; cr = (nr * lr + ni * li) / den; ci = (ni * lr - nr * li) / den; }
__device__ __forceinline__ float reduce16(const float (&v)[16], int lane) {
    float a8[8], a4[4], a2[2], a1;
    { const bool up = (lane & 32) != 0;
#pragma unroll
      for (int j = 0; j < 8; ++j) { const float send = up ? v[j] : v[j + 8]; const float keep = up ? v[j + 8] : v[j]; a8[j] = keep + __shfl_xor(send, 32); } }
    { const bool up = (lane & 16) != 0;
#pragma unroll
      for (int j = 0; j < 4; ++j) { const float send = up ? a8[j] : a8[j + 4]; const float keep = up ? a8[j + 4] : a8[j]; a4[j] = keep + __shfl_xor(send, 16); } }
    { const bool up = (lane & 8) != 0;
#pragma unroll
      for (int j = 0; j < 2; ++j) { const float send = up ? a4[j] : a4[j + 2]; const float keep = up ? a4[j + 2] : a4[j]; a2[j] = keep + __shfl_xor(send, 8); } }
    { const bool up = (lane & 4) != 0; const float send = up ? a2[0] : a2[1]; const float keep = up ? a2[1] : a2[0]; a1 = keep + __shfl_xor(send, 4); }
    a1 += __shfl_xor(a1, 2); a1 += __shfl_xor(a1, 1);
    return a1;
}
#define PH_PTRS GAS unsigned char* wsg_ = (GAS unsigned char*)args.ws; asm volatile("" : "+s"(wsg_)); unsigned char* wsl = (unsigned char*)wsg_;   \
    bf16 *Win_t = (bf16*)(wsl + WS_WIN), *Wglu_t = (bf16*)(wsl + WS_WGLU), *Wa_t = (bf16*)(wsl + WS_WA), *Wb_t = (bf16*)(wsl + WS_WB), *Wo_t = (bf16*)(wsl + WS_WO), *W1_t = (bf16*)(wsl + WS_W1), *W2_t = (bf16*)(wsl + WS_W2); \
    bf16 *U = (bf16*)(wsl + WS_U), *ZX = (bf16*)(wsl + WS_ZX), *Qb = (bf16*)(wsl + WS_Q), *Kb = (bf16*)(wsl + WS_K), *Vb = (bf16*)(wsl + WS_V), *SGA = (bf16*)(wsl + WS_SGA), *SGB = (bf16*)(wsl + WS_SGB); \
    bf16 *VS = (bf16*)(wsl + WS_VS), *YA = (bf16*)(wsl + WS_YA), *MG = (bf16*)(wsl + WS_MG), *MIX = (bf16*)(wsl + WS_MIX), *HM = (bf16*)(wsl + WS_HM); \
    float* ksum = (float*)(wsl + WS_KSUM); float* tab = (float*)(wsl + WS_TAB); bf16 *WsT = (bf16*)(wsl + WS_WS), *KG = (bf16*)(wsl + WS_KG); float* KM = (float*)(wsl + WS_KM); \
    const float* x = args.in[0]; float* out = args.out; \
    (void)Win_t; (void)Wglu_t; (void)Wa_t; (void)Wb_t; (void)Wo_t; (void)W1_t; (void)W2_t; (void)U; (void)ZX; (void)Qb; (void)Kb; (void)Vb; (void)SGA; (void)SGB; (void)VS; (void)YA; (void)MG; (void)MIX; (void)HM; (void)ksum; (void)tab; (void)WsT; (void)KG; (void)KM; (void)x; (void)out
struct Args { const float* in[21]; float* out; unsigned char* ws; int ph_lo, ph_hi, li, pad; };

template <int R> __device__ __forceinline__ void rms_rows_to_bf16(const float* x0, size_t rstride, const f32x4 (&gg)[4], bf16* o0, int lane) {
    f32x4 v[R][4];
#pragma unroll
    for (int r = 0; r < R; ++r) { const GAS f32x4* xr = (const GAS f32x4*)(x0 + r * rstride) + lane;
#pragma unroll
        for (int j = 0; j < 4; ++j) v[r][j] = xr[64 * j]; }
#pragma unroll
    for (int r = 0; r < R; ++r) { float s = 0.f;
#pragma unroll
        for (int j = 0; j < 4; ++j) s += (v[r][j].x * v[r][j].x + v[r][j].y * v[r][j].y) + (v[r][j].z * v[r][j].z + v[r][j].w * v[r][j].w);
        const float rs = 1.0f / sqrtf(wave_sum(s) * (1.f / D) + RMS_EPS);
        GAS unsigned long long* o8 = (GAS unsigned long long*)(o0 + r * rstride) + lane;
#pragma unroll
        for (int j = 0; j < 4; ++j) o8[64 * j] = (unsigned long long)pk2(v[r][j].x * rs * gg[j].x, v[r][j].y * rs * gg[j].y) | ((unsigned long long)pk2(v[r][j].z * rs * gg[j].z, v[r][j].w * rs * gg[j].w) << 32); }
}
__device__ __forceinline__ f32x4 bf4(unsigned long long w) { const unsigned w0 = (unsigned)w, w1 = (unsigned)(w >> 32); return (f32x4){pg8::bf_lo(w0), pg8::bf_hi(w0), pg8::bf_lo(w1), pg8::bf_hi(w1)}; }
__device__ __forceinline__ unsigned long long pk4(f32x4 v) { return (unsigned long long)pk2(v.x, v.y) | ((unsigned long long)pk2(v.z, v.w) << 32); }
__device__ __forceinline__ float sq4(f32x4 v) { return (v.x * v.x + v.y * v.y) + (v.z * v.z + v.w * v.w); }

__global__ void __launch_bounds__(NWAVES * 64, 2) fwd(Args args) {
    extern __shared__ __attribute__((aligned(16))) unsigned char lds[];
    LAS unsigned char* L = (LAS unsigned char*)lds;
    volatile LAS unsigned* MISC = (volatile LAS unsigned*)(L + MISC_OFF);
    const int tid = threadIdx.x, lane = tid & 63, wave = __builtin_amdgcn_readfirstlane(tid >> 6);
    const int G = gridDim.x; const int bx = blockIdx.x; const int vcu = (G % 8 == 0) ? (bx % 8) * (G / 8) + bx / 8 : bx;
    unsigned char* ws = args.ws;
    gu32* ctl = (gu32*)(ws + WS_CTL);
    const int gtid = vcu * (NWAVES * 64) + tid, NTHR = G * NWAVES * 64;
    for (int u = tid; u < (LDS_BYTES - LDSCTL_OFF) / 4; u += NWAVES * 64) ((LAS unsigned*)(L + LDSCTL_OFF))[u] = 0u;
    __syncthreads();
    XcdBarrier bar; bar.bar = (unsigned*)(ctl + CW_BAR) + args.li * XCD_BAR_WORDS; bar.x = 0; bar.st = nullptr;
    if (!MK_PER_PHASE) bar = xcd_barrier_post((unsigned*)(ctl + CW_BAR) + args.li * XCD_BAR_WORDS, MISC + 8);
#define GRID_BAR() do { if (MK_PER_PHASE) { if (tid == 0) __hip_atomic_store(ctl + CW_TMO, 0xBADBA0u, RLX_AGENT); } else { xcd_barrier(bar); } } while (0)
    const int lo = args.ph_lo, hi = args.ph_hi;
#define IN(k) (lo <= (k) && (k) < hi)
#define SKEW() do { if (SKEW_TICKS) { const unsigned long long t0_ = rt(), w_ = (unsigned long long)(((bx >> 3) & 3) * SKEW_TICKS); while (rt() - t0_ < w_) __builtin_amdgcn_s_sleep(8); } } while (0)
#define BOTH(k) (IN(k) && IN((k) + 1))
    const int gw = vcu * NWAVES + wave, NGW = G * NWAVES;

    if (IN(0)) { PH_PTRS;
        LAS float* scr = (LAS float*)(L + RING_OFF + wave * 16384);
        constexpr int I_IN = (D / 64) * (NIN / 32), I_GLU = (SW / 64) * (SW / 32), I_A = (SW / 64) * (D / 32), I_O = (D / 64) * (D / 32), I_1 = (D / 64) * (FF / 32), I_2 = (FF / 64) * (D / 32);
        constexpr int NITEMS = I_IN + I_GLU + 2 * I_A + I_O + I_1 + I_2;
        for (int it = gw; it < NITEMS; it += NGW) {
            int r = it;
            if (r < I_IN) { p0_transpose_item(args.in[2], D, NIN, Win_t, 0, scr, r, lane); continue; } r -= I_IN;
            if (r < I_GLU) { p0_transpose_item(args.in[11], SW, SW, Wglu_t, 0, scr, r, lane); continue; } r -= I_GLU;
            if (r < I_A) { p0_transpose_item(args.in[13], SW, D, Wa_t, 0, scr, r, lane); continue; } r -= I_A;
            if (r < I_A) { p0_transpose_item(args.in[14], AW, D, Wb_t, 0, scr, r, lane); continue; } r -= I_A;
            if (r < I_O) { p0_transpose_item(args.in[15], D, D, Wo_t, 0, scr, r, lane); continue; } r -= I_O;
            if (r < I_1) { p0_transpose_item(args.in[18], D, FF, W1_t, 0, scr, r, lane); continue; } r -= I_1;
            p0_transpose_item(args.in[19], FF, D, W2_t, 0, scr, r, lane);
        }
        { f32x4 gg[4];
#pragma unroll
          for (int j = 0; j < 4; ++j) gg[j] = ((const GAS f32x4*)args.in[1] + lane)[64 * j];
          for (int m = gw; m < M; m += 2 * NGW) rms_rows_to_bf16<2>(x + (size_t)m * D, (size_t)NGW * D, gg, U + (size_t)m * D, lane); }
        const float *lam_re = args.in[3], *lam_im = args.in[4], *log_dt = args.in[5], *b_re = args.in[6], *b_im = args.in[7], *c_re = args.in[8], *c_im = args.in[9];
        if ((gtid & 63) == 1 && (gtid >> 6) < NG * NP) { const int gp = gtid >> 6, g = gp / NP;
            const double lr = (double)lam_re[gp], li = (double)lam_im[gp], dt = exp((double)log_dt[g]);
            double ar, ai, cr, ci; cpowk(lr, li, dt, 1.0, ar, ai); zoh_coef(lr, li, dt, cr, ci);
            tab[TB_ABR + gp] = (float)ar; tab[TB_ABI + gp] = (float)ai;
            cpowk(lr, li, dt, 16.0, ar, ai); tab[TB_A16R + gp] = (float)ar; tab[TB_A16I + gp] = (float)ai;
            cpowk(lr, li, dt, 512.0, ar, ai); tab[TB_A512R + gp] = (float)ar; tab[TB_A512I + gp] = (float)ai;
            for (int h = 0; h < GH; ++h) { const double br = (double)b_re[gp * GH + h], bi = (double)b_im[gp * GH + h];
                tab[TB_BBR + gp * GH + h] = (float)(cr * br - ci * bi); tab[TB_BBI + gp * GH + h] = (float)(cr * bi + ci * br); } }
        for (int e = gtid >> 2; (gtid & 3) == 2 && e < NG * NP * 16; e += NTHR >> 2) {
            const int p = e % NP, s_ = (e / NP) % 16, g = e / (NP * 16), gp = g * NP + p;
            const double lr = (double)lam_re[gp], li = (double)lam_im[gp], dt = exp((double)log_dt[g]);
            double wr_, wi_, cr, ci; cpowk(lr, li, dt, (double)(15 - s_), wr_, wi_); zoh_coef(lr, li, dt, cr, ci);
            float vr[GH], vi[GH];
#pragma unroll
            for (int h = 0; h < GH; ++h) { const double br = (double)b_re[gp * GH + h], bi = (double)b_im[gp * GH + h], Br = cr * br - ci * bi, Bi = cr * bi + ci * br;
                vr[h] = (float)(wr_ * Br - wi_ * Bi); vi[h] = (float)(wr_ * Bi + wi_ * Br); }
            GAS v4u* o_r = (GAS v4u*)(WsT + ((size_t)(g * 256 + p)) * 256 + s_ * 16); GAS v4u* o_i = (GAS v4u*)(WsT + ((size_t)(g * 256 + 64 + p)) * 256 + s_ * 16);
            o_r[0] = (v4u){pk2(vr[0], vr[1]), pk2(vr[2], vr[3]), pk2(vr[4], vr[5]), pk2(vr[6], vr[7])}; o_r[1] = (v4u){pk2(vr[8], vr[9]), pk2(vr[10], vr[11]), pk2(vr[12], vr[13]), pk2(vr[14], vr[15])};
            o_i[0] = (v4u){pk2(vi[0], vi[1]), pk2(vi[2], vi[3]), pk2(vi[4], vi[5]), pk2(vi[6], vi[7])}; o_i[1] = (v4u){pk2(vi[8], vi[9]), pk2(vi[10], vi[11]), pk2(vi[12], vi[13]), pk2(vi[14], vi[15])}; }
        for (int e = gtid; e < NG * 4096; e += NTHR) {
            const int g = e / 4096, r = e % 4096; ((GAS v4u*)(WsT + ((size_t)(g * 256 + 128)) * 256))[r] = (v4u){0u, 0u, 0u, 0u}; }
        for (int e = gtid >> 2; (gtid & 3) == 3 && e < NG * NP * 16; e += NTHR >> 2) {
            const int p = e % NP, t = (e / NP) % 16, g = e / (NP * 16), gp = g * NP + p;
            const double lr = (double)lam_re[gp], li = (double)lam_im[gp], dt = exp((double)log_dt[g]);
            double wr_, wi_; cpowk(lr, li, dt, (double)(t + 1), wr_, wi_);
            for (int h = 0; h < GH; ++h) { const double cr = (double)c_re[(g * GH + h) * NP + p], ci = (double)c_im[(g * GH + h) * NP + p];
                bf16* o = KG + ((size_t)(g * 256 + t * 16 + h)) * 384 + 256 + p;
                o[0] = (bf16)f2bf((float)(cr * wr_ - ci * wi_)); o[64] = (bf16)f2bf((float)(-(cr * wi_ + ci * wr_))); } }
        for (int wt = gw >> 2; (gw & 3) == 0 && wt < NG * 16; wt += NGW >> 2) {
            const int g = wt / 16, j = wt % 16, p = lane, gp = g * NP + p;
            const double lr = (double)lam_re[gp], li = (double)lam_im[gp], dt = exp((double)log_dt[g]);
            double wr_, wi_, cr, ci; cpowk(lr, li, dt, (double)j, wr_, wi_); zoh_coef(lr, li, dt, cr, ci);
            float Br[GH], Bi[GH];
#pragma unroll
            for (int h = 0; h < GH; ++h) { const double br = (double)b_re[gp * GH + h], bi = (double)b_im[gp * GH + h]; Br[h] = (float)(cr * br - ci * bi); Bi[h] = (float)(cr * bi + ci * br); }
            for (int hp = 0; hp < GH; ++hp) { const double c1 = (double)c_re[(g * GH + hp) * NP + p], c2 = (double)c_im[(g * GH + hp) * NP + p];
                const float cwr = (float)(c1 * wr_ - c2 * wi_), cwi = (float)(c1 * wi_ + c2 * wr_);
                float v[GH];
#pragma unroll
                for (int h = 0; h < GH; ++h) v[h] = cwr * Br[h] - cwi * Bi[h];
                const float tot = reduce16(v, lane);
                if ((lane & 3) == 0) KM[((g * 16 + j) * 16 + hp) * 16 + (lane >> 2)] = tot; } }
        if (BOTH(0)) GRID_BAR();
    }

    if (IN(1)) { PH_PTRS;
        for (int e = gtid; e < NG * 256 * 32; e += NTHR) {
            const int kc = e % 32, n = (e / 32) % 256, g_ = e / (32 * 256), s_ = kc >> 1, h0 = (kc & 1) * 8, t = n >> 4, hp = n & 15;
            v4u w = (v4u){0u, 0u, 0u, 0u};
            if (s_ <= t) { const float* k8 = KM + ((g_ * 16 + (t - s_)) * 16 + hp) * 16 + h0; w = (v4u){pk2(k8[0], k8[1]), pk2(k8[2], k8[3]), pk2(k8[4], k8[5]), pk2(k8[6], k8[7])}; }
            *(GAS v4u*)(KG + ((size_t)(g_ * 256 + n)) * 384 + kc * 8) = w; }
        SKEW();
        pg8::Gemm g{U, Win_t, M, NIN, D, D, D}; pg8::StaticOrder S; S.init(M, NIN, G, bx);
        pg8::EpiIn E{wsl, (unsigned)WS_ZX, (unsigned)WS_Q, (unsigned)WS_K, (unsigned)WS_V, (unsigned)WS_SGA, (unsigned)WS_SGB, ksum, C2};
        pg8::gemm_phase<pg8::EpiIn, pg8::StaticOrder, true, true>(L + RING_OFF, g, S, E);
        if (BOTH(1)) GRID_BAR();
    }

    if (IN(2)) { PH_PTRS;
#if SSM_NAIVE
        if (wave == 0) {
            for (int item = vcu; item < BATCH * NG; item += G) {
                const int b = item / NG, g = item % NG, p = lane;
                const float abr = tab[TB_ABR + g * NP + p], abi = tab[TB_ABI + g * NP + p];
                float bbr[GH], bbi[GH], cr[GH], ci[GH];
#pragma unroll
                for (int h = 0; h < GH; ++h) { bbr[h] = tab[TB_BBR + (g * NP + p) * GH + h]; bbi[h] = tab[TB_BBI + (g * NP + p) * GH + h];
                    cr[h] = args.in[8][(g * GH + h) * NP + p]; ci[h] = args.in[9][(g * GH + h) * NP + p]; }
                const int hme = lane >> 2;
                const float dsk = args.in[10][g * GH + hme];
                float xr = 0.f, xi = 0.f;
                const bf16* zrow = ZX + (size_t)((g * 8 + b) * 256) * 384;
                bf16* vrow = VS + (size_t)b * SEQ * SW + g * GH;
                for (int t = 0; t < SEQ; ++t) {
                    const v4u w0 = *(const GAS v4u*)(zrow + (size_t)(t >> 4) * 384 + (t & 15) * 16), w1 = *(const GAS v4u*)(zrow + (size_t)(t >> 4) * 384 + (t & 15) * 16 + 8);
                    float uu[GH];
                    uu[0] = pg8::bf_lo(w0.x); uu[1] = pg8::bf_hi(w0.x); uu[2] = pg8::bf_lo(w0.y); uu[3] = pg8::bf_hi(w0.y); uu[4] = pg8::bf_lo(w0.z); uu[5] = pg8::bf_hi(w0.z); uu[6] = pg8::bf_lo(w0.w); uu[7] = pg8::bf_hi(w0.w);
                    uu[8] = pg8::bf_lo(w1.x); uu[9] = pg8::bf_hi(w1.x); uu[10] = pg8::bf_lo(w1.y); uu[11] = pg8::bf_hi(w1.y); uu[12] = pg8::bf_lo(w1.z); uu[13] = pg8::bf_hi(w1.z); uu[14] = pg8::bf_lo(w1.w); uu[15] = pg8::bf_hi(w1.w);
                    float bur = 0.f, bui = 0.f;
#pragma unroll
                    for (int h = 0; h < GH; ++h) { bur += bbr[h] * uu[h]; bui += bbi[h] * uu[h]; }
                    const float nxr = abr * xr - abi * xi + bur, nxi = abr * xi + abi * xr + bui; xr = nxr; xi = nxi;
                    float v[GH];
#pragma unroll
                    for (int h = 0; h < GH; ++h) v[h] = cr[h] * xr - ci[h] * xi;
                    const float a1 = reduce16(v, lane);
                    float um = uu[0];
#pragma unroll
                    for (int h = 1; h < GH; ++h) um = (hme == h) ? uu[h] : um;
                    const float y = a1 + dsk * um;
                    if ((lane & 3) == 0) vrow[(size_t)t * SW + hme] = (bf16)f2bf(gelu_tanh(y));
                }
            }
        }
#else
        if (vcu < NG * BATCH) { const int item = vcu;
            const int g_ = item >> 3, b_ = item & 7;
            { pg8::Gemm gm{ZX, WsT + (size_t)g_ * 256 * 256, NG * BATCH * 256, 256, 256, 384, 256}; pg8::OneUnit S{item, 0};
              pg8::EpiSsmState E{ZX + (size_t)item * 256 * 384, tab + TB_A16R + g_ * NP, tab + TB_A16I + g_ * NP, tab + TB_A512R + g_ * NP, tab + TB_A512I + g_ * NP};
              pg8::gemm_phase<pg8::EpiSsmState, pg8::OneUnit, false, true>(L + RING_OFF, gm, S, E); }
            VM_WAIT(); __syncthreads();
            { pg8::Gemm gm{ZX, KG + (size_t)g_ * 256 * 384, NG * BATCH * 256, 256, 384, 384, 384}; pg8::OneUnit S{item, 0};
              pg8::EpiSsmOut E{ZX + (size_t)item * 256 * 384, VS + (size_t)b_ * SEQ * SW + g_ * GH, args.in[10] + g_ * GH};
              pg8::gemm_phase<pg8::EpiSsmOut, pg8::OneUnit, true, true>(L + RING_OFF, gm, S, E); }
            __syncthreads();
        }
#endif
    }
    if (IN(3)) { PH_PTRS;
        { const attn_body::AttnTensors AT{(const attn_body::bf16*)Qb, (const attn_body::bf16*)Kb, (const attn_body::bf16*)Vb, (attn_body::bf16*)U, ksum};
          const attn_body::StaticOrder S(G, bx);
          attn_body::attn_phase<attn_body::StaticOrder>((char*)lds + RING_OFF, AT, S); }
        if (BOTH(3)) GRID_BAR();
    }

    if (IN(4)) { PH_PTRS;
        pg8::Gemm g{VS, Wglu_t, M, SW, SW, SW, SW}; pg8::StaticOrder S; S.init(M, SW, G, bx);
        pg8::EpiGlu E{VS, YA, args.in[12]};
        pg8::gemm_phase<pg8::EpiGlu, pg8::StaticOrder, true, true>(L + RING_OFF, g, S, E);
        if (BOTH(4)) GRID_BAR();
    }
    if (IN(5)) { PH_PTRS;
        pg8::Gemm g{YA, Wa_t, M, D, SW, SW, SW}; pg8::StaticOrder S; S.init(M, D, G, bx);
        pg8::EpiGate<false> E{SGA, MG};
        pg8::gemm_phase<pg8::EpiGate<false>, pg8::StaticOrder, true, true>(L + RING_OFF, g, S, E);
    }
    if (IN(6)) { PH_PTRS;
        pg8::Gemm g{U, Wb_t, M, D, AW, AW, AW}; pg8::StaticOrder S; S.init(M, D, G, bx);
        pg8::EpiGate<true> E{SGB, MG};
        pg8::gemm_phase<pg8::EpiGate<true>, pg8::StaticOrder, true, true>(L + RING_OFF, g, S, E);
        if (BOTH(6)) GRID_BAR();
    }
    if (IN(7)) { PH_PTRS;
        pg8::Gemm g{MG, Wo_t, M, D, D, D, D}; pg8::StaticOrder S; S.init(M, D, G, bx);
        pg8::EpiBf16<0> E{MIX, D, nullptr, 0, 0, 1.f};
        pg8::gemm_phase<pg8::EpiBf16<0>, pg8::StaticOrder, true, true>(L + RING_OFF, g, S, E);
        if (BOTH(7)) GRID_BAR();
    }
    if (IN(8)) { PH_PTRS;
        f32x4 gpost[4], gpre[4];
#pragma unroll
        for (int j = 0; j < 4; ++j) { gpost[j] = ((const GAS f32x4*)args.in[16] + lane)[64 * j]; gpre[j] = ((const GAS f32x4*)args.in[17] + lane)[64 * j]; }
        bf16* H1 = MG;
        for (int m0 = gw; m0 < M; m0 += 2 * NGW) {
            f32x4 xv[2][4], mv[2][4];
#pragma unroll
            for (int r = 0; r < 2; ++r) { const size_t m = (size_t)m0 + (size_t)r * NGW; const GAS f32x4* xr = (const GAS f32x4*)(x + m * D) + lane; const GAS unsigned long long* mr = (const GAS unsigned long long*)(MIX + m * D) + lane;
#pragma unroll
                for (int j = 0; j < 4; ++j) { xv[r][j] = xr[64 * j]; mv[r][j] = bf4(mr[64 * j]); } }
#pragma unroll
            for (int r = 0; r < 2; ++r) { const size_t m = (size_t)m0 + (size_t)r * NGW; float s = 0.f;
#pragma unroll
                for (int j = 0; j < 4; ++j) s += sq4(mv[r][j]);
                const float rs = 1.0f / sqrtf(wave_sum(s) * (1.f / D) + RMS_EPS); float s2 = 0.f;
                GAS unsigned long long* h8 = (GAS unsigned long long*)(H1 + m * D) + lane;
#pragma unroll
                for (int j = 0; j < 4; ++j) { xv[r][j] = xv[r][j] + (mv[r][j] * rs) * gpost[j]; h8[64 * j] = pk4(xv[r][j]); s2 += sq4(xv[r][j]); }
                const float r2 = 1.0f / sqrtf(wave_sum(s2) * (1.f / D) + RMS_EPS);
                GAS unsigned long long* o8 = (GAS unsigned long long*)(U + m * D) + lane;
#pragma unroll
                for (int j = 0; j < 4; ++j) o8[64 * j] = pk4(xv[r][j] * r2 * gpre[j]); }
        }
        if (BOTH(8)) GRID_BAR();
    }
    if (IN(9)) { PH_PTRS;
        SKEW();
        pg8::Gemm g{U, W1_t, M, FF, D, D, D}; pg8::StaticOrder S; S.init(M, FF, G, bx);
        pg8::EpiRelu2 E{HM, FF};
        pg8::gemm_phase<pg8::EpiRelu2, pg8::StaticOrder, true, true>(L + RING_OFF, g, S, E);
        if (BOTH(9)) GRID_BAR();
    }
    if (IN(10)) { PH_PTRS;
        pg8::Gemm g{HM, W2_t, M, D, FF, FF, FF}; pg8::StaticOrder S; S.init(M, D, G, bx);
        pg8::EpiBf16<0> E{U, D, nullptr, 0, 0, 1.f};
        pg8::gemm_phase<pg8::EpiBf16<0>, pg8::StaticOrder, true, true>(L + RING_OFF, g, S, E);
        if (BOTH(10)) GRID_BAR();
    }
    if (IN(11)) { PH_PTRS;
        f32x4 gp[4];
#pragma unroll
        for (int j = 0; j < 4; ++j) gp[j] = ((const GAS f32x4*)args.in[20] + lane)[64 * j];
        const bf16* H1 = MG;
        for (int m0 = gw; m0 < M; m0 += 2 * NGW) {
            f32x4 hv[2][4], fv[2][4];
#pragma unroll
            for (int r = 0; r < 2; ++r) { const size_t m = (size_t)m0 + (size_t)r * NGW; const GAS unsigned long long* hr = (const GAS unsigned long long*)(H1 + m * D) + lane; const GAS unsigned long long* fr = (const GAS unsigned long long*)(U + m * D) + lane;
#pragma unroll
                for (int j = 0; j < 4; ++j) { hv[r][j] = bf4(hr[64 * j]); fv[r][j] = bf4(fr[64 * j]); } }
#pragma unroll
            for (int r = 0; r < 2; ++r) { const size_t m = (size_t)m0 + (size_t)r * NGW; float s = 0.f;
#pragma unroll
                for (int j = 0; j < 4; ++j) s += sq4(fv[r][j]);
                const float rs = 1.0f / sqrtf(wave_sum(s) * (1.f / D) + RMS_EPS);
                GAS f32x4* orow = (GAS f32x4*)(out + m * D) + lane;
#pragma unroll
                for (int j = 0; j < 4; ++j) orow[64 * j] = hv[r][j] + (fv[r][j] * rs) * gp[j]; }
        }
    }
#undef IN
#undef BOTH
}

extern "C" void kernel_launch(void* const* d_in, const int* in_sizes, int n_in, void* d_out, int out_size, void* d_ws, size_t ws_size, hipStream_t stream) {
    static int grid = 0;
    if (grid == 0) {
        if (n_in != 21 || in_sizes[0] != M * D || out_size != M * D || ws_size < WS_END) { fprintf(stderr, "kernel_launch: unexpected shapes / workspace (n_in %d, ws %zu)\n", n_in, ws_size); grid = -1; return; }
        int dev = 0, cus = 0, per_cu = 0;
        if (hipGetDevice(&dev) != hipSuccess || hipDeviceGetAttribute(&cus, hipDeviceAttributeMultiprocessorCount, dev) != hipSuccess) { grid = -1; return; }
        if (hipFuncSetAttribute((const void*)fwd, hipFuncAttributeMaxDynamicSharedMemorySize, LDS_BYTES) != hipSuccess) { fprintf(stderr, "kernel_launch: hipFuncSetAttribute failed\n"); grid = -1; return; }
        if (hipOccupancyMaxActiveBlocksPerMultiprocessor(&per_cu, (const void*)fwd, NWAVES * 64, LDS_BYTES) != hipSuccess || per_cu < 1) { fprintf(stderr, "kernel_launch: occupancy query says %d\n", per_cu); }
        (void)hipGetLastError();
        grid = cus;
    }
    if (grid < 0) return;
    if (hipMemsetAsync((char*)d_ws + WS_CTL, 0, CTL_ZERO_BYTES, stream) != hipSuccess) return;
    Args a{};
    for (int i = 0; i < 21; ++i) a.in[i] = (const float*)d_in[i];
    a.out = (float*)d_out; a.ws = (unsigned char*)d_ws;
#ifndef PROBE
#define PROBE 0
#endif
#if MK_PER_PHASE
    for (int p = 0; p < NPHASES; ++p) { a.ph_lo = p; a.ph_hi = p + 1; a.li = 0; hipLaunchKernelGGL(fwd, dim3(grid), dim3(NWAVES * 64), LDS_BYTES, stream, a); }
#else
#if PROBE == 0
    static const int seq[][2] = {{0, NPHASES}};
#elif PROBE == 1
    static const int seq[][2] = {{0, 3}, {2, NPHASES}};
#elif PROBE == 2
    static const int seq[][2] = {{0, 4}, {3, NPHASES}};
#elif PROBE == 3
    static const int seq[][2] = {{0, 1}, {0, NPHASES}};
#elif PROBE == 4
    static const int seq[][2] = {{0, 9}, {8, NPHASES}};
#elif PROBE == 5
    static const int seq[][2] = {{0, 7}, {4, NPHASES}};
#elif PROBE == 6
    static const int seq[][2] = {{0, 8}, {7, NPHASES}};
#endif
    for (int li = 0; li < (int)(sizeof(seq) / sizeof(seq[0])); ++li) { a.ph_lo = seq[li][0]; a.ph_hi = seq[li][1]; a.li = li; hipLaunchKernelGGL(fwd, dim3(grid), dim3(NWAVES * 64), LDS_BYTES, stream, a); }
#endif
}
```

```cpp
#include <hip/hip_runtime.h>
#include <cstdio>
#include <cstdint>
#include <cmath>
namespace pg8 {
#define PG8_LAS __attribute__((address_space(3)))
typedef unsigned short bf16_t;
typedef short bf16x8 __attribute__((ext_vector_type(8)));
typedef float f32x4 __attribute__((ext_vector_type(4)));
typedef unsigned u32x4 __attribute__((ext_vector_type(4)));
constexpr int BM = 256, BK = 64, HALF = 128, HTB = HALF * BK * 2  , STAGE_BYTES = 8 * HTB, NXCD = 8, WGM = 8;

__host__ __device__ __forceinline__ int lds_byte(int r, int c) { const int st = (r >> 4) * 2 + (c >> 5), rr = r & 15, cc = c & 31, ob = rr * 64 + cc * 2; return st * 1024 + (ob ^ (((ob >> 9) & 1) << 5)); }
__host__ __device__ __forceinline__ void stage_rc(int b, int& R, int& C) { const int st = b / 1024, sb = b % 1024, swz = sb ^ (((sb >> 9) & 1) << 5); R = (st >> 1) * 16 + swz / 64; C = (st & 1) * 32 + (swz % 64) / 2; }
__host__ __device__ __forceinline__ int perm32(int rho) { const int n = rho >> 4, i = rho & 15; return 8 * (i >> 2) + 4 * n + (i & 3); }

#ifndef PG8_STORE_SC1
#define PG8_STORE_SC1 0
#endif
#if PG8_STORE_SC1
#define PG8_ST16(p, v) do { const u32x4 v_ = (v); asm volatile("global_store_dwordx4 %0, %1, off sc1" :: "v"(p), "v"(v_) : "memory"); } while (0)
#else
#define PG8_ST16(p, v) (*(u32x4*)(p) = (v))
#endif
#ifndef PG8_STORE_NT
#define PG8_STORE_NT 0
#endif
#if PG8_STORE_NT
#define PG8_ST16NT(p, v) __builtin_nontemporal_store((v), (u32x4*)(p))
#else
#define PG8_ST16NT(p, v) PG8_ST16(p, v)
#endif
struct Unit { int pm, pn; };
struct Gemm { const bf16_t* A; const bf16_t* Bt; int M, N, K, lda, ldb; int ksa = 0, tsa = 0; };

struct StaticOrder {
    int nM, nN, nwg, G, c;
    __host__ __device__ void init(int M, int N, int G_, int c_) { nM = M / BM; nN = N / BM; nwg = nM * nN; G = G_; c = c_; }
    __host__ __device__ bool next(int i, Unit& u) const {
        const long L = (long)i * G + c; if (L >= nwg) return false;
        int wgid = (int)L; { const int q = nwg / NXCD, r = nwg % NXCD, xcd = wgid % NXCD, off = wgid / NXCD; wgid = (xcd < r ? xcd * (q + 1) : r * (q + 1) + (xcd - r) * q) + off; }
        const int nig = WGM * nN, gid = wgid / nig, fm = gid * WGM, gsz = (nM - fm) < WGM ? (nM - fm) : WGM;
        u.pm = fm + ((wgid % nig) % gsz); u.pn = (wgid % nig) / gsz; return true;
    }
    __device__ __forceinline__ void a_ready(const Unit&) const {}
    __device__ __forceinline__ void done(const Unit&) const {}
};

__device__ __forceinline__ unsigned cvt_pk_bf16(float lo, float hi) { unsigned r; asm volatile("v_cvt_pk_bf16_f32 %0, %1, %2" : "=v"(r) : "v"(lo), "v"(hi)); return r; }
typedef float f32x2 __attribute__((ext_vector_type(2)));
__device__ __forceinline__ f32x2 gelu_pk(f32x2 v) {
    const f32x2 av = __builtin_elementwise_abs(v), d = av * 0.2316418882f + 1.0f;
    f32x2 t; t.x = __builtin_amdgcn_rcpf(d.x); t.y = __builtin_amdgcn_rcpf(d.y);
    f32x2 q = t * 0.5307027145f + (-0.7265760135f); q = q * t + 0.7107068705f; q = q * t + (-0.142248368f); q = q * t + 0.127414796f; q = q * t;
    const f32x2 s = (v * v) * (-0.72134752044f);
    f32x2 e; e.x = __builtin_amdgcn_exp2f(s.x); e.y = __builtin_amdgcn_exp2f(s.y);
    const f32x2 m = v * (q * e), r = v - m;
    f32x2 o; o.x = v.x < 0.f ? m.x : r.x; o.y = v.y < 0.f ? m.y : r.y; return o;
}
template <int ACT  > struct EpiBf16 {
    static constexpr bool PERM = true, AFTER_DRAIN = false; static_assert(ACT == 0 || ACT == 1, "EpiBf16: ACT is 0 (none) or 1 (gelu_pk)");
    bf16_t* O; int ldc; const float* bias; int split_cols; size_t split_stride; float scale0;
    __device__ __forceinline__ void operator()(const f32x4 (&acc)[2][2][4][2], const Unit& u, int wr, int wc, int fr, int fq) const {
        const int row0 = u.pm * BM + wr * 64 + fr; int colt = u.pn * BM; bf16_t* base = O;
        float sc = 1.f; if (split_cols) { const int t = colt / split_cols; base += (size_t)t * split_stride; colt -= t * split_cols; if (t == 0) sc = scale0; }
        const int col0 = colt + wc * 32 + 8 * fq, bcol0 = u.pn * BM + wc * 32 + 8 * fq;
        f32x4 bv[2][2];
#pragma unroll
        for (int bj = 0; bj < 2; ++bj)
#pragma unroll
            for (int n = 0; n < 2; ++n) bv[bj][n] = bias ? *(const f32x4*)(bias + bcol0 + bj * HALF + 4 * n) : (f32x4){0.f, 0.f, 0.f, 0.f};
#pragma unroll
        for (int ai = 0; ai < 2; ++ai)
#pragma unroll
            for (int m = 0; m < 4; ++m) { bf16_t* rowp = base + (size_t)(row0 + ai * HALF + m * 16) * ldc + col0;
#pragma unroll
                for (int bj = 0; bj < 2; ++bj) { f32x4 v0 = acc[ai][bj][m][0] + bv[bj][0], v1 = acc[ai][bj][m][1] + bv[bj][1];
                    if (ACT == 1) { f32x2 a = gelu_pk((f32x2){v0[0], v0[1]}), b = gelu_pk((f32x2){v0[2], v0[3]}), c = gelu_pk((f32x2){v1[0], v1[1]}), d = gelu_pk((f32x2){v1[2], v1[3]});
                        v0 = (f32x4){a.x, a.y, b.x, b.y}; v1 = (f32x4){c.x, c.y, d.x, d.y}; }
                    v0 = v0 * sc; v1 = v1 * sc; u32x4 w; w.x = cvt_pk_bf16(v0[0], v0[1]); w.y = cvt_pk_bf16(v0[2], v0[3]); w.z = cvt_pk_bf16(v1[0], v1[1]); w.w = cvt_pk_bf16(v1[2], v1[3]);
                    PG8_ST16(rowp + bj * HALF, w); } }
    }
};
__device__ __forceinline__ float bf_lo(unsigned w) { return __builtin_bit_cast(float, w << 16); }
__device__ __forceinline__ float bf_hi(unsigned w) { return __builtin_bit_cast(float, w & 0xffff0000u); }
__device__ __forceinline__ float sigmoid_f(float x) { return __builtin_amdgcn_rcpf(1.0f + __builtin_amdgcn_exp2f(-1.4426950408889634f * x)); }
__device__ __forceinline__ u32x4 pack8(f32x4 v0, f32x4 v1) { u32x4 w; w.x = cvt_pk_bf16(v0[0], v0[1]); w.y = cvt_pk_bf16(v0[2], v0[3]); w.z = cvt_pk_bf16(v1[0], v1[1]); w.w = cvt_pk_bf16(v1[2], v1[3]); return w; }
__device__ __forceinline__ void unpack8(u32x4 w, f32x4& v0, f32x4& v1) { v0 = (f32x4){bf_lo(w.x), bf_hi(w.x), bf_lo(w.y), bf_hi(w.y)}; v1 = (f32x4){bf_lo(w.z), bf_hi(w.z), bf_lo(w.w), bf_hi(w.w)}; }

struct EpiIn {
    static constexpr bool PERM = true, AFTER_DRAIN = false;
    unsigned char* wsb; unsigned oZX, oQ, oK, oV, oSGA, oSGB; float* ksum; float qscale;
    __device__ __forceinline__ void operator()(const f32x4 (&acc)[2][2][4][2], const Unit& u, int wr, int wc, int fr, int fq) const {
        const int pn = u.pn, row0 = u.pm * BM + wr * 64 + fr;
        unsigned boff; int ldc, colt, mode;
        if (pn < 2) { boff = oZX; ldc = 0; colt = pn * 256; mode = 4; }
        else if (pn < 4) { boff = oQ; ldc = 512; colt = (pn - 2) * 256; mode = 1; }
        else if (pn < 6) { boff = oK; ldc = 512; colt = (pn - 4) * 256; mode = 3; }
        else if (pn < 8) { boff = oV; ldc = 512; colt = (pn - 6) * 256; mode = 0; }
        else if (pn < 12) { boff = oSGA; ldc = 1024; colt = (pn - 8) * 256; mode = 2; }
        else { boff = oSGB; ldc = 1024; colt = (pn - 12) * 256; mode = 2; }
        bf16_t* base = (bf16_t*)(wsb + boff); bf16_t* ZX = base;
        const int col0 = colt + wc * 32 + 8 * fq;
        const float sc = (mode == 1) ? qscale : 1.0f;
        if (mode == 4) {
#pragma unroll
            for (int ai = 0; ai < 2; ++ai)
#pragma unroll
                for (int m = 0; m < 4; ++m) { const int row = row0 + ai * HALF + m * 16, bb = row >> 12, l = row & 4095, c = l >> 4, s_ = l & 15;
#pragma unroll
                    for (int bj = 0; bj < 2; ++bj) { const int col = col0 + bj * HALF, g_ = col >> 4, h0 = col & 15;
                        PG8_ST16(ZX + ((size_t)((g_ * 8 + bb) * 256 + c)) * 384 + s_ * 16 + h0, pack8(acc[ai][bj][m][0], acc[ai][bj][m][1])); } }
            return;
        }
#pragma unroll
        for (int ai = 0; ai < 2; ++ai)
#pragma unroll
            for (int m = 0; m < 4; ++m) { bf16_t* rowp = base + (size_t)(row0 + ai * HALF + m * 16) * ldc + col0;
#pragma unroll
                for (int bj = 0; bj < 2; ++bj) { f32x4 v0 = acc[ai][bj][m][0], v1 = acc[ai][bj][m][1];
                    if (mode == 2) {
#pragma unroll
                        for (int j = 0; j < 4; ++j) { v0[j] = sigmoid_f(v0[j]); v1[j] = sigmoid_f(v1[j]); } }
                    else { v0 = v0 * sc; v1 = v1 * sc; }
                    PG8_ST16NT(rowp + bj * HALF, pack8(v0, v1)); } }
        if (mode == 3) {
#pragma unroll
            for (int bj = 0; bj < 2; ++bj)
#pragma unroll
                for (int n = 0; n < 2; ++n) { f32x4 s = (f32x4){0.f, 0.f, 0.f, 0.f};
#pragma unroll
                    for (int ai = 0; ai < 2; ++ai)
#pragma unroll
                        for (int m = 0; m < 4; ++m) s += acc[ai][bj][m][n];
#pragma unroll
                    for (int j = 0; j < 4; ++j) { float t = s[j]; t += __shfl_xor(t, 1); t += __shfl_xor(t, 2); t += __shfl_xor(t, 4); t += __shfl_xor(t, 8);
                        if (fr == 0) atomicAdd(ksum + (size_t)u.pm * 512 + col0 + bj * HALF + 4 * n + j, t); } }
        }
    }
};
struct EpiGlu {
    static constexpr bool PERM = true, AFTER_DRAIN = false;
    const bf16_t* VS; bf16_t* YA; const float* bias;
    __device__ __forceinline__ void operator()(const f32x4 (&acc)[2][2][4][2], const Unit& u, int wr, int wc, int fr, int fq) const {
        const int row0 = u.pm * BM + wr * 64 + fr, col0 = u.pn * BM + wc * 32 + 8 * fq;
        f32x4 bv[2][2];
#pragma unroll
        for (int bj = 0; bj < 2; ++bj)
#pragma unroll
            for (int n = 0; n < 2; ++n) bv[bj][n] = *(const f32x4*)(bias + col0 + bj * HALF + 4 * n);
#pragma unroll
        for (int ai = 0; ai < 2; ++ai)
#pragma unroll
            for (int m = 0; m < 4; ++m) { const size_t off = (size_t)(row0 + ai * HALF + m * 16) * 512 + col0;
#pragma unroll
                for (int bj = 0; bj < 2; ++bj) { f32x4 v0 = acc[ai][bj][m][0] + bv[bj][0], v1 = acc[ai][bj][m][1] + bv[bj][1];
                    f32x4 a0, a1; unpack8(*(const u32x4*)(VS + off + bj * HALF), a0, a1);
#pragma unroll
                    for (int j = 0; j < 4; ++j) { v0[j] = a0[j] * sigmoid_f(v0[j]); v1[j] = a1[j] * sigmoid_f(v1[j]); }
                    PG8_ST16(YA + off + bj * HALF, pack8(v0, v1)); } }
    }
};
template <bool ADD> struct EpiGate {
    static constexpr bool PERM = true, AFTER_DRAIN = false;
    const bf16_t* G; bf16_t* O;
    __device__ __forceinline__ void operator()(const f32x4 (&acc)[2][2][4][2], const Unit& u, int wr, int wc, int fr, int fq) const {
        const int row0 = u.pm * BM + wr * 64 + fr, col0 = u.pn * BM + wc * 32 + 8 * fq;
#pragma unroll
        for (int ai = 0; ai < 2; ++ai)
#pragma unroll
            for (int m = 0; m < 4; ++m) { const size_t off = (size_t)(row0 + ai * HALF + m * 16) * 1024 + col0;
#pragma unroll
                for (int bj = 0; bj < 2; ++bj) { f32x4 g0, g1; unpack8(*(const u32x4*)(G + off + bj * HALF), g0, g1);
                    f32x4 v0 = acc[ai][bj][m][0] * g0, v1 = acc[ai][bj][m][1] * g1;
                    if (ADD) { f32x4 p0, p1; unpack8(*(const u32x4*)(O + off + bj * HALF), p0, p1); v0 += p0; v1 += p1; }
                    PG8_ST16(O + off + bj * HALF, pack8(v0, v1)); } }
    }
};
struct EpiRelu2 {
    static constexpr bool PERM = true, AFTER_DRAIN = false;
    bf16_t* O; int ldc;
    __device__ __forceinline__ void operator()(const f32x4 (&acc)[2][2][4][2], const Unit& u, int wr, int wc, int fr, int fq) const {
        const int row0 = u.pm * BM + wr * 64 + fr, col0 = u.pn * BM + wc * 32 + 8 * fq;
#pragma unroll
        for (int ai = 0; ai < 2; ++ai)
#pragma unroll
            for (int m = 0; m < 4; ++m) { bf16_t* rowp = O + (size_t)(row0 + ai * HALF + m * 16) * ldc + col0;
#pragma unroll
                for (int bj = 0; bj < 2; ++bj) { f32x4 v0 = acc[ai][bj][m][0], v1 = acc[ai][bj][m][1];
#pragma unroll
                    for (int j = 0; j < 4; ++j) { const float a = fmaxf(v0[j], 0.f), b = fmaxf(v1[j], 0.f); v0[j] = a * a; v1[j] = b * b; }
                    PG8_ST16NT(rowp + bj * HALF, pack8(v0, v1)); } }
    }
};

struct EpiRelu2T {
    static constexpr bool PERM = true, AFTER_DRAIN = false;
    bf16_t* O; int ktiles;
    __device__ __forceinline__ void operator()(const f32x4 (&acc)[2][2][4][2], const Unit& u, int wr, int wc, int fr, int fq) const {
        bf16_t* base = O + ((size_t)u.pm * ktiles + (size_t)u.pn * 4 + (wc >> 1)) * (256 * 64) + (size_t)(wr * 64 + fr) * 64 + (wc & 1) * 32 + 8 * fq;
#pragma unroll
        for (int ai = 0; ai < 2; ++ai)
#pragma unroll
            for (int m = 0; m < 4; ++m)
#pragma unroll
                for (int bj = 0; bj < 2; ++bj) { f32x4 v0 = acc[ai][bj][m][0], v1 = acc[ai][bj][m][1];
#pragma unroll
                    for (int j = 0; j < 4; ++j) { const float a = fmaxf(v0[j], 0.f), b = fmaxf(v1[j], 0.f); v0[j] = a * a; v1[j] = b * b; }
                    PG8_ST16(base + (size_t)bj * 2 * (256 * 64) + (size_t)(ai * HALF + m * 16) * 64, pack8(v0, v1)); }
    }
};
struct OneUnit {
    int pm, pn;
    __device__ __forceinline__ bool next(int i, Unit& u) const { if (i) return false; u.pm = pm; u.pn = pn; return true; }
    __device__ __forceinline__ void a_ready(const Unit&) const {}
    __device__ __forceinline__ void done(const Unit&) const {}
};
struct EpiSsmState {
    static constexpr bool PERM = false, AFTER_DRAIN = true;
    bf16_t* ZXr;
    const float *a16r, *a16i, *a512r, *a512i;
    __device__ __forceinline__ void fused(f32x4 (&acc)[2][2][4][2], const Unit& u, int wr, int wc, int fr, int fq, PG8_LAS unsigned char* lds, int wid, int lane) const {
        PG8_LAS float* S = (PG8_LAS float*)lds;
        PG8_LAS float* E = (PG8_LAS float*)(lds + 132096);
        PG8_LAS float* CI = (PG8_LAS float*)(lds + 132096 + 4096);
#pragma unroll
        for (int ai = 0; ai < 2; ++ai)
#pragma unroll
            for (int m = 0; m < 4; ++m)
#pragma unroll
                for (int n = 0; n < 2; ++n) { const int row = ai * HALF + wr * 64 + m * 16 + fr, col = wc * 32 + n * 16 + 4 * fq;
                    *(PG8_LAS f32x4*)(S + row * 128 + ((col + 4 * row) & 127)) = acc[ai][0][m][n]; }
        asm volatile("s_waitcnt lgkmcnt(0)" ::: "memory"); __builtin_amdgcn_s_barrier(); asm volatile("" ::: "memory");
        const int p = lane, seg = wid;
        const float ar = a16r[p], ai_ = a16i[p];
        { float hr = 0.f, hi = 0.f;
          for (int c = seg * 32; c < seg * 32 + 32; ++c) { const int ir = c * 128 + ((p + 4 * c) & 127), ii = c * 128 + ((64 + p + 4 * c) & 127);
              const float sr = S[ir], si = S[ii]; S[ir] = hr; S[ii] = hi;
              const float nr = ar * hr - ai_ * hi + sr, ni = ar * hi + ai_ * hr + si; hr = nr; hi = ni; }
          E[seg * 128 + p] = hr; E[seg * 128 + 64 + p] = hi; }
        asm volatile("s_waitcnt lgkmcnt(0)" ::: "memory"); __builtin_amdgcn_s_barrier(); asm volatile("" ::: "memory");
        if (wid == 0) { const float br = a512r[p], bi = a512i[p]; float cr = 0.f, ci = 0.f;
#pragma unroll
            for (int sg = 0; sg < 8; ++sg) { CI[sg * 128 + p] = cr; CI[sg * 128 + 64 + p] = ci; const float er = E[sg * 128 + p], ei = E[sg * 128 + 64 + p];
                const float nr = br * cr - bi * ci + er, ni = br * ci + bi * cr + ei; cr = nr; ci = ni; } }
        asm volatile("s_waitcnt lgkmcnt(0)" ::: "memory"); __builtin_amdgcn_s_barrier(); asm volatile("" ::: "memory");
        { float wr_ = CI[seg * 128 + p], wi_ = CI[seg * 128 + 64 + p];
          for (int c = seg * 32; c < seg * 32 + 32; ++c) { const int ir = c * 128 + ((p + 4 * c) & 127), ii = c * 128 + ((64 + p + 4 * c) & 127);
              const float hr = S[ir] + wr_, hi = S[ii] + wi_;
              bf16_t* o = ZXr + (size_t)c * 384 + 256 + p;
              o[0] = (bf16_t)(cvt_pk_bf16(hr, hr) & 0xffffu); o[64] = (bf16_t)(cvt_pk_bf16(hi, hi) & 0xffffu);
              const float nr = ar * wr_ - ai_ * wi_, ni = ar * wi_ + ai_ * wr_; wr_ = nr; wi_ = ni; } }
    }
};
__device__ __forceinline__ float gelu_tanh_f(float x) {
    const float u = 0.7978845608028654f * (x + 0.044715f * x * x * x);
    const float e = __builtin_amdgcn_exp2f(-2.885390081777927f * fabsf(u));
    const float t = (1.0f - e) * __builtin_amdgcn_rcpf(1.0f + e);
    return 0.5f * x * (1.0f + (u < 0.f ? -t : t));
}
struct EpiSsmOut {
    static constexpr bool PERM = true, AFTER_DRAIN = false;
    const bf16_t* ZXr; bf16_t* VSb; const float* dsk;
    __device__ __forceinline__ void operator()(const f32x4 (&acc)[2][2][4][2], const Unit& u, int wr, int wc, int fr, int fq) const {
        const int r0 = wr * 64 + fr, c0 = wc * 32 + 8 * fq;
#pragma unroll
        for (int bj = 0; bj < 2; ++bj) { const int col = c0 + bj * HALF, t = col >> 4, h0 = col & 15;
            const f32x4 d0 = *(const f32x4*)(dsk + h0), d1 = *(const f32x4*)(dsk + h0 + 4);
#pragma unroll
            for (int ai = 0; ai < 2; ++ai)
#pragma unroll
                for (int m = 0; m < 4; ++m) { const int r = r0 + ai * HALF + m * 16;
                    f32x4 u0, u1; unpack8(*(const u32x4*)(ZXr + (size_t)r * 384 + col), u0, u1);
                    f32x4 v0 = acc[ai][bj][m][0] + d0 * u0, v1 = acc[ai][bj][m][1] + d1 * u1;
#pragma unroll
                    for (int j = 0; j < 4; ++j) { v0[j] = gelu_tanh_f(v0[j]); v1[j] = gelu_tanh_f(v1[j]); }
                    PG8_ST16(VSb + (size_t)(r * 16 + t) * 512 + h0, pack8(v0, v1)); } }
    }
};
template <class Epi, class Sched, bool ALIGN_EPI = false, bool SP2 = false>
__device__ __forceinline__ void gemm_phase(PG8_LAS unsigned char* lds, const Gemm g, const Sched& S, const Epi& E) {
    const int tid = threadIdx.x, wid = __builtin_amdgcn_readfirstlane(tid >> 6), lane = tid & 63, wr = wid >> 2, wc = wid & 3, fr = lane & 15, fq = lane >> 4;
    const int K = g.K, nt = K / BK;
    unsigned voffA[2], voffB[2];
#pragma unroll
    for (int i = 0; i < 2; ++i) { int R, C; stage_rc(tid * 16 + i * 8192, R, C); const int Rb = Epi::PERM ? ((R & ~31) + perm32(R & 31)) : R;
        voffA[i] = (unsigned)(R * g.lda + C) * 2u; voffB[i] = (unsigned)(Rb * g.ldb + C) * 2u; }
    const size_t ksA = g.ksa ? (size_t)g.ksa : (size_t)(BK * 2), ksB = (size_t)(BK * 2);
    const size_t hsA = (size_t)HALF * g.lda * 2, hsB = (size_t)HALF * g.ldb * 2;
    const size_t tsA = g.tsa ? (size_t)g.tsa : 2 * hsA, tsB = 2 * hsB;
    const unsigned ldsw = (unsigned)wid * 1024u;
    const int aoff = lds_byte(wr * 64 + fr, fq * 8), boff = lds_byte(wc * 32 + fr, fq * 8);
#define PG8_SA(b, h) (((b) * 2 + (h)) * HTB)
#define PG8_SB(b, h) ((4 + (b) * 2 + (h)) * HTB)
#define PG8_STAGE(bufoff, gbase, voff) do { _Pragma("unroll") for (int _i = 0; _i < 2; ++_i) \
        __builtin_amdgcn_global_load_lds((const unsigned*)((const char*)(gbase) + (voff)[_i]), (PG8_LAS unsigned*)(lds + (bufoff) + ldsw + _i * 8192), 16, 0, 0); } while (0)
#define PG8_LDA(dst, b, h) do { _Pragma("unroll") for (int m = 0; m < 4; ++m) _Pragma("unroll") for (int k = 0; k < 2; ++k) dst[m][k] = *(const PG8_LAS bf16x8*)(lds + PG8_SA(b, h) + aoff + m * 2048 + k * 1024); } while (0)
#define PG8_LDB(dst, b, h) do { _Pragma("unroll") for (int n = 0; n < 2; ++n) _Pragma("unroll") for (int k = 0; k < 2; ++k) dst[n][k] = *(const PG8_LAS bf16x8*)(lds + PG8_SB(b, h) + boff + n * 2048 + k * 1024); } while (0)
#define PG8_MMA(ai, bj, At, Bt) do { __builtin_amdgcn_s_setprio(1); _Pragma("unroll") for (int m = 0; m < 4; ++m) _Pragma("unroll") for (int n = 0; n < 2; ++n) _Pragma("unroll") for (int k = 0; k < 2; ++k) \
        acc[ai][bj][m][n] = __builtin_amdgcn_mfma_f32_16x16x32_bf16(Bt[n][k], At[m][k], acc[ai][bj][m][n], 0, 0, 0); __builtin_amdgcn_s_setprio(0); } while (0)
#define PG8_WAIT_V(n) asm volatile("s_waitcnt vmcnt(" #n ")" ::: "memory")
#define PG8_WAIT_L(n) asm volatile("s_waitcnt lgkmcnt(" #n ")" ::: "memory")
#define PG8_BAR __builtin_amdgcn_s_barrier()
#define PG8_SCHED __builtin_amdgcn_sched_barrier(0)
    Unit cur, nxt; int ui = 0;
    if (!S.next(0, cur)) return;
    f32x4 acc[2][2][4][2];
#pragma unroll
    for (int a = 0; a < 2; ++a)
#pragma unroll
        for (int b = 0; b < 2; ++b)
#pragma unroll
            for (int m = 0; m < 4; ++m)
#pragma unroll
                for (int n = 0; n < 2; ++n) acc[a][b][m][n] = (f32x4){0.f, 0.f, 0.f, 0.f};
    bf16x8 At[4][2], B0[2][2], B1[2][2];
    const char* cA = (const char*)g.A + (size_t)cur.pm * tsA; const char* cB = (const char*)g.Bt + (size_t)cur.pn * tsB;
    S.a_ready(cur);
    if constexpr (SP2) {
        PG8_STAGE(PG8_SB(0, 0), cB, voffB); PG8_STAGE(PG8_SB(0, 1), cB + hsB, voffB); PG8_STAGE(PG8_SA(0, 0), cA, voffA); PG8_STAGE(PG8_SA(0, 1), cA + hsA, voffA);
        if (wr == 1) PG8_BAR;
        PG8_WAIT_V(2); PG8_BAR;
        PG8_STAGE(PG8_SB(1, 0), cB + ksB, voffB); PG8_STAGE(PG8_SA(1, 0), cA + ksA, voffA); PG8_STAGE(PG8_SB(1, 1), cB + hsB + ksB, voffB);
        PG8_WAIT_V(6); PG8_BAR;
    } else {
        PG8_STAGE(PG8_SB(0, 0), cB, voffB); PG8_STAGE(PG8_SA(0, 0), cA, voffA); PG8_STAGE(PG8_SB(0, 1), cB + hsB, voffB); PG8_STAGE(PG8_SA(0, 1), cA + hsA, voffA);
        if (wr == 1) PG8_BAR;
        PG8_WAIT_V(4); PG8_BAR;
        PG8_STAGE(PG8_SB(1, 0), cB + ksB, voffB); PG8_STAGE(PG8_SA(1, 0), cA + ksA, voffA); PG8_STAGE(PG8_SB(1, 1), cB + hsB + ksB, voffB);
        PG8_WAIT_V(6); PG8_BAR;
    }
    for (;;) {
        const bool has_next = S.next(ui + 1, nxt);
        const char* nA = has_next ? (const char*)g.A + (size_t)nxt.pm * tsA : cA; const char* nB = has_next ? (const char*)g.Bt + (size_t)nxt.pn * tsB : cB;
        for (int t = 0; t < nt; t += 2) {
            const bool last = (t == nt - 2);
            const char* a1 = cA + (size_t)(t + 1) * ksA;
            const char* a2 = last ? nA : cA + (size_t)(t + 2) * ksA; const char* b2 = last ? nB : cB + (size_t)(t + 2) * ksB;
            const char* a3 = a2 + ksA; const char* b3 = b2 + ksB;
            if (last && has_next) S.a_ready(nxt);
            if constexpr (SP2) {
            PG8_LDB(B0, 0, 0); PG8_LDB(B1, 0, 1); PG8_SCHED; PG8_LDA(At, 0, 0); PG8_STAGE(PG8_SA(1, 1), a1 + hsA, voffA);
            PG8_WAIT_V(8); PG8_WAIT_L(0); PG8_BAR; PG8_MMA(0, 0, At, B0); PG8_MMA(0, 1, At, B1); PG8_BAR; PG8_SCHED;
            PG8_LDA(At, 0, 1); PG8_STAGE(PG8_SB(0, 0), b2, voffB); PG8_STAGE(PG8_SB(0, 1), b2 + hsB, voffB); PG8_STAGE(PG8_SA(0, 0), a2, voffA);
            PG8_WAIT_V(8); PG8_WAIT_L(0); PG8_BAR; PG8_MMA(1, 0, At, B0); PG8_MMA(1, 1, At, B1); PG8_BAR; PG8_SCHED;
            PG8_LDB(B0, 1, 0); PG8_LDB(B1, 1, 1); PG8_SCHED; PG8_LDA(At, 1, 0); PG8_STAGE(PG8_SA(0, 1), a2 + hsA, voffA);
            PG8_WAIT_V(8); PG8_WAIT_L(0); PG8_BAR; PG8_MMA(0, 0, At, B0); PG8_MMA(0, 1, At, B1); PG8_BAR; PG8_SCHED;
            PG8_LDA(At, 1, 1); PG8_STAGE(PG8_SB(1, 0), b3, voffB); PG8_STAGE(PG8_SB(1, 1), b3 + hsB, voffB); PG8_STAGE(PG8_SA(1, 0), a3, voffA);
            PG8_WAIT_V(8); PG8_WAIT_L(0); PG8_BAR; PG8_MMA(1, 0, At, B0); PG8_MMA(1, 1, At, B1); PG8_BAR; PG8_SCHED;
            } else {
            PG8_LDB(B0, 0, 0); PG8_SCHED; PG8_LDA(At, 0, 0); PG8_STAGE(PG8_SA(1, 1), a1 + hsA, voffA);
            PG8_WAIT_L(8); PG8_BAR; PG8_WAIT_L(0); PG8_MMA(0, 0, At, B0); PG8_BAR; PG8_SCHED;
            PG8_LDB(B1, 0, 1); PG8_STAGE(PG8_SB(0, 0), b2, voffB);
            PG8_BAR; PG8_WAIT_L(0); PG8_MMA(0, 1, At, B1); PG8_BAR;
            PG8_LDA(At, 0, 1); PG8_STAGE(PG8_SA(0, 0), a2, voffA);
            PG8_BAR; PG8_WAIT_L(0); PG8_MMA(1, 0, At, B0); PG8_BAR; PG8_SCHED;
            PG8_STAGE(PG8_SB(0, 1), b2 + hsB, voffB);
            PG8_WAIT_V(6); PG8_BAR; PG8_MMA(1, 1, At, B1); PG8_BAR;
            PG8_LDB(B0, 1, 0); PG8_SCHED; PG8_LDA(At, 1, 0); PG8_STAGE(PG8_SA(0, 1), a2 + hsA, voffA);
            PG8_WAIT_L(8); PG8_BAR; PG8_WAIT_L(0); PG8_MMA(0, 0, At, B0); PG8_BAR; PG8_SCHED;
            PG8_LDB(B1, 1, 1); PG8_STAGE(PG8_SB(1, 0), b3, voffB);
            PG8_BAR; PG8_WAIT_L(0); PG8_MMA(0, 1, At, B1); PG8_BAR;
            PG8_LDA(At, 1, 1); PG8_STAGE(PG8_SA(1, 0), a3, voffA);
            PG8_BAR; PG8_WAIT_L(0); PG8_MMA(1, 0, At, B0); PG8_BAR; PG8_SCHED;
            PG8_STAGE(PG8_SB(1, 1), b3 + hsB, voffB);
            PG8_WAIT_V(6); PG8_BAR; PG8_MMA(1, 1, At, B1); PG8_BAR;
            }
        }
        if constexpr (ALIGN_EPI) { if (wr == 0) PG8_BAR; }
        if constexpr (!Epi::AFTER_DRAIN) { E(acc, cur, wr, wc, fr, fq); S.done(cur); }
        if (!has_next) break;
#pragma unroll
        for (int a = 0; a < 2; ++a)
#pragma unroll
            for (int b = 0; b < 2; ++b)
#pragma unroll
                for (int m = 0; m < 4; ++m)
#pragma unroll
                    for (int n = 0; n < 2; ++n) acc[a][b][m][n] = (f32x4){0.f, 0.f, 0.f, 0.f};
        cur = nxt; cA = nA; cB = nB; ++ui;
        if constexpr (ALIGN_EPI) { if (wr == 1) PG8_BAR; }
    }
    PG8_WAIT_V(0);
    if constexpr (!ALIGN_EPI) { if (wr == 0) PG8_BAR; }
    PG8_BAR;
    if constexpr (Epi::AFTER_DRAIN) { E.fused(acc, cur, wr, wc, fr, fq, lds, wid, lane); S.done(cur); }
#undef PG8_SA
#undef PG8_SB
#undef PG8_STAGE
#undef PG8_LDA
#undef PG8_LDB
#undef PG8_MMA
#undef PG8_WAIT_V
#undef PG8_WAIT_L
#undef PG8_BAR
#undef PG8_SCHED
}
}
#include <hip/hip_bf16.h>
#include <cmath>
namespace attn_body {
using bf16=__hip_bfloat16;
using bf16x8=__attribute__((ext_vector_type(8)))short;
using s16x4=__attribute__((ext_vector_type(4)))short;
using f32x16=__attribute__((ext_vector_type(16)))float;
using u32x4=__attribute__((ext_vector_type(4)))unsigned;
constexpr int BATCH=8,NHEAD=8,SEQ=4096,D=64,DM=NHEAD*D;
constexpr int NW=8,QBLK=32,QB=QBLK*NW,KVBLK=64,NQB=SEQ/QB;
constexpr int ATTN_PITCH=DM, ATTN_UNIT_ROWS=QB;
__device__ __forceinline__ int crow(int r,int hi){return (r&3)+8*(r>>2)+4*hi;}
#define SBAR() __builtin_amdgcn_sched_barrier(0)
__device__ __forceinline__ void cmask(f32x16&p0,f32x16&p1,int jb,int qrel,int hi){
  const float NEG=-INFINITY; int kb=64*jb+4*hi;
  #pragma unroll
  for(int r=0;r<16;++r){int kv=kb+(r&3)+8*(r>>2); if(kv>qrel)p0[r]=NEG; if(kv+32>qrel)p1[r]=NEG;}
}

constexpr int NSLOT=3, SLOTB=8192;
constexpr int LDS_K=0, LDS_V=NSLOT*SLOTB, LDS_WS=2*NSLOT*SLOTB, LDS_OST=LDS_WS+NW*64*4, LDS_BYTES=LDS_OST+NW*4096;
constexpr float C2=0.125f*1.4426950408889634f;
__device__ __forceinline__ void glds16s(const void*sbase,unsigned voff,unsigned lds_dst){unsigned keep;
  asm volatile("s_mov_b32 %0, m0\n\ts_mov_b32 m0, %2\n\ts_nop 0\n\tglobal_load_lds_dwordx4 %1, %3\n\ts_mov_b32 m0, %0":"=&s"(keep):"v"(voff),"s"(lds_dst),"s"(sbase):"memory");}
__device__ __forceinline__ void glds16(const void*gsrc,unsigned lds_dst){unsigned keep;
  asm volatile("s_mov_b32 %0, m0\n\ts_mov_b32 m0, %2\n\ts_nop 0\n\tglobal_load_lds_dwordx4 %1, off\n\ts_mov_b32 m0, %0":"=&s"(keep):"v"(gsrc),"s"(lds_dst):"memory");}
__device__ __forceinline__ float max3f(float a,float b,float c){float r;asm("v_max3_f32 %0, %1, %2, %3":"=v"(r):"v"(a),"v"(b),"v"(c));return r;}
__device__ __forceinline__ float max2f(float a,float b){float r;asm("v_max_f32_e32 %0, %1, %2":"=v"(r):"v"(a),"v"(b));return r;}
__device__ __forceinline__ float fadd_s(float a,float b){float r;asm("v_add_f32_e32 %0, %1, %2":"=v"(r):"v"(a),"v"(b));return r;}
__device__ __forceinline__ float fsub_s(float a,float b){float r;asm("v_sub_f32_e32 %0, %1, %2":"=v"(r):"v"(a),"v"(b));return r;}
typedef float f32x2_t __attribute__((ext_vector_type(2))); typedef float fv4_t __attribute__((ext_vector_type(4))); typedef __bf16 bf16x2_t __attribute__((ext_vector_type(2)));
__device__ __forceinline__ unsigned cvtpk_s(float lo,float hi){f32x2_t v={lo,hi};bf16x2_t b=__builtin_convertvector(v,bf16x2_t);return __builtin_bit_cast(unsigned,b);}
#define WAIT_BAR(N) asm volatile("s_waitcnt vmcnt(" #N ") lgkmcnt(0)\n\ts_barrier":::"memory")

__device__ __forceinline__ void qkt(f32x16&p0,f32x16&p1,const char*Kslot,const bf16x8*qr,const f32x16&negm,int r32,int hi){
  const char*kb=Kslot+hi*1024+r32*16;
  #pragma unroll
  for(int d0=0;d0<4;++d0){
    const bf16x8 b0=*reinterpret_cast<const bf16x8*>(kb+d0*2048);
    const bf16x8 b1=*reinterpret_cast<const bf16x8*>(kb+d0*2048+512);
    if(d0==0){p0=__builtin_amdgcn_mfma_f32_32x32x16_bf16(b0,qr[0],negm,0,0,0);p1=__builtin_amdgcn_mfma_f32_32x32x16_bf16(b1,qr[0],negm,0,0,0);}
    else{p0=__builtin_amdgcn_mfma_f32_32x32x16_bf16(b0,qr[d0],p0,0,0,0);p1=__builtin_amdgcn_mfma_f32_32x32x16_bf16(b1,qr[d0],p1,0,0,0);}}
}
typedef __attribute__((address_space(3))) const char* lds_cptr;
typedef short v4i16_t __attribute__((ext_vector_type(4)));
__device__ __forceinline__ void kload8(bf16x8*kf,lds_cptr kp){
  kf[0]=*(const __attribute__((address_space(3))) bf16x8*)(kp);      kf[1]=*(const __attribute__((address_space(3))) bf16x8*)(kp+512);
  kf[2]=*(const __attribute__((address_space(3))) bf16x8*)(kp+2048); kf[3]=*(const __attribute__((address_space(3))) bf16x8*)(kp+2560);
  kf[4]=*(const __attribute__((address_space(3))) bf16x8*)(kp+4096); kf[5]=*(const __attribute__((address_space(3))) bf16x8*)(kp+4608);
  kf[6]=*(const __attribute__((address_space(3))) bf16x8*)(kp+6144); kf[7]=*(const __attribute__((address_space(3))) bf16x8*)(kp+6656);
}
__device__ __forceinline__ void kload2(bf16x8*kf,lds_cptr kp,int j){ kf[2*j]=*(const __attribute__((address_space(3))) bf16x8*)(kp+j*2048); kf[2*j+1]=*(const __attribute__((address_space(3))) bf16x8*)(kp+j*2048+512); }
__device__ __forceinline__ s16x4 vtr(lds_cptr p){ return __builtin_bit_cast(s16x4,__builtin_amdgcn_ds_read_tr16_b64_v4i16((__attribute__((address_space(3))) v4i16_t*)p)); }
__device__ __forceinline__ float rowmax(const f32x16&p0,const f32x16&p1){
  float a=max3f(p0[0],p0[1],p1[0]),b=max3f(p0[2],p0[3],p1[1]);a=max3f(a,p1[2],p1[3]);
  #pragma unroll
  for(int r=4;r<16;r+=4){a=max3f(a,p0[r],p0[r+1]);b=max3f(b,p0[r+2],p0[r+3]);a=max3f(a,p1[r],p1[r+1]);b=max3f(b,p1[r+2],p1[r+3]);}
  const float m=max2f(a,b);
  auto rr=__builtin_amdgcn_permlane32_swap(__float_as_uint(m),__float_as_uint(m),false,false);
  return max2f(__uint_as_float(rr[0]),__uint_as_float(rr[1]));
}
__device__ __forceinline__ void pv(f32x16*o,int vb,bf16x8 pa0,bf16x8 pa1,bf16x8 pa2,bf16x8 pa3){
  #pragma unroll
  for(int d0=0;d0<2;++d0){s16x4 lo[4],hi[4];
    #pragma unroll
    for(int ks=0;ks<4;++ks){
      asm volatile("ds_read_b64_tr_b16 %0,%1 offset:%c2":"=&v"(lo[ks]):"v"(vb),"i"(d0*4096+ks*1024):"memory");
      asm volatile("ds_read_b64_tr_b16 %0,%1 offset:%c2":"=&v"(hi[ks]):"v"(vb),"i"(d0*4096+ks*1024+512):"memory");}
    asm volatile("s_waitcnt lgkmcnt(0)":::"memory");SBAR();
    #define PK(k) (bf16x8){lo[k][0],lo[k][1],lo[k][2],lo[k][3],hi[k][0],hi[k][1],hi[k][2],hi[k][3]}
    o[d0]=__builtin_amdgcn_mfma_f32_32x32x16_bf16(pa0,PK(0),o[d0],0,0,0);
    o[d0]=__builtin_amdgcn_mfma_f32_32x32x16_bf16(pa1,PK(1),o[d0],0,0,0);
    o[d0]=__builtin_amdgcn_mfma_f32_32x32x16_bf16(pa2,PK(2),o[d0],0,0,0);
    o[d0]=__builtin_amdgcn_mfma_f32_32x32x16_bf16(pa3,PK(3),o[d0],0,0,0);
    #undef PK
  }
}

#ifndef ATTN_STORE16
#define ATTN_STORE16(p,v) (*(u32x4*)(p)=(v))
#endif
template<int THRL> __device__ __forceinline__ void attn_unit(int b,int h,int qb,const bf16*Q,const bf16*__restrict__ K,const bf16*__restrict__ V,bf16*O,const float*__restrict__ ksum,char*shm){
  int tid; asm volatile("v_mov_b32 %0, %1":"=v"(tid):"v"(threadIdx.x));
  const int lane=tid&63,r32=lane&31,hi=lane>>5; const int wid=__builtin_amdgcn_readfirstlane(tid>>6);
  const long rowbase=(long)b*SEQ; const int q0=qb*QB;
  const bf16*Qw=Q+(rowbase+q0+wid*QBLK)*DM+h*D;
  const bf16*Kh=K+rowbase*DM+h*D,*Vh=V+rowbase*DM+h*D;
  const unsigned lds0=(unsigned)(uintptr_t)shm;
  float*wsf=(float*)(shm+LDS_WS)+wid*64;
  const unsigned koff=(unsigned)((lane*DM+wid*8)*2);
  const unsigned voffv=(unsigned)(((16*(wid&3)+(lane>>2))*DM+(wid>>2)*32+(lane&3)*8)*2);
  const unsigned kdst=lds0+LDS_K+wid*1024, vdst=lds0+LDS_V+wid*1024;
  #define DMA_K(t,slot) glds16s(Kh+(long)(t)*KVBLK*DM,koff,(unsigned)__builtin_amdgcn_readfirstlane(kdst+(slot)))
  #define DMA_V(t,slot) glds16s(Vh+(long)(t)*KVBLK*DM,voffv,(unsigned)__builtin_amdgcn_readfirstlane(vdst+(slot)))
  const int vb0=(int)(lds0+LDS_V)+((lane>>4)&1)*32+(lane&3)*8+(4*hi+((lane&15)>>2))*64;
  const char*Kbase=shm+LDS_K; bf16x8 kf[8];
  const lds_cptr shm3=(lds_cptr)shm; const lds_cptr kp0=shm3+LDS_K+hi*1024+r32*16; const lds_cptr vp0=shm3+LDS_V+((lane>>4)&1)*32+(lane&3)*8+(4*hi+((lane&15)>>2))*64;
  const int NT=(q0+QB)/KVBLK;
  DMA_K(0,0);DMA_V(0,0);DMA_K(1,SLOTB);
  bf16x8 qr[4];
  #pragma unroll
  for(int d0=0;d0<4;++d0)qr[d0]=*reinterpret_cast<const bf16x8*>(&Qw[(long)r32*DM+d0*16+hi*8]);
  unsigned selmask=1u<<qb;
  { float qf[32];
    #pragma unroll
    for(int d0=0;d0<4;++d0){
      #pragma unroll
      for(int i=0;i<8;++i)qf[d0*8+i]=__builtin_bit_cast(float,((unsigned)(unsigned short)qr[d0][i])<<16);}
    float g1=-INFINITY,g2=-INFINITY,g3=-INFINITY;int i1=-1,i2=-1,i3=-1;
    { const float*kbase=ksum+((long)(b*(SEQ/QB)))*DM+h*D; fv4_t kv[4];
      #pragma unroll
      for(int i=0;i<4;++i){ const int idx=i*64+lane; kv[i]=*reinterpret_cast<const fv4_t*>(kbase+(long)(idx>>4)*DM+(idx&15)*4); }
      __attribute__((address_space(3))) fv4_t*st=(__attribute__((address_space(3))) fv4_t*)((__attribute__((address_space(3))) char*)shm+LDS_OST+wid*4096);
      #pragma unroll
      for(int i=0;i<4;++i)st[i*64+lane]=kv[i];
      asm volatile("s_waitcnt lgkmcnt(0)":::"memory"); }
    const __attribute__((address_space(3))) float*kst=(const __attribute__((address_space(3))) float*)((__attribute__((address_space(3))) char*)shm+LDS_OST+wid*4096)+hi*8;
    for(int j=0;j<qb;++j){
      const __attribute__((address_space(3))) float*ks=kst+j*64; float gt=0.f;
      #pragma unroll
      for(int d0=0;d0<4;++d0){ const fv4_t k0=*reinterpret_cast<const __attribute__((address_space(3))) fv4_t*>(ks+d0*16),k1=*reinterpret_cast<const __attribute__((address_space(3))) fv4_t*>(ks+d0*16+4);
        gt+=qf[d0*8+0]*k0[0]+qf[d0*8+1]*k0[1]+qf[d0*8+2]*k0[2]+qf[d0*8+3]*k0[3]+qf[d0*8+4]*k1[0]+qf[d0*8+5]*k1[1]+qf[d0*8+6]*k1[2]+qf[d0*8+7]*k1[3];}
      gt+=__shfl_xor(gt,32);
      if(gt>g1){g3=g2;i3=i2;g2=g1;i2=i1;g1=gt;i1=j;} else if(gt>g2){g3=g2;i3=i2;g2=gt;i2=j;} else if(gt>g3){g3=gt;i3=j;}
    }
    if(i1>=0)selmask|=1u<<i1; if(i2>=0)selmask|=1u<<i2; if(i3>=0)selmask|=1u<<i3; }
  float mhat=0.f,l_reg=0.f;f32x16 o[2];o[0]=f32x16{};o[1]=f32x16{};f32x16 negm=f32x16{};asm volatile("":"+v"(negm));
  const int qrel=wid*QBLK+r32;
  #define CMASK(P0,P1,t) do{int jb_=(t)-(NT-4); if(jb_>=0)cmask(P0,P1,jb_,qrel,hi);}while(0)
  bool resc=false;
  #define START(P0,P1) do{ float rm=rowmax(P0,P1); rm=(selmask&1u)?rm:-INFINITY; resc=false; \
    { const float dl=__builtin_fmaxf(rm,-64.f); mhat=fadd_s(mhat,dl); \
      _Pragma("unroll") for(int r=0;r<16;++r){P0[r]=fsub_s(P0[r],dl);P1[r]=fsub_s(P1[r],dl);} \
      _Pragma("unroll") for(int r=0;r<16;++r)negm[r]=-mhat; asm volatile("":"+v"(negm)); } \
    _Pragma("unroll") for(int r=0;r<16;++r)P0[r]=__builtin_amdgcn_exp2f(P0[r]); }while(0)
  #define RESC() do{ if(resc){ asm volatile("s_waitcnt lgkmcnt(0)":::"memory"); \
      _Pragma("unroll") for(int d_=0;d_<2;++d_) _Pragma("unroll") for(int r=0;r<16;++r)o[d_][r]*=wsf[crow(r,hi)]; } }while(0)
  f32x16 pA0,pA1,pB0,pB1;
  int sl_prev=0,sl_cur=0,sl_next=SLOTB;
  #define ROT() do{sl_prev=sl_cur;sl_cur=sl_next;sl_next=(sl_next==(NSLOT-1)*SLOTB)?0:sl_next+SLOTB;}while(0)
  DMA_K(2,2*SLOTB);
  WAIT_BAR(3);
  qkt(pA0,pA1,Kbase,qr,negm,r32,hi);asm volatile("s_nop 15\n\ts_nop 7":"+v"(pA0),"+v"(pA1));CMASK(pA0,pA1,0);
  START(pA0,pA1);
  _Pragma("unroll") for(int r=0;r<16;++r)pA1[r]=__builtin_amdgcn_exp2f(pA1[r]);
  WAIT_BAR(0);
  DMA_K(3,0);DMA_V(1,SLOTB);
  ROT();
  kload8(kf,kp0+sl_cur);
  WAIT_BAR(2);
  s16x4 vlo[8],vhi[8]; u32x4 pw0,pw1,pw2,pw3;
  #define PKW(P,B) cvtpk_s(P[B],P[B+1])
  #define PKWM(P,B) (cvtpk_s(P[B],P[B+1])&selw_)
  #define PAF(k) __builtin_bit_cast(bf16x8,pw##k)
  #define VFR(i) (bf16x8){vlo[i][0],vlo[i][1],vlo[i][2],vlo[i][3],vhi[i][0],vhi[i][1],vhi[i][2],vhi[i][3]}
  #define PIN(x) asm volatile("":"+v"(x))
  #define MX3(a,b,c) __builtin_fmaxf(__builtin_fmaxf((a),(b)),(c))
  #define GAPA(MF,A0,A1,A2,A3,W0,W1,PW) do{ MF; sacc+=A0; sacc+=A1; sacc+=A2; sacc+=A3; PIN(sacc); W0; W1; PIN(PW); SBAR(); }while(0)
  #define EX(v) __builtin_amdgcn_exp2f(v)
  #define GAPB(MF,X,B) do{ MF; X[B]=EX(X[B]); X[B+1]=EX(X[B+1]); X[B+2]=EX(X[B+2]); X[B+3]=EX(X[B+3]); PIN(X); SBAR(); }while(0)
  #define VRD(i) do{ vlo[i]=vtr(vp_+(((i)>>2)*4096+((i)&3)*1024)); vhi[i]=vtr(vp_+(((i)>>2)*4096+((i)&3)*1024+512)); }while(0)
  #define KRD(G,j) do{ if(G){ kload2(kf,kp0+sl_next,j); SBAR(); } }while(0)
  #define STEP(C0,C1,P0,P1,t,GK,GV,GL) do{ SBAR(); const unsigned selw_=0u-((selmask>>(((t)-1)>>2))&1u); \
    const lds_cptr vp_=vp0+sl_prev; \
    VRD(0); SBAR(); float sacc=(P0[0]+P0[1]); \
    GAPA(C0=__builtin_amdgcn_mfma_f32_32x32x16_bf16(kf[0],qr[0],negm,0,0,0), P0[2],P0[3],P0[4],P0[5],     pw0[0]=PKWM(P0,0), pw0[1]=PKWM(P0,2), pw0); \
    VRD(4); SBAR(); GAPA(C1=__builtin_amdgcn_mfma_f32_32x32x16_bf16(kf[1],qr[0],negm,0,0,0), P0[6],P0[7],P0[8],P0[9],     pw0[2]=PKWM(P0,4), pw0[3]=PKWM(P0,6), pw0); \
    VRD(1); SBAR(); GAPA(C0=__builtin_amdgcn_mfma_f32_32x32x16_bf16(kf[2],qr[1],C0,0,0,0),   P0[10],P0[11],P0[12],P0[13], pw1[0]=PKWM(P0,8), pw1[1]=PKWM(P0,10), pw1); \
    VRD(5); SBAR(); GAPA(C1=__builtin_amdgcn_mfma_f32_32x32x16_bf16(kf[3],qr[1],C1,0,0,0),   P0[14],P0[15],P1[0],P1[1],   pw1[2]=PKWM(P0,12),pw1[3]=PKWM(P0,14), pw1); \
    VRD(2); SBAR(); GAPA(C0=__builtin_amdgcn_mfma_f32_32x32x16_bf16(kf[4],qr[2],C0,0,0,0),   P1[2],P1[3],P1[4],P1[5],     pw2[0]=PKWM(P1,0), pw2[1]=PKWM(P1,2), pw2); \
    VRD(6); SBAR(); GAPA(C1=__builtin_amdgcn_mfma_f32_32x32x16_bf16(kf[5],qr[2],C1,0,0,0),   P1[6],P1[7],P1[8],P1[9],     pw2[2]=PKWM(P1,4), pw2[3]=PKWM(P1,6), pw2); \
    VRD(3); SBAR(); GAPA(C0=__builtin_amdgcn_mfma_f32_32x32x16_bf16(kf[6],qr[3],C0,0,0,0),   P1[10],P1[11],P1[12],P1[13], pw3[0]=PKWM(P1,8), pw3[1]=PKWM(P1,10), pw3); \
    VRD(7); SBAR(); GAPA(C1=__builtin_amdgcn_mfma_f32_32x32x16_bf16(kf[7],qr[3],C1,0,0,0),   P1[14],P1[15],0.f,0.f,       pw3[2]=PKWM(P1,12),pw3[3]=PKWM(P1,14), pw3); \
    l_reg+=(selw_?sacc:0.f); \
    if(GK){DMA_K((t)+3,sl_cur);} if(GV){DMA_V((t)+1,sl_next);} \
    CMASK(C0,C1,t); \
    { float a=MX3(C0[0],C0[1],C1[0]),b=MX3(C0[2],C0[3],C1[1]); a=MX3(a,C1[2],C1[3]); \
      _Pragma("unroll") for(int r=4;r<16;r+=4){a=MX3(a,C0[r],C0[r+1]);b=MX3(b,C0[r+2],C0[r+3]);a=MX3(a,C1[r],C1[r+1]);b=MX3(b,C1[r+2],C1[r+3]);} \
      float rm=__builtin_fmaxf(a,b); { auto rr=__builtin_amdgcn_permlane32_swap(__float_as_uint(rm),__float_as_uint(rm),false,false); rm=__builtin_fmaxf(__uint_as_float(rr[0]),__uint_as_float(rr[1])); } \
      rm=((selmask>>((t)>>2))&1u)?rm:-INFINITY; resc=false; \
      if(__builtin_expect(__any(rm>(float)THRL),0)){ const float dl=__builtin_fmaxf(rm,0.f); mhat+=dl; \
        _Pragma("unroll") for(int r=0;r<16;++r){C0[r]-=dl;C1[r]-=dl;} \
        _Pragma("unroll") for(int r=0;r<16;++r)negm[r]=-mhat; asm volatile("":"+v"(negm)); \
        const float f=__builtin_amdgcn_exp2f(-dl); l_reg*=f; if(hi==0)wsf[r32]=f; resc=true; } } \
    SBAR(); \
    GAPB(o[0]=__builtin_amdgcn_mfma_f32_32x32x16_bf16(PAF(0),VFR(0),o[0],0,0,0), C0,0); \
    GAPB(o[1]=__builtin_amdgcn_mfma_f32_32x32x16_bf16(PAF(0),VFR(4),o[1],0,0,0), C0,4); \
    KRD(GL,0); GAPB(o[0]=__builtin_amdgcn_mfma_f32_32x32x16_bf16(PAF(1),VFR(1),o[0],0,0,0), C0,8); \
    KRD(GL,1); GAPB(o[1]=__builtin_amdgcn_mfma_f32_32x32x16_bf16(PAF(1),VFR(5),o[1],0,0,0), C0,12); \
    KRD(GL,2); GAPB(o[0]=__builtin_amdgcn_mfma_f32_32x32x16_bf16(PAF(2),VFR(2),o[0],0,0,0), C1,0); \
    KRD(GL,3); GAPB(o[1]=__builtin_amdgcn_mfma_f32_32x32x16_bf16(PAF(2),VFR(6),o[1],0,0,0), C1,4); \
    GAPB(o[0]=__builtin_amdgcn_mfma_f32_32x32x16_bf16(PAF(3),VFR(3),o[0],0,0,0), C1,8); \
    GAPB(o[1]=__builtin_amdgcn_mfma_f32_32x32x16_bf16(PAF(3),VFR(7),o[1],0,0,0), C1,12); \
    }while(0)
  int t=1;
  #undef CMASK
  #define CMASK(P0,P1,t) do{}while(0)
  for(;t+5<NT;t+=2){
    STEP(pB0,pB1,pA0,pA1,t,true,true,true);     WAIT_BAR(2); RESC(); ROT();
    STEP(pA0,pA1,pB0,pB1,t+1,true,true,true);   WAIT_BAR(2); RESC(); ROT();
  }
  #undef CMASK
  #define CMASK(P0,P1,t) do{int jb_=(t)-(NT-4); if(jb_>=0)cmask(P0,P1,jb_,qrel,hi);}while(0)
  #define ENDW(tt) do{ if((tt)+3<NT){WAIT_BAR(2);} else if((tt)+2<NT){WAIT_BAR(1);} else {WAIT_BAR(0);} }while(0)
  for(;t+1<NT;t+=2){
    STEP(pB0,pB1,pA0,pA1,t,(t+3<NT),(t+1<NT),(t+1<NT));       ENDW(t);   RESC(); ROT();
    STEP(pA0,pA1,pB0,pB1,t+1,(t+4<NT),(t+2<NT),(t+2<NT));     ENDW(t+1); RESC(); ROT();
  }
  STEP(pB0,pB1,pA0,pA1,NT-1,false,false,false); RESC();
  { float sacc=pB0[0]+pB0[1]; _Pragma("unroll") for(int r=2;r<16;++r)sacc+=pB0[r]; _Pragma("unroll") for(int r=0;r<16;++r)sacc+=pB1[r]; l_reg+=sacc;
    pw0=(u32x4){PKW(pB0,0),PKW(pB0,2),PKW(pB0,4),PKW(pB0,6)};pw1=(u32x4){PKW(pB0,8),PKW(pB0,10),PKW(pB0,12),PKW(pB0,14)};pw2=(u32x4){PKW(pB1,0),PKW(pB1,2),PKW(pB1,4),PKW(pB1,6)};pw3=(u32x4){PKW(pB1,8),PKW(pB1,10),PKW(pB1,12),PKW(pB1,14)};
    SBAR(); pv(o,vb0+sl_cur,PAF(0),PAF(1),PAF(2),PAF(3)); }
  #undef PKW
  #undef PKWM
  #undef PAF
  #undef VFR
  #undef PIN
  #undef MX3
  #undef GAPA
  #undef GAPB
  #undef EX
  #undef VRD
  #undef KRD
  #undef STEP
  #undef ENDW
  {auto rr=__builtin_amdgcn_permlane32_swap(__float_as_uint(l_reg),__float_as_uint(l_reg),false,false);l_reg=__uint_as_float(rr[0])+__uint_as_float(rr[1]);}
  if(hi==0)wsf[32+r32]=l_reg;asm volatile("s_waitcnt lgkmcnt(0)":::"memory");
  float rli[16];
  #pragma unroll
  for(int r=0;r<16;++r)rli[r]=__builtin_amdgcn_rcpf(wsf[32+crow(r,hi)]);
  bf16*Ow=O+(rowbase+q0+wid*QBLK)*DM+h*D;
  { bf16*stg=(bf16*)(shm+LDS_OST)+wid*2048;
    #pragma unroll
    for(int r=0;r<16;++r){const int orow=crow(r,hi);
      #pragma unroll
      for(int d0=0;d0<2;++d0)stg[orow*64+d0*32+r32]=__float2bfloat16(o[d0][r]*rli[r]);}
    asm volatile("s_waitcnt lgkmcnt(0)":::"memory");
    #pragma unroll
    for(int i=0;i<4;++i){const int row=i*8+(lane>>3),ch=lane&7; const u32x4 v=*(const u32x4*)(stg+row*64+ch*8); ATTN_STORE16(Ow+(long)row*DM+ch*8,v);} }
  asm volatile("s_waitcnt lgkmcnt(0)\n\ts_barrier":::"memory");
  #undef DMA_K
  #undef DMA_V
  #undef CMASK
  #undef START
  #undef RESC
  #undef ROT
}
constexpr int ATTN_LDS_BYTES=LDS_BYTES;
struct AttnTensors { const bf16* Q; const bf16* K; const bf16* V; bf16* O; const float* ksum; };
struct AttnUnit { int bh; int qb; };
struct StaticOrder {
  int vcu,G;
  __device__ __forceinline__ explicit StaticOrder(int grid,int block):vcu((grid%8==0)?(block%8)*(grid/8)+block/8:block),G(grid){}
  __device__ __forceinline__ bool next(int i,AttnUnit&u)const{ if(G!=256){ const int id=i*G+vcu; if(id>=BATCH*NHEAD*NQB)return false; u.bh=id/NQB; u.qb=NQB-1-id%NQB; return true; }
    if(i>=4)return false; const int s=vcu&3; u.bh=vcu>>2; u.qb=(i==0)?15-s:(i==1)?s:(i==2)?11-s:4+s; return true; }
  __device__ __forceinline__ void a_ready(const AttnUnit&)const{}
  __device__ __forceinline__ void done(const AttnUnit&)const{}
};
template<class Sched,int THRL=8> __device__ __forceinline__ void attn_phase(char*lds,const AttnTensors&T,const Sched&S){
  AttnUnit u;
  for(int i=0;S.next(i,u);++i){ S.a_ready(u); attn_unit<THRL>(u.bh/NHEAD,u.bh%NHEAD,u.qb,T.Q,T.K,T.V,T.O,T.ksum,lds); S.done(u); }
}
#undef SBAR
#undef WAIT_BAR
}
#define GAS __attribute__((address_space(1)))
#define LAS __attribute__((address_space(3)))
typedef unsigned short bf16;
typedef unsigned v4u __attribute__((ext_vector_type(4)));
typedef float f32x4 __attribute__((ext_vector_type(4)));
typedef short bf16x8 __attribute__((ext_vector_type(8)));
typedef GAS unsigned gu32;
typedef GAS unsigned long long gu64;
#define RLX_AGENT __ATOMIC_RELAXED, __HIP_MEMORY_SCOPE_AGENT
#define LDS_WAIT() asm volatile("s_waitcnt lgkmcnt(0)" ::: "memory")
#define VM_WAIT() asm volatile("s_waitcnt vmcnt(0)" ::: "memory")
__device__ __forceinline__ unsigned long long rt() { return __builtin_amdgcn_s_memrealtime(); }
__device__ __forceinline__ unsigned f2bf(float f) { unsigned u = __builtin_bit_cast(unsigned, f); return (u + 0x7fffu + ((u >> 16) & 1u)) >> 16; }
__device__ __forceinline__ unsigned pk2(float lo, float hi) { return f2bf(lo) | (f2bf(hi) << 16); }
#define XB_TMO      128
#define XB_XCNT(j)  (256  + 64 * (j))
#define XB_XSUB(j)  (1280 + 64 * (j))
#define XB_XGEN(j)  (2304 + 64 * (j))
#define XB_TOP      3328
#define XB_TOPGEN   3392
#define XCD_BAR_WORDS 3456
#define XB_SPIN_CAP (1u << 18)

__device__ __forceinline__ unsigned xb_ld(unsigned* p)              { return __hip_atomic_load(p, __ATOMIC_RELAXED, __HIP_MEMORY_SCOPE_AGENT); }
__device__ __forceinline__ unsigned xb_add(unsigned* p, unsigned v) { return __hip_atomic_fetch_add(p, v, __ATOMIC_RELAXED, __HIP_MEMORY_SCOPE_AGENT); }
__device__ __forceinline__ unsigned xb_xcc_id() { return (unsigned)__builtin_amdgcn_s_getreg((3 << 11) | 20) & 0xFu; }
#define XB_SPIN(cond, bar) do { unsigned _sp = 0; while (cond) { __builtin_amdgcn_s_sleep(1); \
    if ((++_sp & 255u) == 0u) { if (xb_ld(&(bar)[XB_TMO])) break; if (_sp > XB_SPIN_CAP) { atomicAdd(&(bar)[XB_TMO], 1u); break; } } } } while (0)

struct XcdBarrier {
    unsigned* bar; unsigned x;
    volatile LAS unsigned* st;
};

__device__ __forceinline__ XcdBarrier xcd_barrier_post(unsigned* bar, volatile LAS unsigned* st) {
    XcdBarrier b; b.bar = bar; b.x = xb_xcc_id(); b.st = st;
    if (threadIdx.x == 0) (void)xb_add(&bar[XB_XCNT(b.x)], 1u);
    return b;
}
__device__ __forceinline__ void xcd_barrier_complete(unsigned* bar, unsigned x, unsigned& nloc, unsigned& nx) {
    const unsigned G = gridDim.x * gridDim.y * gridDim.z;
    unsigned sum, cnt, mine, sp = 0u;
    for (;;) {
        sum = 0u; cnt = 0u; mine = 0u;
#pragma unroll
        for (unsigned j = 0; j < 16; ++j) { const unsigned c = xb_ld(&bar[XB_XCNT(j)]); sum += c; cnt += (c > 0u) ? 1u : 0u; mine = (j == x) ? c : mine; }
        if (sum == G) break;
        __builtin_amdgcn_s_sleep(1);
        if ((++sp & 255u) == 0u) { if (xb_ld(&bar[XB_TMO])) break; if (sp > XB_SPIN_CAP) { atomicAdd(&bar[XB_TMO], 1u); break; } }
    }
    nloc = mine > 0u ? mine : 1u; nx = cnt > 0u ? cnt : 1u;
}

__device__ __forceinline__ void xcd_barrier(const XcdBarrier& b) {
    asm volatile("s_waitcnt vmcnt(0)" ::: "memory");
    __syncthreads();
    if (threadIdx.x == 0) {
        unsigned* bar = b.bar;
        __builtin_amdgcn_s_waitcnt(0);
        unsigned nloc = b.st[0], nx = b.st[1];
        if (nloc == 0u) { xcd_barrier_complete(bar, b.x, nloc, nx); b.st[0] = nloc; b.st[1] = nx; }
        const unsigned old = xb_add(&bar[XB_XSUB(b.x)], 1u);
        const unsigned gen = old / nloc;
        if (old + 1u == (gen + 1u) * nloc) {
            __builtin_amdgcn_fence(__ATOMIC_RELEASE, "agent");
            asm volatile("s_waitcnt vmcnt(0)" ::: "memory");
            const unsigned og = xb_add(&bar[XB_TOP], 1u);
            const unsigned tg = og / nx;
            if (og + 1u == (tg + 1u) * nx) xb_add(&bar[XB_TOPGEN], 1u);
            else XB_SPIN(xb_ld(&bar[XB_TOPGEN]) == tg, bar);
            __builtin_amdgcn_fence(__ATOMIC_ACQUIRE, "agent");
            xb_add(&bar[XB_XGEN(b.x)], 1u);
            asm volatile("s_waitcnt vmcnt(0)" ::: "memory");
        } else {
            XB_SPIN(xb_ld(&bar[XB_XGEN(b.x)]) == gen, bar);
            __builtin_amdgcn_fence(__ATOMIC_ACQUIRE, "agent");
            asm volatile("s_waitcnt vmcnt(0)" ::: "memory");
        }
    }
    __syncthreads();
}
__device__ __forceinline__ float wave_sum(float v) {
#pragma unroll
    for (int o = 1; o < 64; o <<= 1) v += __shfl_xor(v, o);
    return v;
}
__device__ __forceinline__ void p0_transpose_item(const float* W, int K, int N, bf16* WT, int row_off, LAS float* scr, int item, int lane) {
    const int nblk = N / 32, kb = item / nblk, nb = item % nblk, k0 = 64 * kb, n0 = 32 * nb;
    float tv[32];
#pragma unroll
    for (int i = 0; i < 32; ++i) { const int kk = 2 * i + (lane >> 5); tv[i] = W[(size_t)(k0 + kk) * N + n0 + (lane & 31)]; }
#pragma unroll
    for (int i = 0; i < 32; ++i) { const int kk = 2 * i + (lane >> 5); scr[kk * 33 + (lane & 31)] = tv[i]; }
    LDS_WAIT(); asm volatile("" ::: "memory");
    const int c = lane & 7;
#pragma unroll
    for (int j = 0; j < 4; ++j) { const int n = (lane >> 3) + 8 * j; const LAS float* s = scr + (8 * c) * 33 + n;
        v4u o; o.x = pk2(s[0 * 33], s[1 * 33]); o.y = pk2(s[2 * 33], s[3 * 33]); o.z = pk2(s[4 * 33], s[5 * 33]); o.w = pk2(s[6 * 33], s[7 * 33]);
        *(GAS v4u*)(WT + (size_t)(row_off + n0 + n) * K + k0 + 8 * c) = o; }
    LDS_WAIT(); asm volatile("" ::: "memory");
}
constexpr int NWAVES = 8;
#ifndef MK_PER_PHASE
#define MK_PER_PHASE 0
#endif
constexpr int NPHASES = 12;

constexpr int BATCH = 8, SEQ = 4096, D = 1024, M = BATCH * SEQ, NIN = 4096, SW = 512, AW = 512;
constexpr int NG = 32, GH = 16, NP = 64, NH = 8, HD = 64, FF = 4096, NBLK = 16, BLK = 256;
constexpr float RMS_EPS = 1e-6f;
constexpr float C2 = 0.125f * 1.4426950408889634f;

constexpr size_t MiB = 1u << 20;
constexpr size_t WS_CTL = 0, CTL_ZERO_BYTES = 1 * MiB;
constexpr size_t WS_KSUM = 512 * 1024;
constexpr size_t WS_TAB = 1 * MiB;
constexpr size_t WS_WIN = 2 * MiB, WS_WGLU = 10 * MiB, WS_WA = 11 * MiB, WS_WB = 12 * MiB, WS_WO = 13 * MiB, WS_W1 = 15 * MiB, WS_W2 = 23 * MiB;
constexpr size_t WS_U = 32 * MiB;
constexpr size_t WS_ZX = 96 * MiB;
constexpr size_t WS_Q = 144 * MiB, WS_K = 176 * MiB, WS_V = 208 * MiB;
constexpr size_t WS_SGA = 240 * MiB, WS_SGB = 304 * MiB;
constexpr size_t WS_VS = 368 * MiB, WS_YA = 400 * MiB;
constexpr size_t WS_MG = 432 * MiB;
constexpr size_t WS_MIX = 368 * MiB;
constexpr size_t WS_HM = 96 * MiB;
constexpr size_t WS_WS = 496 * MiB, WS_KG = 500 * MiB, WS_KM = 506 * MiB;
constexpr size_t WS_END = 507 * MiB;
constexpr int CW_TMO = 0, CW_CODE = 1, CW_BAR = 4096, CW_XL = 65536;

constexpr int RING_OFF = 0, RING_BYTES = 131072;
constexpr int LDSCTL_OFF = RING_BYTES, MISC_OFF = LDSCTL_OFF + 320;
constexpr int LDS_BYTES = 147456;

constexpr int TB_ABR = 0, TB_ABI = 2048, TB_BBR = 4096, TB_BBI = 4096 + 32768, TB_A16R = 4096 + 65536, TB_A16I = TB_A16R + 2048, TB_A512R = TB_A16I + 2048, TB_A512I = TB_A512R + 2048;
#ifndef SKEW_TICKS
#define SKEW_TICKS 0
#endif
#ifndef SSM_NAIVE
#define SSM_NAIVE 0
#endif

__device__ __forceinline__ float bf2f(bf16 v) { return __builtin_bit_cast(float, (unsigned)v << 16); }
__device__ __forceinline__ float gelu_tanh(float x) {
    const float u = 0.7978845608028654f * (x + 0.044715f * x * x * x);
    const float e = __builtin_amdgcn_exp2f(-2.0f * 1.4426950408889634f * fabsf(u));
    const float t = (1.0f - e) * __builtin_amdgcn_rcpf(1.0f + e);
    return 0.5f * x * (1.0f + (u < 0.f ? -t : t));
}

__device__ __forceinline__ void cpowk(double lr, double li, double dt, double k, double& re, double& im) { const double mg = exp(k * lr * dt), an = k * li * dt; re = mg * cos(an); im = mg * sin(an); }
__device__ __forceinline__ void cipow(double ar, double ai, int k, double& re, double& im) { double br = ar, bi = ai; re = 1.0; im = 0.0;
    while (k) { if (k & 1) { const double t = re * br - im * bi; im = re * bi + im * br; re = t; } const double t2 = br * br - bi * bi; bi = 2.0 * br * bi; br = t2; k >>= 1; } }
__device__ __forceinline__ void zoh_from_a(double ar, double ai, double lr, double li, double& cr, double& ci) { const double nr = ar - 1.0, ni = ai, den = lr * lr + li * li; cr = (nr * lr + ni * li) / den; ci = (ni * lr - nr * li) / den; }
__device__ __forceinline__ void zoh_coef(double lr, double li, double dt, double& cr, double& ci) { double ar, ai; cpowk(lr, li, dt, 1.0, ar, ai); const double nr = ar - 1.0, ni = ai, den = lr * lr + li * li; cr = (nr * lr + ni * li) / den; ci = (ni * lr - nr * li) / den; }
__device__ __forceinline__ float reduce16(const float (&v)[16], int lane) {
    float a8[8], a4[4], a2[2], a1;
    { const bool up = (lane & 32) != 0;
#pragma unroll
      for (int j = 0; j < 8; ++j) { const float send = up ? v[j] : v[j + 8]; const float keep = up ? v[j + 8] : v[j]; a8[j] = keep + __shfl_xor(send, 32); } }
    { const bool up = (lane & 16) != 0;
#pragma unroll
      for (int j = 0; j < 4; ++j) { const float send = up ? a8[j] : a8[j + 4]; const float keep = up ? a8[j + 4] : a8[j]; a4[j] = keep + __shfl_xor(send, 16); } }
    { const bool up = (lane & 8) != 0;
#pragma unroll
      for (int j = 0; j < 2; ++j) { const float send = up ? a4[j] : a4[j + 2]; const float keep = up ? a4[j + 2] : a4[j]; a2[j] = keep + __shfl_xor(send, 8); } }
    { const bool up = (lane & 4) != 0; const float send = up ? a2[0] : a2[1]; const float keep = up ? a2[1] : a2[0]; a1 = keep + __shfl_xor(send, 4); }
    a1 += __shfl_xor(a1, 2); a1 += __shfl_xor(a1, 1);
    return a1;
}
#define PH_PTRS GAS unsigned char* wsg_ = (GAS unsigned char*)args.ws; asm volatile("" : "+s"(wsg_)); unsigned char* wsl = (unsigned char*)wsg_;   \
    bf16 *Win_t = (bf16*)(wsl + WS_WIN), *Wglu_t = (bf16*)(wsl + WS_WGLU), *Wa_t = (bf16*)(wsl + WS_WA), *Wb_t = (bf16*)(wsl + WS_WB), *Wo_t = (bf16*)(wsl + WS_WO), *W1_t = (bf16*)(wsl + WS_W1), *W2_t = (bf16*)(wsl + WS_W2); \
    bf16 *U = (bf16*)(wsl + WS_U), *ZX = (bf16*)(wsl + WS_ZX), *Qb = (bf16*)(wsl + WS_Q), *Kb = (bf16*)(wsl + WS_K), *Vb = (bf16*)(wsl + WS_V), *SGA = (bf16*)(wsl + WS_SGA), *SGB = (bf16*)(wsl + WS_SGB); \
    bf16 *VS = (bf16*)(wsl + WS_VS), *YA = (bf16*)(wsl + WS_YA), *MG = (bf16*)(wsl + WS_MG), *MIX = (bf16*)(wsl + WS_MIX), *HM = (bf16*)(wsl + WS_HM); \
    float* ksum = (float*)(wsl + WS_KSUM); float* tab = (float*)(wsl + WS_TAB); bf16 *WsT = (bf16*)(wsl + WS_WS), *KG = (bf16*)(wsl + WS_KG); float* KM = (float*)(wsl + WS_KM); \
    const float* x = args.in[0]; float* out = args.out; \
    (void)Win_t; (void)Wglu_t; (void)Wa_t; (void)Wb_t; (void)Wo_t; (void)W1_t; (void)W2_t; (void)U; (void)ZX; (void)Qb; (void)Kb; (void)Vb; (void)SGA; (void)SGB; (void)VS; (void)YA; (void)MG; (void)MIX; (void)HM; (void)ksum; (void)tab; (void)WsT; (void)KG; (void)KM; (void)x; (void)out
struct Args { const float* in[21]; float* out; unsigned char* ws; int ph_lo, ph_hi, li, pad; };

template <int R> __device__ __forceinline__ void rms_rows_to_bf16(const float* x0, size_t rstride, const f32x4 (&gg)[4], bf16* o0, int lane) {
    f32x4 v[R][4];
#pragma unroll
    for (int r = 0; r < R; ++r) { const GAS f32x4* xr = (const GAS f32x4*)(x0 + r * rstride) + lane;
#pragma unroll
        for (int j = 0; j < 4; ++j) v[r][j] = xr[64 * j]; }
#pragma unroll
    for (int r = 0; r < R; ++r) { float s = 0.f;
#pragma unroll
        for (int j = 0; j < 4; ++j) s += (v[r][j].x * v[r][j].x + v[r][j].y * v[r][j].y) + (v[r][j].z * v[r][j].z + v[r][j].w * v[r][j].w);
        const float rs = 1.0f / sqrtf(wave_sum(s) * (1.f / D) + RMS_EPS);
        GAS unsigned long long* o8 = (GAS unsigned long long*)(o0 + r * rstride) + lane;
#pragma unroll
        for (int j = 0; j < 4; ++j) o8[64 * j] = (unsigned long long)pk2(v[r][j].x * rs * gg[j].x, v[r][j].y * rs * gg[j].y) | ((unsigned long long)pk2(v[r][j].z * rs * gg[j].z, v[r][j].w * rs * gg[j].w) << 32); }
}
__device__ __forceinline__ f32x4 bf4(unsigned long long w) { const unsigned w0 = (unsigned)w, w1 = (unsigned)(w >> 32); return (f32x4){pg8::bf_lo(w0), pg8::bf_hi(w0), pg8::bf_lo(w1), pg8::bf_hi(w1)}; }
__device__ __forceinline__ unsigned long long pk4(f32x4 v) { return (unsigned long long)pk2(v.x, v.y) | ((unsigned long long)pk2(v.z, v.w) << 32); }
__device__ __forceinline__ float sq4(f32x4 v) { return (v.x * v.x + v.y * v.y) + (v.z * v.z + v.w * v.w); }

__global__ void __launch_bounds__(NWAVES * 64, 2) fwd(Args args) {
    extern __shared__ __attribute__((aligned(16))) unsigned char lds[];
    LAS unsigned char* L = (LAS unsigned char*)lds;
    volatile LAS unsigned* MISC = (volatile LAS unsigned*)(L + MISC_OFF);
    const int tid = threadIdx.x, lane = tid & 63, wave = __builtin_amdgcn_readfirstlane(tid >> 6);
    const int G = gridDim.x; const int bx = blockIdx.x; const int vcu = (G % 8 == 0) ? (bx % 8) * (G / 8) + bx / 8 : bx;
    unsigned char* ws = args.ws;
    gu32* ctl = (gu32*)(ws + WS_CTL);
    const int gtid = vcu * (NWAVES * 64) + tid, NTHR = G * NWAVES * 64;
    for (int u = tid; u < (LDS_BYTES - LDSCTL_OFF) / 4; u += NWAVES * 64) ((LAS unsigned*)(L + LDSCTL_OFF))[u] = 0u;
    __syncthreads();
    XcdBarrier bar; bar.bar = (unsigned*)(ctl + CW_BAR) + args.li * XCD_BAR_WORDS; bar.x = xb_xcc_id(); bar.st = MISC + 8;
    if (!MK_PER_PHASE && tid == 0) MISC[10] = xb_add(&bar.bar[XB_XCNT(bar.x)], 1u);
    unsigned xl_gen = 0u;
    int cu = bx; bool xloc = false;
#define GRID_BAR() do { if (MK_PER_PHASE) { if (tid == 0) __hip_atomic_store(ctl + CW_TMO, 0xBADBA0u, RLX_AGENT); } else { xcd_barrier(bar); } } while (0)
#define ENSURE_CENSUS() do { if (!MK_PER_PHASE) { __syncthreads(); \
        if (tid == 0) { if (MISC[8] == 0u) { unsigned nloc_, nx_; xcd_barrier_complete(bar.bar, bar.x, nloc_, nx_); MISC[8] = nloc_; MISC[9] = nx_; } \
            if (MISC[11] == 0u) { bool uni_ = (G == 256); for (unsigned j_ = 0; j_ < 16; ++j_) { const unsigned c_ = xb_ld(&bar.bar[XB_XCNT(j_)]); uni_ = uni_ && (c_ == (j_ < 8u ? 32u : 0u)); } MISC[11] = uni_ ? 2u : 1u; } } \
        __syncthreads(); xloc = (MISC[11] == 2u); if (xloc) cu = (int)MISC[10] * 8 + (int)bar.x; } } while (0)
#define XL_WORD ((unsigned*)(ctl + CW_XL) + args.li * 1024 + 64 * bar.x)
#define SEAM_BAR() do { if (MK_PER_PHASE) { if (tid == 0) __hip_atomic_store(ctl + CW_TMO, 0xBADBA0u, RLX_AGENT); } \
      else if (xloc) { VM_WAIT(); __syncthreads(); \
          if (tid == 0) { __builtin_amdgcn_s_waitcnt(0); (void)xb_add(XL_WORD, 1u); const unsigned want_ = (xl_gen + 1u) * 32u; XB_SPIN(xb_ld(XL_WORD) < want_, bar.bar); \
              __builtin_amdgcn_fence(__ATOMIC_ACQUIRE, "agent"); asm volatile("s_waitcnt vmcnt(0)" ::: "memory"); } \
          ++xl_gen; __syncthreads(); } \
      else { xcd_barrier(bar); } } while (0)
    const int lo = args.ph_lo, hi = args.ph_hi;
#define IN(k) (lo <= (k) && (k) < hi)
#define BOTH(k) (IN(k) && IN((k) + 1))
    const int gw = vcu * NWAVES + wave, NGW = G * NWAVES;
#define ROWDEAL const int rbase = xloc ? (int)bar.x * SEQ : 0, rfirst = xloc ? (cu >> 3) * NWAVES + wave : gw, rstep = xloc ? 32 * NWAVES : NGW, rlim = xloc ? SEQ : M

    if (IN(0)) { PH_PTRS;
        LAS float* scr = (LAS float*)(L + RING_OFF + wave * 16384);
        constexpr int I_IN = (D / 64) * (NIN / 32), I_GLU = (SW / 64) * (SW / 32), I_A = (SW / 64) * (D / 32), I_O = (D / 64) * (D / 32), I_1 = (D / 64) * (FF / 32), I_2 = (FF / 64) * (D / 32);
        constexpr int NITEMS = I_IN + I_GLU + 2 * I_A + I_O + I_1 + I_2;
        for (int it = gw; it < NITEMS; it += NGW) {
            int r = it;
            if (r < I_IN) { p0_transpose_item(args.in[2], D, NIN, Win_t, 0, scr, r, lane); continue; } r -= I_IN;
            if (r < I_GLU) { p0_transpose_item(args.in[11], SW, SW, Wglu_t, 0, scr, r, lane); continue; } r -= I_GLU;
            if (r < I_A) { p0_transpose_item(args.in[13], SW, D, Wa_t, 0, scr, r, lane); continue; } r -= I_A;
            if (r < I_A) { p0_transpose_item(args.in[14], AW, D, Wb_t, 0, scr, r, lane); continue; } r -= I_A;
            if (r < I_O) { p0_transpose_item(args.in[15], D, D, Wo_t, 0, scr, r, lane); continue; } r -= I_O;
            if (r < I_1) { p0_transpose_item(args.in[18], D, FF, W1_t, 0, scr, r, lane); continue; } r -= I_1;
            p0_transpose_item(args.in[19], FF, D, W2_t, 0, scr, r, lane);
        }
        { f32x4 gg[4];
#pragma unroll
          for (int j = 0; j < 4; ++j) gg[j] = ((const GAS f32x4*)args.in[1] + lane)[64 * j];
          for (int m = gw; m < M; m += 2 * NGW) rms_rows_to_bf16<2>(x + (size_t)m * D, (size_t)NGW * D, gg, U + (size_t)m * D, lane); }
        const float *lam_re = args.in[3], *lam_im = args.in[4], *log_dt = args.in[5], *b_re = args.in[6], *b_im = args.in[7], *c_re = args.in[8], *c_im = args.in[9];
        if ((gtid & 63) == 1 && (gtid >> 6) < NG * NP) { const int gp = gtid >> 6, g = gp / NP;
            const double lr = (double)lam_re[gp], li = (double)lam_im[gp], dt = exp((double)log_dt[g]);
            double ar, ai, cr, ci, a1r, a1i; cpowk(lr, li, dt, 1.0, a1r, a1i); ar = a1r; ai = a1i; zoh_from_a(a1r, a1i, lr, li, cr, ci);
            tab[TB_ABR + gp] = (float)ar; tab[TB_ABI + gp] = (float)ai;
            cipow(a1r, a1i, 16, ar, ai); tab[TB_A16R + gp] = (float)ar; tab[TB_A16I + gp] = (float)ai;
            cipow(a1r, a1i, 512, ar, ai); tab[TB_A512R + gp] = (float)ar; tab[TB_A512I + gp] = (float)ai;
            for (int h = 0; h < GH; ++h) { const double br = (double)b_re[gp * GH + h], bi = (double)b_im[gp * GH + h];
                tab[TB_BBR + gp * GH + h] = (float)(cr * br - ci * bi); tab[TB_BBI + gp * GH + h] = (float)(cr * bi + ci * br); } }
        for (int e = gtid >> 2; (gtid & 3) == 2 && e < NG * NP * 16; e += NTHR >> 2) {
            const int p = e % NP, s_ = (e / NP) % 16, g = e / (NP * 16), gp = g * NP + p;
            const double lr = (double)lam_re[gp], li = (double)lam_im[gp], dt = exp((double)log_dt[g]);
            double wr_, wi_, cr, ci, a1r, a1i; cpowk(lr, li, dt, 1.0, a1r, a1i); cipow(a1r, a1i, 15 - s_, wr_, wi_); zoh_from_a(a1r, a1i, lr, li, cr, ci);
            float vr[GH], vi[GH];
#pragma unroll
            for (int h = 0; h < GH; ++h) { const double br = (double)b_re[gp * GH + h], bi = (double)b_im[gp * GH + h], Br = cr * br - ci * bi, Bi = cr * bi + ci * br;
                vr[h] = (float)(wr_ * Br - wi_ * Bi); vi[h] = (float)(wr_ * Bi + wi_ * Br); }
            GAS v4u* o_r = (GAS v4u*)(WsT + ((size_t)(g * 256 + p)) * 256 + s_ * 16); GAS v4u* o_i = (GAS v4u*)(WsT + ((size_t)(g * 256 + 64 + p)) * 256 + s_ * 16);
            o_r[0] = (v4u){pk2(vr[0], vr[1]), pk2(vr[2], vr[3]), pk2(vr[4], vr[5]), pk2(vr[6], vr[7])}; o_r[1] = (v4u){pk2(vr[8], vr[9]), pk2(vr[10], vr[11]), pk2(vr[12], vr[13]), pk2(vr[14], vr[15])};
            o_i[0] = (v4u){pk2(vi[0], vi[1]), pk2(vi[2], vi[3]), pk2(vi[4], vi[5]), pk2(vi[6], vi[7])}; o_i[1] = (v4u){pk2(vi[8], vi[9]), pk2(vi[10], vi[11]), pk2(vi[12], vi[13]), pk2(vi[14], vi[15])}; }
        for (int e = gtid; e < NG * 4096; e += NTHR) {
            const int g = e / 4096, r = e % 4096; ((GAS v4u*)(WsT + ((size_t)(g * 256 + 128)) * 256))[r] = (v4u){0u, 0u, 0u, 0u}; }
        for (int e = gtid >> 2; (gtid & 3) == 3 && e < NG * NP * 16; e += NTHR >> 2) {
            const int p = e % NP, t = (e / NP) % 16, g = e / (NP * 16), gp = g * NP + p;
            const double lr = (double)lam_re[gp], li = (double)lam_im[gp], dt = exp((double)log_dt[g]);
            double wr_, wi_, a1r, a1i; cpowk(lr, li, dt, 1.0, a1r, a1i); cipow(a1r, a1i, t + 1, wr_, wi_);
            for (int h = 0; h < GH; ++h) { const double cr = (double)c_re[(g * GH + h) * NP + p], ci = (double)c_im[(g * GH + h) * NP + p];
                bf16* o = KG + ((size_t)(g * 256 + t * 16 + h)) * 384 + 256 + p;
                o[0] = (bf16)f2bf((float)(cr * wr_ - ci * wi_)); o[64] = (bf16)f2bf((float)(-(cr * wi_ + ci * wr_))); } }
        for (int wt = gw >> 2; (gw & 3) == 0 && wt < NG * 16; wt += NGW >> 2) {
            const int g = wt / 16, j = wt % 16, p = lane, gp = g * NP + p;
            const double lr = (double)lam_re[gp], li = (double)lam_im[gp], dt = exp((double)log_dt[g]);
            double wr_, wi_, cr, ci, a1r, a1i; cpowk(lr, li, dt, 1.0, a1r, a1i); cipow(a1r, a1i, j, wr_, wi_); zoh_from_a(a1r, a1i, lr, li, cr, ci);
            float Br[GH], Bi[GH];
#pragma unroll
            for (int h = 0; h < GH; ++h) { const double br = (double)b_re[gp * GH + h], bi = (double)b_im[gp * GH + h]; Br[h] = (float)(cr * br - ci * bi); Bi[h] = (float)(cr * bi + ci * br); }
            for (int hp = 0; hp < GH; ++hp) { const double c1 = (double)c_re[(g * GH + hp) * NP + p], c2 = (double)c_im[(g * GH + hp) * NP + p];
                const float cwr = (float)(c1 * wr_ - c2 * wi_), cwi = (float)(c1 * wi_ + c2 * wr_);
                float v[GH];
#pragma unroll
                for (int h = 0; h < GH; ++h) v[h] = cwr * Br[h] - cwi * Bi[h];
                const float tot = reduce16(v, lane);
                if ((lane & 3) == 0) scr[hp * 16 + (lane >> 2)] = tot; }
            LDS_WAIT(); asm volatile("" ::: "memory");
            if (lane < 32) { const int hp = lane >> 1, hf = lane & 1; const LAS float* k8 = scr + hp * 16 + hf * 8;
                const v4u w = (v4u){pk2(k8[0], k8[1]), pk2(k8[2], k8[3]), pk2(k8[4], k8[5]), pk2(k8[6], k8[7])};
                for (int t = j; t < 16; ++t) *(GAS v4u*)(KG + ((size_t)(g * 256 + t * 16 + hp)) * 384 + (t - j) * 16 + hf * 8) = w; }
            LDS_WAIT(); asm volatile("" ::: "memory"); }
        for (int e = gtid; e < NG * 256 * 32; e += NTHR) {
            const int kc = e % 32, n = (e / 32) % 256, g_ = e / (32 * 256);
            if ((kc >> 1) > (n >> 4)) *(GAS v4u*)(KG + ((size_t)(g_ * 256 + n)) * 384 + kc * 8) = (v4u){0u, 0u, 0u, 0u}; }
        if (BOTH(0)) GRID_BAR();
    }
    if (hi > 1) ENSURE_CENSUS();

    if (IN(1)) { PH_PTRS;
        pg8::Gemm g{U, Win_t, M, NIN, D, D, D}; pg8::StaticOrder S; S.init(M, NIN, G, cu);
        pg8::EpiIn E{wsl, (unsigned)WS_ZX, (unsigned)WS_Q, (unsigned)WS_K, (unsigned)WS_V, (unsigned)WS_SGA, (unsigned)WS_SGB, ksum, C2};
        pg8::gemm_phase<pg8::EpiIn, pg8::StaticOrder, true, true>(L + RING_OFF, g, S, E);
        if (BOTH(1)) SEAM_BAR();
    }

    if (IN(2)) { PH_PTRS;
#if SSM_NAIVE
        if (wave == 0) {
            for (int item = vcu; item < BATCH * NG; item += G) {
                const int b = item / NG, g = item % NG, p = lane;
                const float abr = tab[TB_ABR + g * NP + p], abi = tab[TB_ABI + g * NP + p];
                float bbr[GH], bbi[GH], cr[GH], ci[GH];
#pragma unroll
                for (int h = 0; h < GH; ++h) { bbr[h] = tab[TB_BBR + (g * NP + p) * GH + h]; bbi[h] = tab[TB_BBI + (g * NP + p) * GH + h];
                    cr[h] = args.in[8][(g * GH + h) * NP + p]; ci[h] = args.in[9][(g * GH + h) * NP + p]; }
                const int hme = lane >> 2;
                const float dsk = args.in[10][g * GH + hme];
                float xr = 0.f, xi = 0.f;
                const bf16* zrow = ZX + (size_t)((g * 8 + b) * 256) * 384;
                bf16* vrow = VS + (size_t)b * SEQ * SW + g * GH;
                for (int t = 0; t < SEQ; ++t) {
                    const v4u w0 = *(const GAS v4u*)(zrow + (size_t)(t >> 4) * 384 + (t & 15) * 16), w1 = *(const GAS v4u*)(zrow + (size_t)(t >> 4) * 384 + (t & 15) * 16 + 8);
                    float uu[GH];
                    uu[0] = pg8::bf_lo(w0.x); uu[1] = pg8::bf_hi(w0.x); uu[2] = pg8::bf_lo(w0.y); uu[3] = pg8::bf_hi(w0.y); uu[4] = pg8::bf_lo(w0.z); uu[5] = pg8::bf_hi(w0.z); uu[6] = pg8::bf_lo(w0.w); uu[7] = pg8::bf_hi(w0.w);
                    uu[8] = pg8::bf_lo(w1.x); uu[9] = pg8::bf_hi(w1.x); uu[10] = pg8::bf_lo(w1.y); uu[11] = pg8::bf_hi(w1.y); uu[12] = pg8::bf_lo(w1.z); uu[13] = pg8::bf_hi(w1.z); uu[14] = pg8::bf_lo(w1.w); uu[15] = pg8::bf_hi(w1.w);
                    float bur = 0.f, bui = 0.f;
#pragma unroll
                    for (int h = 0; h < GH; ++h) { bur += bbr[h] * uu[h]; bui += bbi[h] * uu[h]; }
                    const float nxr = abr * xr - abi * xi + bur, nxi = abr * xi + abi * xr + bui; xr = nxr; xi = nxi;
                    float v[GH];
#pragma unroll
                    for (int h = 0; h < GH; ++h) v[h] = cr[h] * xr - ci[h] * xi;
                    const float a1 = reduce16(v, lane);
                    float um = uu[0];
#pragma unroll
                    for (int h = 1; h < GH; ++h) um = (hme == h) ? uu[h] : um;
                    const float y = a1 + dsk * um;
                    if ((lane & 3) == 0) vrow[(size_t)t * SW + hme] = (bf16)f2bf(gelu_tanh(y));
                }
            }
        }
#else
        if (cu < NG * BATCH) { const int item = cu;
            const int g_ = item >> 3, b_ = item & 7;
            { pg8::Gemm gm{ZX, WsT + (size_t)g_ * 256 * 256, NG * BATCH * 256, 256, 256, 384, 256}; pg8::OneUnit S{item, 0};
              pg8::EpiSsmState E{ZX + (size_t)item * 256 * 384, tab + TB_A16R + g_ * NP, tab + TB_A16I + g_ * NP, tab + TB_A512R + g_ * NP, tab + TB_A512I + g_ * NP};
              pg8::gemm_phase<pg8::EpiSsmState, pg8::OneUnit, false, true>(L + RING_OFF, gm, S, E); }
            VM_WAIT(); __syncthreads();
            { pg8::Gemm gm{ZX, KG + (size_t)g_ * 256 * 384, NG * BATCH * 256, 256, 384, 384, 384}; pg8::OneUnit S{item, 0};
              pg8::EpiSsmOut E{ZX + (size_t)item * 256 * 384, VS + (size_t)b_ * SEQ * SW + g_ * GH, args.in[10] + g_ * GH};
              pg8::gemm_phase<pg8::EpiSsmOut, pg8::OneUnit, true, true>(L + RING_OFF, gm, S, E); }
            __syncthreads();
        }
#endif
    }
    if (IN(3)) { PH_PTRS;
        { const attn_body::AttnTensors AT{(const attn_body::bf16*)Qb, (const attn_body::bf16*)Kb, (const attn_body::bf16*)Vb, (attn_body::bf16*)U, ksum};
          const attn_body::StaticOrder S(G, cu);
          attn_body::attn_phase<attn_body::StaticOrder>((char*)lds + RING_OFF, AT, S); }
        if (BOTH(3)) SEAM_BAR();
    }

    if (IN(4)) { PH_PTRS;
        pg8::Gemm g{VS, Wglu_t, M, SW, SW, SW, SW}; pg8::StaticOrder S; S.init(M, SW, G, cu);
        pg8::EpiGlu E{VS, YA, args.in[12]};
        pg8::gemm_phase<pg8::EpiGlu, pg8::StaticOrder, true, true>(L + RING_OFF, g, S, E);
        if (BOTH(4)) SEAM_BAR();
    }
    if (IN(5)) { PH_PTRS;
        pg8::Gemm g{YA, Wa_t, M, D, SW, SW, SW}; pg8::StaticOrder S; S.init(M, D, G, cu);
        pg8::EpiGate<false> E{SGA, MG};
        pg8::gemm_phase<pg8::EpiGate<false>, pg8::StaticOrder, true, true>(L + RING_OFF, g, S, E);
    }
    if (IN(6)) { PH_PTRS;
        pg8::Gemm g{U, Wb_t, M, D, AW, AW, AW}; pg8::StaticOrder S; S.init(M, D, G, cu);
        pg8::EpiGate<true> E{SGB, MG};
        pg8::gemm_phase<pg8::EpiGate<true>, pg8::StaticOrder, true, true>(L + RING_OFF, g, S, E);
        if (BOTH(6)) SEAM_BAR();
    }
    if (IN(7)) { PH_PTRS;
        pg8::Gemm g{MG, Wo_t, M, D, D, D, D}; pg8::StaticOrder S; S.init(M, D, G, cu);
        pg8::EpiBf16<0> E{MIX, D, nullptr, 0, 0, 1.f};
        pg8::gemm_phase<pg8::EpiBf16<0>, pg8::StaticOrder, true, true>(L + RING_OFF, g, S, E);
        if (BOTH(7)) SEAM_BAR();
    }
    if (IN(8)) { PH_PTRS;
        f32x4 gpost[4], gpre[4];
#pragma unroll
        for (int j = 0; j < 4; ++j) { gpost[j] = ((const GAS f32x4*)args.in[16] + lane)[64 * j]; gpre[j] = ((const GAS f32x4*)args.in[17] + lane)[64 * j]; }
        ROWDEAL;
        bf16* H1 = MG;
        for (int m0 = rfirst; m0 < rlim; m0 += 2 * rstep) {
            f32x4 xv[2][4], mv[2][4];
#pragma unroll
            for (int r = 0; r < 2; ++r) { const size_t m = (size_t)rbase + (size_t)m0 + (size_t)r * rstep; const GAS f32x4* xr = (const GAS f32x4*)(x + m * D) + lane; const GAS unsigned long long* mr = (const GAS unsigned long long*)(MIX + m * D) + lane;
#pragma unroll
                for (int j = 0; j < 4; ++j) { xv[r][j] = xr[64 * j]; mv[r][j] = bf4(mr[64 * j]); } }
#pragma unroll
            for (int r = 0; r < 2; ++r) { const size_t m = (size_t)rbase + (size_t)m0 + (size_t)r * rstep; float s = 0.f;
#pragma unroll
                for (int j = 0; j < 4; ++j) s += sq4(mv[r][j]);
                const float rs = 1.0f / sqrtf(wave_sum(s) * (1.f / D) + RMS_EPS); float s2 = 0.f;
                GAS unsigned long long* h8 = (GAS unsigned long long*)(H1 + m * D) + lane;
#pragma unroll
                for (int j = 0; j < 4; ++j) { xv[r][j] = xv[r][j] + (mv[r][j] * rs) * gpost[j]; h8[64 * j] = pk4(xv[r][j]); s2 += sq4(xv[r][j]); }
                const float r2 = 1.0f / sqrtf(wave_sum(s2) * (1.f / D) + RMS_EPS);
                GAS unsigned long long* o8 = (GAS unsigned long long*)(U + m * D) + lane;
#pragma unroll
                for (int j = 0; j < 4; ++j) o8[64 * j] = pk4(xv[r][j] * r2 * gpre[j]); }
        }
        if (BOTH(8)) SEAM_BAR();
    }
    if (IN(9)) { PH_PTRS;
        pg8::Gemm g{U, W1_t, M, FF, D, D, D}; pg8::StaticOrder S; S.init(M, FF, G, cu);
        pg8::EpiRelu2T E{HM, FF / 64};
        pg8::gemm_phase<pg8::EpiRelu2T, pg8::StaticOrder, true, true>(L + RING_OFF, g, S, E);
        if (BOTH(9)) SEAM_BAR();
    }
    if (IN(10)) { PH_PTRS;
        pg8::Gemm g{HM, W2_t, M, D, FF, 64, FF, 256 * 64 * 2, 256 * FF * 2}; pg8::StaticOrder S; S.init(M, D, G, cu);
        pg8::EpiBf16<0> E{U, D, nullptr, 0, 0, 1.f};
        pg8::gemm_phase<pg8::EpiBf16<0>, pg8::StaticOrder, true, true>(L + RING_OFF, g, S, E);
        if (BOTH(10)) SEAM_BAR();
    }
    if (IN(11)) { PH_PTRS;
        f32x4 gp[4];
#pragma unroll
        for (int j = 0; j < 4; ++j) gp[j] = ((const GAS f32x4*)args.in[20] + lane)[64 * j];
        ROWDEAL;
        const bf16* H1 = MG;
        for (int m0 = rfirst; m0 < rlim; m0 += 2 * rstep) {
            f32x4 hv[2][4], fv[2][4];
#pragma unroll
            for (int r = 0; r < 2; ++r) { const size_t m = (size_t)rbase + (size_t)m0 + (size_t)r * rstep; const GAS unsigned long long* hr = (const GAS unsigned long long*)(H1 + m * D) + lane; const GAS unsigned long long* fr = (const GAS unsigned long long*)(U + m * D) + lane;
#pragma unroll
                for (int j = 0; j < 4; ++j) { hv[r][j] = bf4(hr[64 * j]); fv[r][j] = bf4(fr[64 * j]); } }
#pragma unroll
            for (int r = 0; r < 2; ++r) { const size_t m = (size_t)rbase + (size_t)m0 + (size_t)r * rstep; float s = 0.f;
#pragma unroll
                for (int j = 0; j < 4; ++j) s += sq4(fv[r][j]);
                const float rs = 1.0f / sqrtf(wave_sum(s) * (1.f / D) + RMS_EPS);
                GAS f32x4* orow = (GAS f32x4*)(out + m * D) + lane;
#pragma unroll
                for (int j = 0; j < 4; ++j) orow[64 * j] = hv[r][j] + (fv[r][j] * rs) * gp[j]; }
        }
    }
#undef IN
#undef BOTH
}

extern "C" void kernel_launch(void* const* d_in, const int* in_sizes, int n_in, void* d_out, int out_size, void* d_ws, size_t ws_size, hipStream_t stream) {
    static int grid = 0;
    if (grid == 0) {
        if (n_in != 21 || in_sizes[0] != M * D || out_size != M * D || ws_size < WS_END) { fprintf(stderr, "kernel_launch: unexpected shapes / workspace (n_in %d, ws %zu)\n", n_in, ws_size); grid = -1; return; }
        int dev = 0, cus = 0, per_cu = 0;
        if (hipGetDevice(&dev) != hipSuccess || hipDeviceGetAttribute(&cus, hipDeviceAttributeMultiprocessorCount, dev) != hipSuccess) { grid = -1; return; }
        if (hipFuncSetAttribute((const void*)fwd, hipFuncAttributeMaxDynamicSharedMemorySize, LDS_BYTES) != hipSuccess) { fprintf(stderr, "kernel_launch: hipFuncSetAttribute failed\n"); grid = -1; return; }
        if (hipOccupancyMaxActiveBlocksPerMultiprocessor(&per_cu, (const void*)fwd, NWAVES * 64, LDS_BYTES) != hipSuccess || per_cu < 1) { fprintf(stderr, "kernel_launch: occupancy query says %d\n", per_cu); }
        (void)hipGetLastError();
        grid = cus;
    }
    if (grid < 0) return;
    if (hipMemsetAsync((char*)d_ws + WS_CTL, 0, CTL_ZERO_BYTES, stream) != hipSuccess) return;
    Args a{};
    for (int i = 0; i < 21; ++i) a.in[i] = (const float*)d_in[i];
    a.out = (float*)d_out; a.ws = (unsigned char*)d_ws;
#ifndef PROBE
#define PROBE 0
#endif
#if MK_PER_PHASE
    for (int p = 0; p < NPHASES; ++p) { a.ph_lo = p; a.ph_hi = p + 1; a.li = 0; hipLaunchKernelGGL(fwd, dim3(grid), dim3(NWAVES * 64), LDS_BYTES, stream, a); }
#else
#if PROBE == 0
    static const int seq[][2] = {{0, NPHASES}};
#elif PROBE == 1
    static const int seq[][2] = {{0, 3}, {2, NPHASES}};
#elif PROBE == 2
    static const int seq[][2] = {{0, 4}, {3, NPHASES}};
#elif PROBE == 3
    static const int seq[][2] = {{0, 1}, {0, NPHASES}};
#elif PROBE == 4
    static const int seq[][2] = {{0, 9}, {8, NPHASES}};
#elif PROBE == 5
    static const int seq[][2] = {{0, 7}, {4, NPHASES}};
#elif PROBE == 7
    static const int seq[][2] = {{0, 10}, {9, NPHASES}};
#elif PROBE == 8
    static const int seq[][2] = {{0, 11}, {10, NPHASES}};
#elif PROBE == 9
    static const int seq[][2] = {{0, 2}, {1, NPHASES}};
#elif PROBE == 6
    static const int seq[][2] = {{0, 8}, {7, NPHASES}};
#endif
    for (int li = 0; li < (int)(sizeof(seq) / sizeof(seq[0])); ++li) { a.ph_lo = seq[li][0]; a.ph_hi = seq[li][1]; a.li = li; hipLaunchKernelGGL(fwd, dim3(grid), dim3(NWAVES * 64), LDS_BYTES, stream, a); }
#endif
}
```

```cpp
#include <hip/hip_runtime.h>
#include <cstdio>
#include <cstdint>
#include <cmath>
namespace pg8 {
#define PG8_LAS __attribute__((address_space(3)))
typedef unsigned short bf16_t;
typedef short bf16x8 __attribute__((ext_vector_type(8)));
typedef float f32x4 __attribute__((ext_vector_type(4)));
typedef unsigned u32x4 __attribute__((ext_vector_type(4)));
constexpr int BM = 256, BK = 64, HALF = 128, HTB = HALF * BK * 2  , STAGE_BYTES = 8 * HTB, NXCD = 8, WGM = 8;

__host__ __device__ __forceinline__ int lds_byte(int r, int c) { const int st = (r >> 4) * 2 + (c >> 5), rr = r & 15, cc = c & 31, ob = rr * 64 + cc * 2; return st * 1024 + (ob ^ (((ob >> 9) & 1) << 5)); }
__host__ __device__ __forceinline__ void stage_rc(int b, int& R, int& C) { const int st = b / 1024, sb = b % 1024, swz = sb ^ (((sb >> 9) & 1) << 5); R = (st >> 1) * 16 + swz / 64; C = (st & 1) * 32 + (swz % 64) / 2; }
__host__ __device__ __forceinline__ int perm32(int rho) { const int n = rho >> 4, i = rho & 15; return 8 * (i >> 2) + 4 * n + (i & 3); }

#ifndef PG8_STORE_SC1
#define PG8_STORE_SC1 0
#endif
#if PG8_STORE_SC1
#define PG8_ST16(p, v) do { const u32x4 v_ = (v); asm volatile("global_store_dwordx4 %0, %1, off sc1" :: "v"(p), "v"(v_) : "memory"); } while (0)
#else
#define PG8_ST16(p, v) (*(u32x4*)(p) = (v))
#endif
#ifndef PG8_STORE_NT
#define PG8_STORE_NT 0
#endif
#if PG8_STORE_NT
#define PG8_ST16NT(p, v) __builtin_nontemporal_store((v), (u32x4*)(p))
#else
#define PG8_ST16NT(p, v) PG8_ST16(p, v)
#endif
struct Unit { int pm, pn; long aoff = 0, boff = 0; int sub = 0, keep = 0; };
struct Gemm { const bf16_t* A; const bf16_t* Bt; int M, N, K, lda, ldb; int ksa = 0, tsa = 0; };

struct StaticOrder {
    static constexpr bool KEEPS = false;
    int nM, nN, nwg, G, c;
    __host__ __device__ void init(int M, int N, int G_, int c_) { nM = M / BM; nN = N / BM; nwg = nM * nN; G = G_; c = c_; }
    __host__ __device__ bool next(int i, Unit& u) const {
        const long L = (long)i * G + c; if (L >= nwg) return false;
        int wgid = (int)L; { const int q = nwg / NXCD, r = nwg % NXCD, xcd = wgid % NXCD, off = wgid / NXCD; wgid = (xcd < r ? xcd * (q + 1) : r * (q + 1) + (xcd - r) * q) + off; }
        const int nig = WGM * nN, gid = wgid / nig, fm = gid * WGM, gsz = (nM - fm) < WGM ? (nM - fm) : WGM;
        u.pm = fm + ((wgid % nig) % gsz); u.pn = (wgid % nig) / gsz; return true;
    }
    __device__ __forceinline__ void a_ready(const Unit&) const {}
    __device__ __forceinline__ void done(const Unit&) const {}
};

__device__ __forceinline__ unsigned cvt_pk_bf16(float lo, float hi) { unsigned r; asm volatile("v_cvt_pk_bf16_f32 %0, %1, %2" : "=v"(r) : "v"(lo), "v"(hi)); return r; }
typedef float f32x2 __attribute__((ext_vector_type(2)));
__device__ __forceinline__ f32x2 gelu_pk(f32x2 v) {
    const f32x2 av = __builtin_elementwise_abs(v), d = av * 0.2316418882f + 1.0f;
    f32x2 t; t.x = __builtin_amdgcn_rcpf(d.x); t.y = __builtin_amdgcn_rcpf(d.y);
    f32x2 q = t * 0.5307027145f + (-0.7265760135f); q = q * t + 0.7107068705f; q = q * t + (-0.142248368f); q = q * t + 0.127414796f; q = q * t;
    const f32x2 s = (v * v) * (-0.72134752044f);
    f32x2 e; e.x = __builtin_amdgcn_exp2f(s.x); e.y = __builtin_amdgcn_exp2f(s.y);
    const f32x2 m = v * (q * e), r = v - m;
    f32x2 o; o.x = v.x < 0.f ? m.x : r.x; o.y = v.y < 0.f ? m.y : r.y; return o;
}
template <int ACT  > struct EpiBf16 {
    static constexpr bool PERM = true, AFTER_DRAIN = false; static_assert(ACT == 0 || ACT == 1, "EpiBf16: ACT is 0 (none) or 1 (gelu_pk)");
    bf16_t* O; int ldc; const float* bias; int split_cols; size_t split_stride; float scale0;
    __device__ __forceinline__ void operator()(const f32x4 (&acc)[2][2][4][2], const Unit& u, int wr, int wc, int fr, int fq) const {
        const int row0 = u.pm * BM + wr * 64 + fr; int colt = u.pn * BM; bf16_t* base = O;
        float sc = 1.f; if (split_cols) { const int t = colt / split_cols; base += (size_t)t * split_stride; colt -= t * split_cols; if (t == 0) sc = scale0; }
        const int col0 = colt + wc * 32 + 8 * fq, bcol0 = u.pn * BM + wc * 32 + 8 * fq;
        f32x4 bv[2][2];
#pragma unroll
        for (int bj = 0; bj < 2; ++bj)
#pragma unroll
            for (int n = 0; n < 2; ++n) bv[bj][n] = bias ? *(const f32x4*)(bias + bcol0 + bj * HALF + 4 * n) : (f32x4){0.f, 0.f, 0.f, 0.f};
#pragma unroll
        for (int ai = 0; ai < 2; ++ai)
#pragma unroll
            for (int m = 0; m < 4; ++m) { bf16_t* rowp = base + (size_t)(row0 + ai * HALF + m * 16) * ldc + col0;
#pragma unroll
                for (int bj = 0; bj < 2; ++bj) { f32x4 v0 = acc[ai][bj][m][0] + bv[bj][0], v1 = acc[ai][bj][m][1] + bv[bj][1];
                    if (ACT == 1) { f32x2 a = gelu_pk((f32x2){v0[0], v0[1]}), b = gelu_pk((f32x2){v0[2], v0[3]}), c = gelu_pk((f32x2){v1[0], v1[1]}), d = gelu_pk((f32x2){v1[2], v1[3]});
                        v0 = (f32x4){a.x, a.y, b.x, b.y}; v1 = (f32x4){c.x, c.y, d.x, d.y}; }
                    v0 = v0 * sc; v1 = v1 * sc; u32x4 w; w.x = cvt_pk_bf16(v0[0], v0[1]); w.y = cvt_pk_bf16(v0[2], v0[3]); w.z = cvt_pk_bf16(v1[0], v1[1]); w.w = cvt_pk_bf16(v1[2], v1[3]);
                    PG8_ST16(rowp + bj * HALF, w); } }
    }
};
__device__ __forceinline__ float bf_lo(unsigned w) { return __builtin_bit_cast(float, w << 16); }
__device__ __forceinline__ float bf_hi(unsigned w) { return __builtin_bit_cast(float, w & 0xffff0000u); }
__device__ __forceinline__ float sigmoid_f(float x) { return __builtin_amdgcn_rcpf(1.0f + __builtin_amdgcn_exp2f(-1.4426950408889634f * x)); }
__device__ __forceinline__ u32x4 pack8(f32x4 v0, f32x4 v1) { u32x4 w; w.x = cvt_pk_bf16(v0[0], v0[1]); w.y = cvt_pk_bf16(v0[2], v0[3]); w.z = cvt_pk_bf16(v1[0], v1[1]); w.w = cvt_pk_bf16(v1[2], v1[3]); return w; }
__device__ __forceinline__ void unpack8(u32x4 w, f32x4& v0, f32x4& v1) { v0 = (f32x4){bf_lo(w.x), bf_hi(w.x), bf_lo(w.y), bf_hi(w.y)}; v1 = (f32x4){bf_lo(w.z), bf_hi(w.z), bf_lo(w.w), bf_hi(w.w)}; }

typedef unsigned u32x2 __attribute__((ext_vector_type(2)));
__device__ __forceinline__ u32x2 packg8(f32x4 v0, f32x4 v1) { u32x2 w; unsigned a = 0u, b = 0u;
    a = __builtin_amdgcn_cvt_pk_u8_f32(v0[0] * 256.f - 0.5f, 0, a); a = __builtin_amdgcn_cvt_pk_u8_f32(v0[1] * 256.f - 0.5f, 1, a); a = __builtin_amdgcn_cvt_pk_u8_f32(v0[2] * 256.f - 0.5f, 2, a); a = __builtin_amdgcn_cvt_pk_u8_f32(v0[3] * 256.f - 0.5f, 3, a);
    b = __builtin_amdgcn_cvt_pk_u8_f32(v1[0] * 256.f - 0.5f, 0, b); b = __builtin_amdgcn_cvt_pk_u8_f32(v1[1] * 256.f - 0.5f, 1, b); b = __builtin_amdgcn_cvt_pk_u8_f32(v1[2] * 256.f - 0.5f, 2, b); b = __builtin_amdgcn_cvt_pk_u8_f32(v1[3] * 256.f - 0.5f, 3, b);
    w.x = a; w.y = b; return w; }
__device__ __forceinline__ void unpackg8(u32x2 w, f32x4& v0, f32x4& v1) {
    v0 = (f32x4){(float)((w.x >> 0) & 0xffu), (float)((w.x >> 8) & 0xffu), (float)((w.x >> 16) & 0xffu), (float)((w.x >> 24) & 0xffu)} * (1.f / 256.f) + (0.5f / 256.f);
    v1 = (f32x4){(float)((w.y >> 0) & 0xffu), (float)((w.y >> 8) & 0xffu), (float)((w.y >> 16) & 0xffu), (float)((w.y >> 24) & 0xffu)} * (1.f / 256.f) + (0.5f / 256.f); }
struct EpiIn {
    static constexpr bool PERM = true, AFTER_DRAIN = false;
    unsigned char* wsb; unsigned oZX, oQ, oK, oV, oSGA, oSGB; float* ksum; float qscale; const float* rinv;
    __device__ __forceinline__ void operator()(f32x4 (&acc)[2][2][4][2], const Unit& u, int wr, int wc, int fr, int fq) const {
        const int pn = u.pn, row0 = u.pm * BM + wr * 64 + fr;
        unsigned boff; int ldc, colt, mode;
        if (pn < 2) { boff = oZX; ldc = 0; colt = pn * 256; mode = 4; }
        else if (pn < 4) { boff = oQ; ldc = 512; colt = (pn - 2) * 256; mode = 1; }
        else if (pn < 6) { boff = oK; ldc = 512; colt = (pn - 4) * 256; mode = 3; }
        else if (pn < 8) { boff = oV; ldc = 512; colt = (pn - 6) * 256; mode = 0; }
        else if (pn < 12) { boff = oSGA; ldc = 1024; colt = (pn - 8) * 256; mode = 2; }
        else { boff = oSGB; ldc = 1024; colt = (pn - 12) * 256; mode = 2; }
        bf16_t* base = (bf16_t*)(wsb + boff); bf16_t* ZX = base;
        const int col0 = colt + wc * 32 + 8 * fq;
        const float sc = (mode == 1) ? qscale : 1.0f;
        float rs[2][4];
#pragma unroll
        for (int ai = 0; ai < 2; ++ai)
#pragma unroll
            for (int m = 0; m < 4; ++m) rs[ai][m] = rinv[row0 + ai * HALF + m * 16];
#pragma unroll
        for (int ai = 0; ai < 2; ++ai)
#pragma unroll
            for (int bj = 0; bj < 2; ++bj)
#pragma unroll
                for (int m = 0; m < 4; ++m) { acc[ai][bj][m][0] *= rs[ai][m]; acc[ai][bj][m][1] *= rs[ai][m]; }
        if (mode == 4) {
#pragma unroll
            for (int ai = 0; ai < 2; ++ai)
#pragma unroll
                for (int m = 0; m < 4; ++m) { const int row = row0 + ai * HALF + m * 16, bb = row >> 12, l = row & 4095, c = l >> 4, s_ = l & 15;
#pragma unroll
                    for (int bj = 0; bj < 2; ++bj) { const int col = col0 + bj * HALF, g_ = col >> 4, h0 = col & 15;
                        PG8_ST16(ZX + ((size_t)((g_ * 8 + bb) * 256 + c)) * 384 + s_ * 16 + h0, pack8(acc[ai][bj][m][0], acc[ai][bj][m][1])); } }
            return;
        }
#pragma unroll
        for (int ai = 0; ai < 2; ++ai)
#pragma unroll
            for (int m = 0; m < 4; ++m) { bf16_t* rowp = base + (size_t)(row0 + ai * HALF + m * 16) * ldc + col0;
#pragma unroll
                for (int bj = 0; bj < 2; ++bj) { f32x4 v0 = acc[ai][bj][m][0], v1 = acc[ai][bj][m][1];
                    if (mode == 2) {
#pragma unroll
                        for (int j = 0; j < 4; ++j) { v0[j] = sigmoid_f(v0[j]); v1[j] = sigmoid_f(v1[j]); }
                        *(u32x2*)((unsigned char*)base + (size_t)(row0 + ai * HALF + m * 16) * 1024 + col0 + bj * HALF) = packg8(v0, v1); continue; }
                    else { v0 = v0 * sc; v1 = v1 * sc; }
                    PG8_ST16NT(rowp + bj * HALF, pack8(v0, v1)); } }
        if (mode == 3) {
#pragma unroll
            for (int bj = 0; bj < 2; ++bj)
#pragma unroll
                for (int n = 0; n < 2; ++n) { f32x4 s = (f32x4){0.f, 0.f, 0.f, 0.f};
#pragma unroll
                    for (int ai = 0; ai < 2; ++ai)
#pragma unroll
                        for (int m = 0; m < 4; ++m) s += acc[ai][bj][m][n];
#pragma unroll
                    for (int j = 0; j < 4; ++j) { float t = s[j]; t += __shfl_xor(t, 1); t += __shfl_xor(t, 2); t += __shfl_xor(t, 4); t += __shfl_xor(t, 8);
                        if (fr == 0) atomicAdd(ksum + (size_t)u.pm * 512 + col0 + bj * HALF + 4 * n + j, t); } }
        }
    }
};
struct EpiGlu {
    static constexpr bool PERM = true, AFTER_DRAIN = false;
    const bf16_t* VS; bf16_t* YA; const float* bias;
    __device__ __forceinline__ void operator()(const f32x4 (&acc)[2][2][4][2], const Unit& u, int wr, int wc, int fr, int fq) const {
        const int row0 = u.pm * BM + wr * 64 + fr, col0 = u.pn * BM + wc * 32 + 8 * fq;
        f32x4 bv[2][2];
#pragma unroll
        for (int bj = 0; bj < 2; ++bj)
#pragma unroll
            for (int n = 0; n < 2; ++n) bv[bj][n] = *(const f32x4*)(bias + col0 + bj * HALF + 4 * n);
#pragma unroll
        for (int ai = 0; ai < 2; ++ai)
#pragma unroll
            for (int m = 0; m < 4; ++m) { const size_t off = (size_t)(row0 + ai * HALF + m * 16) * 512 + col0;
#pragma unroll
                for (int bj = 0; bj < 2; ++bj) { f32x4 v0 = acc[ai][bj][m][0] + bv[bj][0], v1 = acc[ai][bj][m][1] + bv[bj][1];
                    f32x4 a0, a1; unpack8(*(const u32x4*)(VS + off + bj * HALF), a0, a1);
#pragma unroll
                    for (int j = 0; j < 4; ++j) { v0[j] = a0[j] * sigmoid_f(v0[j]); v1[j] = a1[j] * sigmoid_f(v1[j]); }
                    PG8_ST16(YA + off + bj * HALF, pack8(v0, v1)); } }
    }
};
template <bool ADD> struct EpiGate {
    static constexpr bool PERM = true, AFTER_DRAIN = false;
    const bf16_t* G; bf16_t* O;
    __device__ __forceinline__ void operator()(const f32x4 (&acc)[2][2][4][2], const Unit& u, int wr, int wc, int fr, int fq) const {
        const int row0 = u.pm * BM + wr * 64 + fr, col0 = u.pn * BM + wc * 32 + 8 * fq;
#pragma unroll
        for (int ai = 0; ai < 2; ++ai)
#pragma unroll
            for (int m = 0; m < 4; ++m) { const size_t off = (size_t)(row0 + ai * HALF + m * 16) * 1024 + col0;
#pragma unroll
                for (int bj = 0; bj < 2; ++bj) { f32x4 g0, g1; unpack8(*(const u32x4*)(G + off + bj * HALF), g0, g1);
                    f32x4 v0 = acc[ai][bj][m][0] * g0, v1 = acc[ai][bj][m][1] * g1;
                    if (ADD) { f32x4 p0, p1; unpack8(*(const u32x4*)(O + off + bj * HALF), p0, p1); v0 += p0; v1 += p1; }
                    PG8_ST16(O + off + bj * HALF, pack8(v0, v1)); } }
    }
};
struct BranchOrder {
    static constexpr bool KEEPS = true;
    StaticOrder base; long aoff1, boff1;
    __device__ __forceinline__ bool next(int i, Unit& u) const { if (!base.next(i >> 1, u)) return false; u.sub = i & 1; u.keep = (i & 1) ^ 1; u.aoff = (i & 1) ? aoff1 : 0; u.boff = (i & 1) ? boff1 : 0; return true; }
    __device__ __forceinline__ void a_ready(const Unit&) const {}
    __device__ __forceinline__ void done(const Unit&) const {}
};
struct EpiGate2 {
    static constexpr bool PERM = true, AFTER_DRAIN = false;
    const unsigned char* GA; const unsigned char* GB; bf16_t* O;
    __device__ __forceinline__ void operator()(f32x4 (&acc)[2][2][4][2], const Unit& u, int wr, int wc, int fr, int fq) const {
        const int row0 = u.pm * BM + wr * 64 + fr, col0 = u.pn * BM + wc * 32 + 8 * fq;
        if (u.sub == 0) {
#pragma unroll
            for (int ai = 0; ai < 2; ++ai)
#pragma unroll
                for (int m = 0; m < 4; ++m)
#pragma unroll
                    for (int bj = 0; bj < 2; ++bj) { const size_t off = (size_t)(row0 + ai * HALF + m * 16) * 1024 + col0 + bj * HALF;
                        f32x4 a0, a1, b0, b1; unpackg8(*(const u32x2*)(GA + off), a0, a1); unpackg8(*(const u32x2*)(GB + off), b0, b1);
#pragma unroll
                        for (int j = 0; j < 4; ++j) { acc[ai][bj][m][0][j] *= b0[j] * __builtin_amdgcn_rcpf(fmaxf(a0[j], 1e-30f)); acc[ai][bj][m][1][j] *= b1[j] * __builtin_amdgcn_rcpf(fmaxf(a1[j], 1e-30f)); } }
        } else {
#pragma unroll
            for (int ai = 0; ai < 2; ++ai) { u32x2 gv[4][2];
#pragma unroll
                for (int m = 0; m < 4; ++m)
#pragma unroll
                    for (int bj = 0; bj < 2; ++bj) gv[m][bj] = *(const u32x2*)(GA + (size_t)(row0 + ai * HALF + m * 16) * 1024 + col0 + bj * HALF);
#pragma unroll
                for (int m = 0; m < 4; ++m)
#pragma unroll
                    for (int bj = 0; bj < 2; ++bj) { f32x4 g0, g1; unpackg8(gv[m][bj], g0, g1);
                        PG8_ST16(O + (size_t)(row0 + ai * HALF + m * 16) * 1024 + col0 + bj * HALF, pack8(acc[ai][bj][m][0] * g0, acc[ai][bj][m][1] * g1)); }
                asm volatile("" ::: "memory"); }
        }
    }
};
struct EpiRelu2 {
    static constexpr bool PERM = true, AFTER_DRAIN = false;
    bf16_t* O; int ldc;
    __device__ __forceinline__ void operator()(const f32x4 (&acc)[2][2][4][2], const Unit& u, int wr, int wc, int fr, int fq) const {
        const int row0 = u.pm * BM + wr * 64 + fr, col0 = u.pn * BM + wc * 32 + 8 * fq;
#pragma unroll
        for (int ai = 0; ai < 2; ++ai)
#pragma unroll
            for (int m = 0; m < 4; ++m) { bf16_t* rowp = O + (size_t)(row0 + ai * HALF + m * 16) * ldc + col0;
#pragma unroll
                for (int bj = 0; bj < 2; ++bj) { f32x4 v0 = acc[ai][bj][m][0], v1 = acc[ai][bj][m][1];
#pragma unroll
                    for (int j = 0; j < 4; ++j) { const float a = fmaxf(v0[j], 0.f), b = fmaxf(v1[j], 0.f); v0[j] = a * a; v1[j] = b * b; }
                    PG8_ST16NT(rowp + bj * HALF, pack8(v0, v1)); } }
    }
};

struct EpiRelu2T {
    static constexpr bool PERM = true, AFTER_DRAIN = false;
    bf16_t* O; int ktiles; const float* rinv;
    __device__ __forceinline__ void operator()(const f32x4 (&acc)[2][2][4][2], const Unit& u, int wr, int wc, int fr, int fq) const {
        bf16_t* base = O + ((size_t)u.pm * ktiles + (size_t)u.pn * 4 + (wc >> 1)) * (256 * 64) + (size_t)(wr * 64 + fr) * 64 + (wc & 1) * 32 + 8 * fq;
        float r2[2][4];
#pragma unroll
        for (int ai = 0; ai < 2; ++ai)
#pragma unroll
            for (int m = 0; m < 4; ++m) { const float r = rinv[u.pm * BM + wr * 64 + fr + ai * HALF + m * 16]; r2[ai][m] = r * r; }
#pragma unroll
        for (int ai = 0; ai < 2; ++ai)
#pragma unroll
            for (int m = 0; m < 4; ++m)
#pragma unroll
                for (int bj = 0; bj < 2; ++bj) { f32x4 v0 = acc[ai][bj][m][0], v1 = acc[ai][bj][m][1];
#pragma unroll
                    for (int j = 0; j < 4; ++j) { const float a = fmaxf(v0[j], 0.f), b = fmaxf(v1[j], 0.f); v0[j] = a * a * r2[ai][m]; v1[j] = b * b * r2[ai][m]; }
                    PG8_ST16(base + (size_t)bj * 2 * (256 * 64) + (size_t)(ai * HALF + m * 16) * 64, pack8(v0, v1)); }
    }
};
struct OneUnit {
    static constexpr bool KEEPS = false;
    int pm, pn;
    __device__ __forceinline__ bool next(int i, Unit& u) const { if (i) return false; u.pm = pm; u.pn = pn; return true; }
    __device__ __forceinline__ void a_ready(const Unit&) const {}
    __device__ __forceinline__ void done(const Unit&) const {}
};
struct EpiSsmState {
    static constexpr bool PERM = false, AFTER_DRAIN = true;
    bf16_t* ZXr;
    const float *a16r, *a16i, *a512r, *a512i;
    __device__ __forceinline__ void fused(f32x4 (&acc)[2][2][4][2], const Unit& u, int wr, int wc, int fr, int fq, PG8_LAS unsigned char* lds, int wid, int lane) const {
        PG8_LAS float* S = (PG8_LAS float*)lds;
        PG8_LAS float* E = (PG8_LAS float*)(lds + 132096);
        PG8_LAS float* CI = (PG8_LAS float*)(lds + 132096 + 4096);
#pragma unroll
        for (int ai = 0; ai < 2; ++ai)
#pragma unroll
            for (int m = 0; m < 4; ++m)
#pragma unroll
                for (int n = 0; n < 2; ++n) { const int row = ai * HALF + wr * 64 + m * 16 + fr, col = wc * 32 + n * 16 + 4 * fq;
                    *(PG8_LAS f32x4*)(S + row * 128 + ((col + 4 * row) & 127)) = acc[ai][0][m][n]; }
        asm volatile("s_waitcnt lgkmcnt(0)" ::: "memory"); __builtin_amdgcn_s_barrier(); asm volatile("" ::: "memory");
        const int p = lane, seg = wid;
        const float ar = a16r[p], ai_ = a16i[p];
        { float sr[32], si[32];
#pragma unroll
          for (int k = 0; k < 32; ++k) { const int c = seg * 32 + k; sr[k] = S[c * 128 + ((p + 4 * c) & 127)]; si[k] = S[c * 128 + ((64 + p + 4 * c) & 127)]; }
          float hr = 0.f, hi = 0.f;
#pragma unroll
          for (int k = 0; k < 32; ++k) { const int c = seg * 32 + k; const float tr = sr[k], ti = si[k];
              S[c * 128 + ((p + 4 * c) & 127)] = hr; S[c * 128 + ((64 + p + 4 * c) & 127)] = hi;
              const float nr = ar * hr - ai_ * hi + tr, ni = ar * hi + ai_ * hr + ti; hr = nr; hi = ni; }
          E[seg * 128 + p] = hr; E[seg * 128 + 64 + p] = hi; }
        asm volatile("s_waitcnt lgkmcnt(0)" ::: "memory"); __builtin_amdgcn_s_barrier(); asm volatile("" ::: "memory");
        if (wid == 0) { const float br = a512r[p], bi = a512i[p]; float cr = 0.f, ci = 0.f;
#pragma unroll
            for (int sg = 0; sg < 8; ++sg) { CI[sg * 128 + p] = cr; CI[sg * 128 + 64 + p] = ci; const float er = E[sg * 128 + p], ei = E[sg * 128 + 64 + p];
                const float nr = br * cr - bi * ci + er, ni = br * ci + bi * cr + ei; cr = nr; ci = ni; } }
        asm volatile("s_waitcnt lgkmcnt(0)" ::: "memory"); __builtin_amdgcn_s_barrier(); asm volatile("" ::: "memory");
        { float wr_ = CI[seg * 128 + p], wi_ = CI[seg * 128 + 64 + p];
          float sr[32], si[32];
#pragma unroll
          for (int k = 0; k < 32; ++k) { const int c = seg * 32 + k; sr[k] = S[c * 128 + ((p + 4 * c) & 127)]; si[k] = S[c * 128 + ((64 + p + 4 * c) & 127)]; }
#pragma unroll
          for (int k = 0; k < 32; ++k) { const int c = seg * 32 + k; const float hr = sr[k] + wr_, hi = si[k] + wi_;
              bf16_t* o = ZXr + (size_t)c * 384 + 256 + p;
              o[0] = (bf16_t)(cvt_pk_bf16(hr, hr) & 0xffffu); o[64] = (bf16_t)(cvt_pk_bf16(hi, hi) & 0xffffu);
              const float nr = ar * wr_ - ai_ * wi_, ni = ar * wi_ + ai_ * wr_; wr_ = nr; wi_ = ni; } }
    }
};
__device__ __forceinline__ float gelu_tanh_f(float x) {
    const float u = 0.7978845608028654f * (x + 0.044715f * x * x * x);
    const float e = __builtin_amdgcn_exp2f(-2.885390081777927f * fabsf(u));
    const float t = (1.0f - e) * __builtin_amdgcn_rcpf(1.0f + e);
    return 0.5f * x * (1.0f + (u < 0.f ? -t : t));
}
struct EpiSsmOut {
    static constexpr bool PERM = true, AFTER_DRAIN = false;
    const bf16_t* ZXr; bf16_t* VSb; const float* dsk;
    __device__ __forceinline__ void operator()(const f32x4 (&acc)[2][2][4][2], const Unit& u, int wr, int wc, int fr, int fq) const {
        const int r0 = wr * 64 + fr, c0 = wc * 32 + 8 * fq;
#pragma unroll
        for (int bj = 0; bj < 2; ++bj) { const int col = c0 + bj * HALF, t = col >> 4, h0 = col & 15;
            const f32x4 d0 = *(const f32x4*)(dsk + h0), d1 = *(const f32x4*)(dsk + h0 + 4);
#pragma unroll
            for (int ai = 0; ai < 2; ++ai)
#pragma unroll
                for (int m = 0; m < 4; ++m) { const int r = r0 + ai * HALF + m * 16;
                    f32x4 u0, u1; unpack8(*(const u32x4*)(ZXr + (size_t)r * 384 + col), u0, u1);
                    f32x4 v0 = acc[ai][bj][m][0] + d0 * u0, v1 = acc[ai][bj][m][1] + d1 * u1;
#pragma unroll
                    for (int j = 0; j < 4; ++j) { v0[j] = gelu_tanh_f(v0[j]); v1[j] = gelu_tanh_f(v1[j]); }
                    PG8_ST16(VSb + (size_t)(r * 16 + t) * 512 + h0, pack8(v0, v1)); } }
    }
};
template <class Epi, class Sched, bool ALIGN_EPI = false, bool SP2 = false>
__device__ __forceinline__ void gemm_phase(PG8_LAS unsigned char* lds, const Gemm g, const Sched& S, const Epi& E) {
    const int tid = threadIdx.x, wid = __builtin_amdgcn_readfirstlane(tid >> 6), lane = tid & 63, wr = wid >> 2, wc = wid & 3, fr = lane & 15, fq = lane >> 4;
    const int K = g.K, nt = K / BK;
    unsigned voffA[2], voffB[2];
#pragma unroll
    for (int i = 0; i < 2; ++i) { int R, C; stage_rc(tid * 16 + i * 8192, R, C); const int Rb = Epi::PERM ? ((R & ~31) + perm32(R & 31)) : R;
        voffA[i] = (unsigned)(R * g.lda + C) * 2u; voffB[i] = (unsigned)(Rb * g.ldb + C) * 2u; }
    const size_t ksA = g.ksa ? (size_t)g.ksa : (size_t)(BK * 2), ksB = (size_t)(BK * 2);
    const size_t hsA = (size_t)HALF * g.lda * 2, hsB = (size_t)HALF * g.ldb * 2;
    const size_t tsA = g.tsa ? (size_t)g.tsa : 2 * hsA, tsB = 2 * hsB;
    const unsigned ldsw = (unsigned)wid * 1024u;
    const int aoff = lds_byte(wr * 64 + fr, fq * 8), boff = lds_byte(wc * 32 + fr, fq * 8);
#define PG8_SA(b, h) (((b) * 2 + (h)) * HTB)
#define PG8_SB(b, h) ((4 + (b) * 2 + (h)) * HTB)
#define PG8_STAGE(bufoff, gbase, voff) do { _Pragma("unroll") for (int _i = 0; _i < 2; ++_i) \
        __builtin_amdgcn_global_load_lds((const unsigned*)((const char*)(gbase) + (voff)[_i]), (PG8_LAS unsigned*)(lds + (bufoff) + ldsw + _i * 8192), 16, 0, 0); } while (0)
#define PG8_LDA(dst, b, h) do { _Pragma("unroll") for (int m = 0; m < 4; ++m) _Pragma("unroll") for (int k = 0; k < 2; ++k) dst[m][k] = *(const PG8_LAS bf16x8*)(lds + PG8_SA(b, h) + aoff + m * 2048 + k * 1024); } while (0)
#define PG8_LDB(dst, b, h) do { _Pragma("unroll") for (int n = 0; n < 2; ++n) _Pragma("unroll") for (int k = 0; k < 2; ++k) dst[n][k] = *(const PG8_LAS bf16x8*)(lds + PG8_SB(b, h) + boff + n * 2048 + k * 1024); } while (0)
#define PG8_MMA(ai, bj, At, Bt) do { __builtin_amdgcn_s_setprio(1); _Pragma("unroll") for (int m = 0; m < 4; ++m) _Pragma("unroll") for (int n = 0; n < 2; ++n) _Pragma("unroll") for (int k = 0; k < 2; ++k) \
        acc[ai][bj][m][n] = __builtin_amdgcn_mfma_f32_16x16x32_bf16(Bt[n][k], At[m][k], acc[ai][bj][m][n], 0, 0, 0); __builtin_amdgcn_s_setprio(0); } while (0)
#define PG8_WAIT_V(n) asm volatile("s_waitcnt vmcnt(" #n ")" ::: "memory")
#define PG8_WAIT_L(n) asm volatile("s_waitcnt lgkmcnt(" #n ")" ::: "memory")
#define PG8_BAR __builtin_amdgcn_s_barrier()
#define PG8_SCHED __builtin_amdgcn_sched_barrier(0)
    Unit cur, nxt; int ui = 0;
    if (!S.next(0, cur)) return;
    f32x4 acc[2][2][4][2];
#pragma unroll
    for (int a = 0; a < 2; ++a)
#pragma unroll
        for (int b = 0; b < 2; ++b)
#pragma unroll
            for (int m = 0; m < 4; ++m)
#pragma unroll
                for (int n = 0; n < 2; ++n) acc[a][b][m][n] = (f32x4){0.f, 0.f, 0.f, 0.f};
    bf16x8 At[4][2], B0[2][2], B1[2][2];
    const char* cA = (const char*)g.A + (size_t)cur.pm * tsA + cur.aoff; const char* cB = (const char*)g.Bt + (size_t)cur.pn * tsB + cur.boff;
    S.a_ready(cur);
    if constexpr (SP2) {
        PG8_STAGE(PG8_SB(0, 0), cB, voffB); PG8_STAGE(PG8_SB(0, 1), cB + hsB, voffB); PG8_STAGE(PG8_SA(0, 0), cA, voffA); PG8_STAGE(PG8_SA(0, 1), cA + hsA, voffA);
        if (wr == 1) PG8_BAR;
        PG8_WAIT_V(2); PG8_BAR;
        PG8_STAGE(PG8_SB(1, 0), cB + ksB, voffB); PG8_STAGE(PG8_SA(1, 0), cA + ksA, voffA); PG8_STAGE(PG8_SB(1, 1), cB + hsB + ksB, voffB);
        PG8_WAIT_V(6); PG8_BAR;
    } else {
        PG8_STAGE(PG8_SB(0, 0), cB, voffB); PG8_STAGE(PG8_SA(0, 0), cA, voffA); PG8_STAGE(PG8_SB(0, 1), cB + hsB, voffB); PG8_STAGE(PG8_SA(0, 1), cA + hsA, voffA);
        if (wr == 1) PG8_BAR;
        PG8_WAIT_V(4); PG8_BAR;
        PG8_STAGE(PG8_SB(1, 0), cB + ksB, voffB); PG8_STAGE(PG8_SA(1, 0), cA + ksA, voffA); PG8_STAGE(PG8_SB(1, 1), cB + hsB + ksB, voffB);
        PG8_WAIT_V(6); PG8_BAR;
    }
    for (;;) {
        const bool has_next = S.next(ui + 1, nxt);
        const char* nA = has_next ? (const char*)g.A + (size_t)nxt.pm * tsA + nxt.aoff : cA; const char* nB = has_next ? (const char*)g.Bt + (size_t)nxt.pn * tsB + nxt.boff : cB;
        for (int t = 0; t < nt; t += 2) {
            const bool last = (t == nt - 2);
            const char* a1 = cA + (size_t)(t + 1) * ksA;
            const char* a2 = last ? nA : cA + (size_t)(t + 2) * ksA; const char* b2 = last ? nB : cB + (size_t)(t + 2) * ksB;
            const char* a3 = a2 + ksA; const char* b3 = b2 + ksB;
            if (last && has_next) S.a_ready(nxt);
            if constexpr (SP2) {
            PG8_LDB(B0, 0, 0); PG8_LDB(B1, 0, 1); PG8_SCHED; PG8_LDA(At, 0, 0); PG8_STAGE(PG8_SA(1, 1), a1 + hsA, voffA);
            PG8_WAIT_V(8); PG8_WAIT_L(0); PG8_BAR; PG8_MMA(0, 0, At, B0); PG8_MMA(0, 1, At, B1); PG8_BAR; PG8_SCHED;
            PG8_LDA(At, 0, 1); PG8_STAGE(PG8_SB(0, 0), b2, voffB); PG8_STAGE(PG8_SB(0, 1), b2 + hsB, voffB); PG8_STAGE(PG8_SA(0, 0), a2, voffA);
            PG8_WAIT_V(8); PG8_WAIT_L(0); PG8_BAR; PG8_MMA(1, 0, At, B0); PG8_MMA(1, 1, At, B1); PG8_BAR; PG8_SCHED;
            PG8_LDB(B0, 1, 0); PG8_LDB(B1, 1, 1); PG8_SCHED; PG8_LDA(At, 1, 0); PG8_STAGE(PG8_SA(0, 1), a2 + hsA, voffA);
            PG8_WAIT_V(8); PG8_WAIT_L(0); PG8_BAR; PG8_MMA(0, 0, At, B0); PG8_MMA(0, 1, At, B1); PG8_BAR; PG8_SCHED;
            PG8_LDA(At, 1, 1); PG8_STAGE(PG8_SB(1, 0), b3, voffB); PG8_STAGE(PG8_SB(1, 1), b3 + hsB, voffB); PG8_STAGE(PG8_SA(1, 0), a3, voffA);
            PG8_WAIT_V(8); PG8_WAIT_L(0); PG8_BAR; PG8_MMA(1, 0, At, B0); PG8_MMA(1, 1, At, B1); PG8_BAR; PG8_SCHED;
            } else {
            PG8_LDB(B0, 0, 0); PG8_SCHED; PG8_LDA(At, 0, 0); PG8_STAGE(PG8_SA(1, 1), a1 + hsA, voffA);
            PG8_WAIT_L(8); PG8_BAR; PG8_WAIT_L(0); PG8_MMA(0, 0, At, B0); PG8_BAR; PG8_SCHED;
            PG8_LDB(B1, 0, 1); PG8_STAGE(PG8_SB(0, 0), b2, voffB);
            PG8_BAR; PG8_WAIT_L(0); PG8_MMA(0, 1, At, B1); PG8_BAR;
            PG8_LDA(At, 0, 1); PG8_STAGE(PG8_SA(0, 0), a2, voffA);
            PG8_BAR; PG8_WAIT_L(0); PG8_MMA(1, 0, At, B0); PG8_BAR; PG8_SCHED;
            PG8_STAGE(PG8_SB(0, 1), b2 + hsB, voffB);
            PG8_WAIT_V(6); PG8_BAR; PG8_MMA(1, 1, At, B1); PG8_BAR;
            PG8_LDB(B0, 1, 0); PG8_SCHED; PG8_LDA(At, 1, 0); PG8_STAGE(PG8_SA(0, 1), a2 + hsA, voffA);
            PG8_WAIT_L(8); PG8_BAR; PG8_WAIT_L(0); PG8_MMA(0, 0, At, B0); PG8_BAR; PG8_SCHED;
            PG8_LDB(B1, 1, 1); PG8_STAGE(PG8_SB(1, 0), b3, voffB);
            PG8_BAR; PG8_WAIT_L(0); PG8_MMA(0, 1, At, B1); PG8_BAR;
            PG8_LDA(At, 1, 1); PG8_STAGE(PG8_SA(1, 0), a3, voffA);
            PG8_BAR; PG8_WAIT_L(0); PG8_MMA(1, 0, At, B0); PG8_BAR; PG8_SCHED;
            PG8_STAGE(PG8_SB(1, 1), b3 + hsB, voffB);
            PG8_WAIT_V(6); PG8_BAR; PG8_MMA(1, 1, At, B1); PG8_BAR;
            }
        }
        if constexpr (ALIGN_EPI) { if (wr == 0) PG8_BAR; }
        if constexpr (!Epi::AFTER_DRAIN) { E(acc, cur, wr, wc, fr, fq); S.done(cur); }
        if (!has_next) break;
        bool zero_ = true; if constexpr (Sched::KEEPS) zero_ = (cur.keep == 0);
        if (zero_) {
#pragma unroll
        for (int a = 0; a < 2; ++a)
#pragma unroll
            for (int b = 0; b < 2; ++b)
#pragma unroll
                for (int m = 0; m < 4; ++m)
#pragma unroll
                    for (int n = 0; n < 2; ++n) acc[a][b][m][n] = (f32x4){0.f, 0.f, 0.f, 0.f};
        }
        cur = nxt; cA = nA; cB = nB; ++ui;
        if constexpr (ALIGN_EPI) { if (wr == 1) PG8_BAR; }
    }
    PG8_WAIT_V(0);
    if constexpr (!ALIGN_EPI) { if (wr == 0) PG8_BAR; }
    PG8_BAR;
    if constexpr (Epi::AFTER_DRAIN) { E.fused(acc, cur, wr, wc, fr, fq, lds, wid, lane); S.done(cur); }
#undef PG8_SA
#undef PG8_SB
#undef PG8_STAGE
#undef PG8_LDA
#undef PG8_LDB
#undef PG8_MMA
#undef PG8_WAIT_V
#undef PG8_WAIT_L
#undef PG8_BAR
#undef PG8_SCHED
}
}
#include <hip/hip_bf16.h>
#include <cmath>
namespace attn_body {
using bf16=__hip_bfloat16;
using bf16x8=__attribute__((ext_vector_type(8)))short;
using s16x4=__attribute__((ext_vector_type(4)))short;
using f32x16=__attribute__((ext_vector_type(16)))float;
using u32x4=__attribute__((ext_vector_type(4)))unsigned;
constexpr int BATCH=8,NHEAD=8,SEQ=4096,D=64,DM=NHEAD*D;
constexpr int NW=8,QBLK=32,QB=QBLK*NW,KVBLK=64,NQB=SEQ/QB;
constexpr int ATTN_PITCH=DM, ATTN_UNIT_ROWS=QB;
__device__ __forceinline__ int crow(int r,int hi){return (r&3)+8*(r>>2)+4*hi;}
#define SBAR() __builtin_amdgcn_sched_barrier(0)
__device__ __forceinline__ void cmask(f32x16&p0,f32x16&p1,int jb,int qrel,int hi){
  const float NEG=-INFINITY; int kb=64*jb+4*hi;
  #pragma unroll
  for(int r=0;r<16;++r){int kv=kb+(r&3)+8*(r>>2); if(kv>qrel)p0[r]=NEG; if(kv+32>qrel)p1[r]=NEG;}
}

constexpr int NSLOT=3, SLOTB=8192;
constexpr int LDS_K=0, LDS_V=NSLOT*SLOTB, LDS_WS=2*NSLOT*SLOTB, LDS_OST=LDS_WS+NW*64*4, LDS_BYTES=LDS_OST+NW*4096;
constexpr float C2=0.125f*1.4426950408889634f;
__device__ __forceinline__ void glds16s(const void*sbase,unsigned voff,unsigned lds_dst){unsigned keep;
  asm volatile("s_mov_b32 %0, m0\n\ts_mov_b32 m0, %2\n\ts_nop 0\n\tglobal_load_lds_dwordx4 %1, %3\n\ts_mov_b32 m0, %0":"=&s"(keep):"v"(voff),"s"(lds_dst),"s"(sbase):"memory");}
__device__ __forceinline__ void glds16(const void*gsrc,unsigned lds_dst){unsigned keep;
  asm volatile("s_mov_b32 %0, m0\n\ts_mov_b32 m0, %2\n\ts_nop 0\n\tglobal_load_lds_dwordx4 %1, off\n\ts_mov_b32 m0, %0":"=&s"(keep):"v"(gsrc),"s"(lds_dst):"memory");}
__device__ __forceinline__ float max3f(float a,float b,float c){float r;asm("v_max3_f32 %0, %1, %2, %3":"=v"(r):"v"(a),"v"(b),"v"(c));return r;}
__device__ __forceinline__ float max2f(float a,float b){float r;asm("v_max_f32_e32 %0, %1, %2":"=v"(r):"v"(a),"v"(b));return r;}
__device__ __forceinline__ float fadd_s(float a,float b){float r;asm("v_add_f32_e32 %0, %1, %2":"=v"(r):"v"(a),"v"(b));return r;}
__device__ __forceinline__ float fsub_s(float a,float b){float r;asm("v_sub_f32_e32 %0, %1, %2":"=v"(r):"v"(a),"v"(b));return r;}
typedef float f32x2_t __attribute__((ext_vector_type(2))); typedef float fv4_t __attribute__((ext_vector_type(4))); typedef __bf16 bf16x2_t __attribute__((ext_vector_type(2)));
__device__ __forceinline__ unsigned cvtpk_s(float lo,float hi){f32x2_t v={lo,hi};bf16x2_t b=__builtin_convertvector(v,bf16x2_t);return __builtin_bit_cast(unsigned,b);}
#define WAIT_BAR(N) asm volatile("s_waitcnt vmcnt(" #N ") lgkmcnt(0)\n\ts_barrier":::"memory")

__device__ __forceinline__ void qkt(f32x16&p0,f32x16&p1,const char*Kslot,const bf16x8*qr,const f32x16&negm,int r32,int hi){
  const char*kb=Kslot+hi*1024+r32*16;
  #pragma unroll
  for(int d0=0;d0<4;++d0){
    const bf16x8 b0=*reinterpret_cast<const bf16x8*>(kb+d0*2048);
    const bf16x8 b1=*reinterpret_cast<const bf16x8*>(kb+d0*2048+512);
    if(d0==0){p0=__builtin_amdgcn_mfma_f32_32x32x16_bf16(b0,qr[0],negm,0,0,0);p1=__builtin_amdgcn_mfma_f32_32x32x16_bf16(b1,qr[0],negm,0,0,0);}
    else{p0=__builtin_amdgcn_mfma_f32_32x32x16_bf16(b0,qr[d0],p0,0,0,0);p1=__builtin_amdgcn_mfma_f32_32x32x16_bf16(b1,qr[d0],p1,0,0,0);}}
}
typedef __attribute__((address_space(3))) const char* lds_cptr;
typedef short v4i16_t __attribute__((ext_vector_type(4)));
__device__ __forceinline__ void kload8(bf16x8*kf,lds_cptr kp){
  kf[0]=*(const __attribute__((address_space(3))) bf16x8*)(kp);      kf[1]=*(const __attribute__((address_space(3))) bf16x8*)(kp+512);
  kf[2]=*(const __attribute__((address_space(3))) bf16x8*)(kp+2048); kf[3]=*(const __attribute__((address_space(3))) bf16x8*)(kp+2560);
  kf[4]=*(const __attribute__((address_space(3))) bf16x8*)(kp+4096); kf[5]=*(const __attribute__((address_space(3))) bf16x8*)(kp+4608);
  kf[6]=*(const __attribute__((address_space(3))) bf16x8*)(kp+6144); kf[7]=*(const __attribute__((address_space(3))) bf16x8*)(kp+6656);
}
__device__ __forceinline__ void kload2(bf16x8*kf,lds_cptr kp,int j){ kf[2*j]=*(const __attribute__((address_space(3))) bf16x8*)(kp+j*2048); kf[2*j+1]=*(const __attribute__((address_space(3))) bf16x8*)(kp+j*2048+512); }
__device__ __forceinline__ s16x4 vtr(lds_cptr p){ return __builtin_bit_cast(s16x4,__builtin_amdgcn_ds_read_tr16_b64_v4i16((__attribute__((address_space(3))) v4i16_t*)p)); }
__device__ __forceinline__ float rowmax(const f32x16&p0,const f32x16&p1){
  float a=max3f(p0[0],p0[1],p1[0]),b=max3f(p0[2],p0[3],p1[1]);a=max3f(a,p1[2],p1[3]);
  #pragma unroll
  for(int r=4;r<16;r+=4){a=max3f(a,p0[r],p0[r+1]);b=max3f(b,p0[r+2],p0[r+3]);a=max3f(a,p1[r],p1[r+1]);b=max3f(b,p1[r+2],p1[r+3]);}
  const float m=max2f(a,b);
  auto rr=__builtin_amdgcn_permlane32_swap(__float_as_uint(m),__float_as_uint(m),false,false);
  return max2f(__uint_as_float(rr[0]),__uint_as_float(rr[1]));
}
__device__ __forceinline__ void pv(f32x16*o,int vb,bf16x8 pa0,bf16x8 pa1,bf16x8 pa2,bf16x8 pa3){
  #pragma unroll
  for(int d0=0;d0<2;++d0){s16x4 lo[4],hi[4];
    #pragma unroll
    for(int ks=0;ks<4;++ks){
      asm volatile("ds_read_b64_tr_b16 %0,%1 offset:%c2":"=&v"(lo[ks]):"v"(vb),"i"(d0*4096+ks*1024):"memory");
      asm volatile("ds_read_b64_tr_b16 %0,%1 offset:%c2":"=&v"(hi[ks]):"v"(vb),"i"(d0*4096+ks*1024+512):"memory");}
    asm volatile("s_waitcnt lgkmcnt(0)":::"memory");SBAR();
    #define PK(k) (bf16x8){lo[k][0],lo[k][1],lo[k][2],lo[k][3],hi[k][0],hi[k][1],hi[k][2],hi[k][3]}
    o[d0]=__builtin_amdgcn_mfma_f32_32x32x16_bf16(pa0,PK(0),o[d0],0,0,0);
    o[d0]=__builtin_amdgcn_mfma_f32_32x32x16_bf16(pa1,PK(1),o[d0],0,0,0);
    o[d0]=__builtin_amdgcn_mfma_f32_32x32x16_bf16(pa2,PK(2),o[d0],0,0,0);
    o[d0]=__builtin_amdgcn_mfma_f32_32x32x16_bf16(pa3,PK(3),o[d0],0,0,0);
    #undef PK
  }
}

#ifndef ATTN_STORE16
#define ATTN_STORE16(p,v) (*(u32x4*)(p)=(v))
#endif
template<int THRL> __device__ __forceinline__ void attn_unit(int b,int h,int qb,const bf16*Q,const bf16*__restrict__ K,const bf16*__restrict__ V,bf16*O,const float*__restrict__ ksum,bool stage,char*shm){
  int tid; asm volatile("v_mov_b32 %0, %1":"=v"(tid):"v"(threadIdx.x));
  const int lane=tid&63,r32=lane&31,hi=lane>>5; const int wid=__builtin_amdgcn_readfirstlane(tid>>6);
  const long rowbase=(long)b*SEQ; const int q0=qb*QB;
  const bf16*Qw=Q+(rowbase+q0+wid*QBLK)*DM+h*D;
  const bf16*Kh=K+rowbase*DM+h*D,*Vh=V+rowbase*DM+h*D;
  const unsigned lds0=(unsigned)(uintptr_t)shm;
  float*wsf=(float*)(shm+LDS_WS)+wid*64;
  const unsigned koff=(unsigned)((lane*DM+wid*8)*2);
  const unsigned voffv=(unsigned)(((16*(wid&3)+(lane>>2))*DM+(wid>>2)*32+(lane&3)*8)*2);
  const unsigned kdst=lds0+LDS_K+wid*1024, vdst=lds0+LDS_V+wid*1024;
  #define DMA_K(t,slot) glds16s(Kh+(long)(t)*KVBLK*DM,koff,(unsigned)__builtin_amdgcn_readfirstlane(kdst+(slot)))
  #define DMA_V(t,slot) glds16s(Vh+(long)(t)*KVBLK*DM,voffv,(unsigned)__builtin_amdgcn_readfirstlane(vdst+(slot)))
  const int vb0=(int)(lds0+LDS_V)+((lane>>4)&1)*32+(lane&3)*8+(4*hi+((lane&15)>>2))*64;
  const char*Kbase=shm+LDS_K; bf16x8 kf[8];
  const lds_cptr shm3=(lds_cptr)shm; const lds_cptr kp0=shm3+LDS_K+hi*1024+r32*16; const lds_cptr vp0=shm3+LDS_V+((lane>>4)&1)*32+(lane&3)*8+(4*hi+((lane&15)>>2))*64;
  const int NT=(q0+QB)/KVBLK;
  DMA_K(0,0);DMA_V(0,0);DMA_K(1,SLOTB);
  bf16x8 qr[4];
  #pragma unroll
  for(int d0=0;d0<4;++d0)qr[d0]=*reinterpret_cast<const bf16x8*>(&Qw[(long)r32*DM+d0*16+hi*8]);
  unsigned selmask=1u<<qb;
  { float qf[32];
    #pragma unroll
    for(int d0=0;d0<4;++d0){
      #pragma unroll
      for(int i=0;i<8;++i)qf[d0*8+i]=__builtin_bit_cast(float,((unsigned)(unsigned short)qr[d0][i])<<16);}
    float g1=-INFINITY,g2=-INFINITY,g3=-INFINITY;int i1=-1,i2=-1,i3=-1;
    if(stage){ const float*kbase=ksum+((long)(b*(SEQ/QB)))*DM+h*D; fv4_t kv[4];
      #pragma unroll
      for(int i=0;i<4;++i){ const int idx=i*64+lane; kv[i]=*reinterpret_cast<const fv4_t*>(kbase+(long)(idx>>4)*DM+(idx&15)*4); }
      __attribute__((address_space(3))) fv4_t*st=(__attribute__((address_space(3))) fv4_t*)((__attribute__((address_space(3))) char*)shm+LDS_BYTES+wid*4096);
      #pragma unroll
      for(int i=0;i<4;++i)st[i*64+lane]=kv[i];
      asm volatile("s_waitcnt lgkmcnt(0)":::"memory"); }
    const __attribute__((address_space(3))) float*kst=(const __attribute__((address_space(3))) float*)((__attribute__((address_space(3))) char*)shm+LDS_BYTES+wid*4096)+hi*8;
    for(int j=0;j<qb;++j){
      const __attribute__((address_space(3))) float*ks=kst+j*64; float gt=0.f;
      #pragma unroll
      for(int d0=0;d0<4;++d0){ const fv4_t k0=*reinterpret_cast<const __attribute__((address_space(3))) fv4_t*>(ks+d0*16),k1=*reinterpret_cast<const __attribute__((address_space(3))) fv4_t*>(ks+d0*16+4);
        gt+=qf[d0*8+0]*k0[0]+qf[d0*8+1]*k0[1]+qf[d0*8+2]*k0[2]+qf[d0*8+3]*k0[3]+qf[d0*8+4]*k1[0]+qf[d0*8+5]*k1[1]+qf[d0*8+6]*k1[2]+qf[d0*8+7]*k1[3];}
      gt+=__shfl_xor(gt,32);
      if(gt>g1){g3=g2;i3=i2;g2=g1;i2=i1;g1=gt;i1=j;} else if(gt>g2){g3=g2;i3=i2;g2=gt;i2=j;} else if(gt>g3){g3=gt;i3=j;}
    }
    if(i1>=0)selmask|=1u<<i1; if(i2>=0)selmask|=1u<<i2; if(i3>=0)selmask|=1u<<i3; }
  bf16x8 kx=bf16x8{}; kx[0]=(short)(hi?0:0x3F80); bf16x8 qx0=bf16x8{}; asm volatile("":"+v"(kx),"+v"(qx0));
  float mhat=0.f,l_reg=0.f;f32x16 o[2];o[0]=f32x16{};o[1]=f32x16{};f32x16 negm=f32x16{};asm volatile("":"+v"(negm));
  const int qrel=wid*QBLK+r32;
  #define CMASK(P0,P1,t) do{int jb_=(t)-(NT-4); if(jb_>=0)cmask(P0,P1,jb_,qrel,hi);}while(0)
  bool resc=false;
  #define START(P0,P1) do{ float rm=rowmax(P0,P1); resc=false; \
    { const float dl=__builtin_fmaxf(rm,-64.f); mhat=fadd_s(mhat,dl); \
      _Pragma("unroll") for(int r=0;r<16;++r){P0[r]=fsub_s(P0[r],dl);P1[r]=fsub_s(P1[r],dl);} \
      _Pragma("unroll") for(int r=0;r<16;++r)negm[r]=-mhat; asm volatile("":"+v"(negm)); } \
    _Pragma("unroll") for(int r=0;r<16;++r)P0[r]=__builtin_amdgcn_exp2f(P0[r]); }while(0)
  #define RESC() do{ if(resc){ asm volatile("s_waitcnt lgkmcnt(0)":::"memory"); \
      _Pragma("unroll") for(int d_=0;d_<2;++d_) _Pragma("unroll") for(int r=0;r<16;++r)o[d_][r]*=wsf[crow(r,hi)]; } }while(0)
  f32x16 pA0,pA1,pB0,pB1;
  int sl_prev=0,sl_cur=0,sl_next=SLOTB;
  #define ROT() do{sl_prev=sl_cur;sl_cur=sl_next;sl_next=(sl_next==(NSLOT-1)*SLOTB)?0:sl_next+SLOTB;}while(0)
  DMA_K(2,2*SLOTB);
  WAIT_BAR(3);
  qkt(pA0,pA1,Kbase,qr,negm,r32,hi);asm volatile("s_nop 15\n\ts_nop 7":"+v"(pA0),"+v"(pA1));CMASK(pA0,pA1,0);
  if(!(selmask&1u)){ _Pragma("unroll") for(int r=0;r<16;++r){pA0[r]-=30000.f;pA1[r]-=30000.f;} }
  START(pA0,pA1);
  _Pragma("unroll") for(int r=0;r<16;++r)pA1[r]=__builtin_amdgcn_exp2f(pA1[r]);
  WAIT_BAR(0);
  DMA_K(3,0);DMA_V(1,SLOTB);
  ROT();
  kload8(kf,kp0+sl_cur);
  WAIT_BAR(2);
  s16x4 vlo[8],vhi[8]; u32x4 pw0,pw1,pw2,pw3;
  #define PKW(P,B) cvtpk_s(P[B],P[B+1])
  #define PAF(k) __builtin_bit_cast(bf16x8,pw##k)
  #define VFR(i) (bf16x8){vlo[i][0],vlo[i][1],vlo[i][2],vlo[i][3],vhi[i][0],vhi[i][1],vhi[i][2],vhi[i][3]}
  #define PIN(x) asm volatile("":"+v"(x))
  #define MX3(a,b,c) __builtin_fmaxf(__builtin_fmaxf((a),(b)),(c))
  #define GAPA(MF,A0,A1,A2,A3,W0,W1,PW) do{ MF; sacc+=A0; sacc+=A1; sacc+=A2; sacc+=A3; PIN(sacc); W0; W1; PIN(PW); SBAR(); }while(0)
  #define EX(v) __builtin_amdgcn_exp2f(v)
  #define GAPB(MF,X,B) do{ MF; X[B]=EX(X[B]); X[B+1]=EX(X[B+1]); X[B+2]=EX(X[B+2]); X[B+3]=EX(X[B+3]); PIN(X); SBAR(); }while(0)
  #define VRD(i) do{ vlo[i]=vtr(vp_+(((i)>>2)*4096+((i)&3)*1024)); vhi[i]=vtr(vp_+(((i)>>2)*4096+((i)&3)*1024+512)); }while(0)
  #define KRD(G,j) do{ if(G){ kload2(kf,kp0+sl_next,j); SBAR(); } }while(0)
  #define STEP(C0,C1,P0,P1,t,GK,GV,GL) do{ SBAR(); \
    const lds_cptr vp_=vp0+sl_prev; \
    VRD(0); SBAR(); float sacc=(P0[0]+P0[1]); \
    GAPA(C0=__builtin_amdgcn_mfma_f32_32x32x16_bf16(kf[0],qr[0],negm,0,0,0), P0[2],P0[3],P0[4],P0[5],     pw0[0]=PKW(P0,0), pw0[1]=PKW(P0,2), pw0); \
    VRD(4); SBAR(); GAPA(C1=__builtin_amdgcn_mfma_f32_32x32x16_bf16(kf[1],qr[0],negm,0,0,0), P0[6],P0[7],P0[8],P0[9],     pw0[2]=PKW(P0,4), pw0[3]=PKW(P0,6), pw0); \
    VRD(1); SBAR(); GAPA(C0=__builtin_amdgcn_mfma_f32_32x32x16_bf16(kf[2],qr[1],C0,0,0,0),   P0[10],P0[11],P0[12],P0[13], pw1[0]=PKW(P0,8), pw1[1]=PKW(P0,10), pw1); \
    VRD(5); SBAR(); GAPA(C1=__builtin_amdgcn_mfma_f32_32x32x16_bf16(kf[3],qr[1],C1,0,0,0),   P0[14],P0[15],P1[0],P1[1],   pw1[2]=PKW(P0,12),pw1[3]=PKW(P0,14), pw1); \
    VRD(2); SBAR(); GAPA(C0=__builtin_amdgcn_mfma_f32_32x32x16_bf16(kf[4],qr[2],C0,0,0,0),   P1[2],P1[3],P1[4],P1[5],     pw2[0]=PKW(P1,0), pw2[1]=PKW(P1,2), pw2); \
    VRD(6); SBAR(); GAPA(C1=__builtin_amdgcn_mfma_f32_32x32x16_bf16(kf[5],qr[2],C1,0,0,0),   P1[6],P1[7],P1[8],P1[9],     pw2[2]=PKW(P1,4), pw2[3]=PKW(P1,6), pw2); \
    VRD(3); SBAR(); GAPA(C0=__builtin_amdgcn_mfma_f32_32x32x16_bf16(kf[6],qr[3],C0,0,0,0),   P1[10],P1[11],P1[12],P1[13], pw3[0]=PKW(P1,8), pw3[1]=PKW(P1,10), pw3); \
    VRD(7); SBAR(); GAPA(C1=__builtin_amdgcn_mfma_f32_32x32x16_bf16(kf[7],qr[3],C1,0,0,0),   P1[14],P1[15],0.f,0.f,       pw3[2]=PKW(P1,12),pw3[3]=PKW(P1,14), pw3); \
    l_reg+=sacc; \
    { const unsigned mw_=((selmask>>((t)>>2))&1u)?0u:0xC6EAu; bf16x8 qx_=qx0; qx_[0]=(short)(hi?0u:mw_); \
      C0=__builtin_amdgcn_mfma_f32_32x32x16_bf16(kx,qx_,C0,0,0,0); C1=__builtin_amdgcn_mfma_f32_32x32x16_bf16(kx,qx_,C1,0,0,0); } \
    if(GK){DMA_K((t)+3,sl_cur);} if(GV){DMA_V((t)+1,sl_next);} \
    CMASK(C0,C1,t); \
    { float a=MX3(C0[0],C0[1],C1[0]),b=MX3(C0[2],C0[3],C1[1]); a=MX3(a,C1[2],C1[3]); \
      _Pragma("unroll") for(int r=4;r<16;r+=4){a=MX3(a,C0[r],C0[r+1]);b=MX3(b,C0[r+2],C0[r+3]);a=MX3(a,C1[r],C1[r+1]);b=MX3(b,C1[r+2],C1[r+3]);} \
      float rm=__builtin_fmaxf(a,b); { auto rr=__builtin_amdgcn_permlane32_swap(__float_as_uint(rm),__float_as_uint(rm),false,false); rm=__builtin_fmaxf(__uint_as_float(rr[0]),__uint_as_float(rr[1])); } \
      resc=false; \
      if(__builtin_expect(__any(rm>(float)THRL),0)){ const float dl=__builtin_fmaxf(rm,0.f); mhat+=dl; \
        _Pragma("unroll") for(int r=0;r<16;++r){C0[r]-=dl;C1[r]-=dl;} \
        _Pragma("unroll") for(int r=0;r<16;++r)negm[r]=-mhat; asm volatile("":"+v"(negm)); \
        const float f=__builtin_amdgcn_exp2f(-dl); l_reg*=f; if(hi==0)wsf[r32]=f; resc=true; } } \
    SBAR(); \
    GAPB(o[0]=__builtin_amdgcn_mfma_f32_32x32x16_bf16(PAF(0),VFR(0),o[0],0,0,0), C0,0); \
    GAPB(o[1]=__builtin_amdgcn_mfma_f32_32x32x16_bf16(PAF(0),VFR(4),o[1],0,0,0), C0,4); \
    KRD(GL,0); GAPB(o[0]=__builtin_amdgcn_mfma_f32_32x32x16_bf16(PAF(1),VFR(1),o[0],0,0,0), C0,8); \
    KRD(GL,1); GAPB(o[1]=__builtin_amdgcn_mfma_f32_32x32x16_bf16(PAF(1),VFR(5),o[1],0,0,0), C0,12); \
    KRD(GL,2); GAPB(o[0]=__builtin_amdgcn_mfma_f32_32x32x16_bf16(PAF(2),VFR(2),o[0],0,0,0), C1,0); \
    KRD(GL,3); GAPB(o[1]=__builtin_amdgcn_mfma_f32_32x32x16_bf16(PAF(2),VFR(6),o[1],0,0,0), C1,4); \
    GAPB(o[0]=__builtin_amdgcn_mfma_f32_32x32x16_bf16(PAF(3),VFR(3),o[0],0,0,0), C1,8); \
    GAPB(o[1]=__builtin_amdgcn_mfma_f32_32x32x16_bf16(PAF(3),VFR(7),o[1],0,0,0), C1,12); \
    }while(0)
  int t=1;
  #undef CMASK
  #define CMASK(P0,P1,t) do{}while(0)
  for(;t+5<NT;t+=2){
    STEP(pB0,pB1,pA0,pA1,t,true,true,true);     WAIT_BAR(2); RESC(); ROT();
    STEP(pA0,pA1,pB0,pB1,t+1,true,true,true);   WAIT_BAR(2); RESC(); ROT();
  }
  #undef CMASK
  #define CMASK(P0,P1,t) do{int jb_=(t)-(NT-4); if(jb_>=0)cmask(P0,P1,jb_,qrel,hi);}while(0)
  #define ENDW(tt) do{ if((tt)+3<NT){WAIT_BAR(2);} else if((tt)+2<NT){WAIT_BAR(1);} else {WAIT_BAR(0);} }while(0)
  for(;t+1<NT;t+=2){
    STEP(pB0,pB1,pA0,pA1,t,(t+3<NT),(t+1<NT),(t+1<NT));       ENDW(t);   RESC(); ROT();
    STEP(pA0,pA1,pB0,pB1,t+1,(t+4<NT),(t+2<NT),(t+2<NT));     ENDW(t+1); RESC(); ROT();
  }
  STEP(pB0,pB1,pA0,pA1,NT-1,false,false,false); RESC();
  { float sacc=pB0[0]+pB0[1]; _Pragma("unroll") for(int r=2;r<16;++r)sacc+=pB0[r]; _Pragma("unroll") for(int r=0;r<16;++r)sacc+=pB1[r]; l_reg+=sacc;
    pw0=(u32x4){PKW(pB0,0),PKW(pB0,2),PKW(pB0,4),PKW(pB0,6)};pw1=(u32x4){PKW(pB0,8),PKW(pB0,10),PKW(pB0,12),PKW(pB0,14)};pw2=(u32x4){PKW(pB1,0),PKW(pB1,2),PKW(pB1,4),PKW(pB1,6)};pw3=(u32x4){PKW(pB1,8),PKW(pB1,10),PKW(pB1,12),PKW(pB1,14)};
    SBAR(); pv(o,vb0+sl_cur,PAF(0),PAF(1),PAF(2),PAF(3)); }
  #undef PKW
  #undef PAF
  #undef VFR
  #undef PIN
  #undef MX3
  #undef GAPA
  #undef GAPB
  #undef EX
  #undef VRD
  #undef KRD
  #undef STEP
  #undef ENDW
  {auto rr=__builtin_amdgcn_permlane32_swap(__float_as_uint(l_reg),__float_as_uint(l_reg),false,false);l_reg=__uint_as_float(rr[0])+__uint_as_float(rr[1]);}
  if(hi==0)wsf[32+r32]=l_reg;asm volatile("s_waitcnt lgkmcnt(0)":::"memory");
  float rli[16];
  #pragma unroll
  for(int r=0;r<16;++r)rli[r]=__builtin_amdgcn_rcpf(wsf[32+crow(r,hi)]);
  bf16*Ow=O+(rowbase+q0+wid*QBLK)*DM+h*D;
  { bf16*stg=(bf16*)(shm+LDS_OST)+wid*2048;
    #pragma unroll
    for(int r=0;r<16;++r){const int orow=crow(r,hi);
      #pragma unroll
      for(int d0=0;d0<2;++d0)stg[orow*64+d0*32+r32]=__float2bfloat16(o[d0][r]*rli[r]);}
    asm volatile("s_waitcnt lgkmcnt(0)":::"memory");
    #pragma unroll
    for(int i=0;i<4;++i){const int row=i*8+(lane>>3),ch=lane&7; const u32x4 v=*(const u32x4*)(stg+row*64+ch*8); ATTN_STORE16(Ow+(long)row*DM+ch*8,v);} }
  asm volatile("s_waitcnt lgkmcnt(0)\n\ts_barrier":::"memory");
  #undef DMA_K
  #undef DMA_V
  #undef CMASK
  #undef START
  #undef RESC
  #undef ROT
}
constexpr int ATTN_LDS_BYTES=LDS_BYTES;
struct AttnTensors { const bf16* Q; const bf16* K; const bf16* V; bf16* O; const float* ksum; };
struct AttnUnit { int bh; int qb; };
struct StaticOrder {
  int vcu,G;
  __device__ __forceinline__ explicit StaticOrder(int grid,int block):vcu((grid%8==0)?(block%8)*(grid/8)+block/8:block),G(grid){}
  __device__ __forceinline__ bool next(int i,AttnUnit&u)const{ if(G!=256){ const int id=i*G+vcu; if(id>=BATCH*NHEAD*NQB)return false; u.bh=id/NQB; u.qb=NQB-1-id%NQB; return true; }
    if(i>=4)return false; const int s=vcu&3; u.bh=vcu>>2; u.qb=(i==0)?15-s:(i==1)?s:(i==2)?11-s:4+s; return true; }
  __device__ __forceinline__ void a_ready(const AttnUnit&)const{}
  __device__ __forceinline__ void done(const AttnUnit&)const{}
};
template<class Sched,int THRL=8> __device__ __forceinline__ void attn_phase(char*lds,const AttnTensors&T,const Sched&S){
  AttnUnit u; int pbh=-1;
  for(int i=0;S.next(i,u);++i){ S.a_ready(u); attn_unit<THRL>(u.bh/NHEAD,u.bh%NHEAD,u.qb,T.Q,T.K,T.V,T.O,T.ksum,(i==0)||(u.bh!=pbh),lds); pbh=u.bh; S.done(u); }
}
#undef SBAR
#undef WAIT_BAR
}
#define GAS __attribute__((address_space(1)))
#define LAS __attribute__((address_space(3)))
typedef unsigned short bf16;
typedef unsigned v4u __attribute__((ext_vector_type(4)));
typedef float f32x4 __attribute__((ext_vector_type(4)));
typedef short bf16x8 __attribute__((ext_vector_type(8)));
typedef GAS unsigned gu32;
typedef GAS unsigned long long gu64;
#define RLX_AGENT __ATOMIC_RELAXED, __HIP_MEMORY_SCOPE_AGENT
#define LDS_WAIT() asm volatile("s_waitcnt lgkmcnt(0)" ::: "memory")
#define VM_WAIT() asm volatile("s_waitcnt vmcnt(0)" ::: "memory")
__device__ __forceinline__ unsigned long long rt() { return __builtin_amdgcn_s_memrealtime(); }
__device__ __forceinline__ unsigned f2bf(float f) { unsigned u = __builtin_bit_cast(unsigned, f); return (u + 0x7fffu + ((u >> 16) & 1u)) >> 16; }
__device__ __forceinline__ unsigned pk2(float lo, float hi) { return f2bf(lo) | (f2bf(hi) << 16); }
#define XB_TMO      128
#define XB_XCNT(j)  (256  + 64 * (j))
#define XB_XSUB(j)  (1280 + 64 * (j))
#define XB_XGEN(j)  (2304 + 64 * (j))
#define XB_TOP      3328
#define XB_TOPGEN   3392
#define XCD_BAR_WORDS 3456
#define XB_SPIN_CAP (1u << 18)

__device__ __forceinline__ unsigned xb_ld(unsigned* p)              { return __hip_atomic_load(p, __ATOMIC_RELAXED, __HIP_MEMORY_SCOPE_AGENT); }
__device__ __forceinline__ unsigned xb_add(unsigned* p, unsigned v) { return __hip_atomic_fetch_add(p, v, __ATOMIC_RELAXED, __HIP_MEMORY_SCOPE_AGENT); }
__device__ __forceinline__ unsigned xb_xcc_id() { return (unsigned)__builtin_amdgcn_s_getreg((3 << 11) | 20) & 0xFu; }
#define XB_SPIN(cond, bar) do { unsigned _sp = 0; while (cond) { __builtin_amdgcn_s_sleep(1); \
    if ((++_sp & 255u) == 0u) { if (xb_ld(&(bar)[XB_TMO])) break; if (_sp > XB_SPIN_CAP) { atomicAdd(&(bar)[XB_TMO], 1u); break; } } } } while (0)

struct XcdBarrier {
    unsigned* bar; unsigned x;
    volatile LAS unsigned* st;
};

__device__ __forceinline__ XcdBarrier xcd_barrier_post(unsigned* bar, volatile LAS unsigned* st) {
    XcdBarrier b; b.bar = bar; b.x = xb_xcc_id(); b.st = st;
    if (threadIdx.x == 0) (void)xb_add(&bar[XB_XCNT(b.x)], 1u);
    return b;
}
__device__ __forceinline__ void xcd_barrier_complete(unsigned* bar, unsigned x, unsigned& nloc, unsigned& nx) {
    const unsigned G = gridDim.x * gridDim.y * gridDim.z;
    unsigned sum, cnt, mine, sp = 0u;
    for (;;) {
        sum = 0u; cnt = 0u; mine = 0u;
#pragma unroll
        for (unsigned j = 0; j < 16; ++j) { const unsigned c = xb_ld(&bar[XB_XCNT(j)]); sum += c; cnt += (c > 0u) ? 1u : 0u; mine = (j == x) ? c : mine; }
        if (sum == G) break;
        __builtin_amdgcn_s_sleep(1);
        if ((++sp & 255u) == 0u) { if (xb_ld(&bar[XB_TMO])) break; if (sp > XB_SPIN_CAP) { atomicAdd(&bar[XB_TMO], 1u); break; } }
    }
    nloc = mine > 0u ? mine : 1u; nx = cnt > 0u ? cnt : 1u;
}

__device__ __forceinline__ void xcd_barrier(const XcdBarrier& b) {
    asm volatile("s_waitcnt vmcnt(0)" ::: "memory");
    __syncthreads();
    if (threadIdx.x == 0) {
        unsigned* bar = b.bar;
        __builtin_amdgcn_s_waitcnt(0);
        unsigned nloc = b.st[0], nx = b.st[1];
        if (nloc == 0u) { xcd_barrier_complete(bar, b.x, nloc, nx); b.st[0] = nloc; b.st[1] = nx; }
        const unsigned old = xb_add(&bar[XB_XSUB(b.x)], 1u);
        const unsigned gen = old / nloc;
        if (old + 1u == (gen + 1u) * nloc) {
            __builtin_amdgcn_fence(__ATOMIC_RELEASE, "agent");
            asm volatile("s_waitcnt vmcnt(0)" ::: "memory");
            const unsigned og = xb_add(&bar[XB_TOP], 1u);
            const unsigned tg = og / nx;
            if (og + 1u == (tg + 1u) * nx) xb_add(&bar[XB_TOPGEN], 1u);
            else XB_SPIN(xb_ld(&bar[XB_TOPGEN]) == tg, bar);
            __builtin_amdgcn_fence(__ATOMIC_ACQUIRE, "agent");
            xb_add(&bar[XB_XGEN(b.x)], 1u);
            asm volatile("s_waitcnt vmcnt(0)" ::: "memory");
        } else {
            XB_SPIN(xb_ld(&bar[XB_XGEN(b.x)]) == gen, bar);
            __builtin_amdgcn_fence(__ATOMIC_ACQUIRE, "agent");
            asm volatile("s_waitcnt vmcnt(0)" ::: "memory");
        }
    }
    __syncthreads();
}
__device__ __forceinline__ float wave_sum(float v) {
#pragma unroll
    for (int o = 1; o < 64; o <<= 1) v += __shfl_xor(v, o);
    return v;
}
__device__ __forceinline__ void p0_transpose_item(const float* W, int K, int N, bf16* WT, int row_off, LAS float* scr, int item, int lane, const float* gk = nullptr) {
    const int nblk = N / 32, kb = item / nblk, nb = item % nblk, k0 = 64 * kb, n0 = 32 * nb;
    float tv[32];
#pragma unroll
    for (int i = 0; i < 32; ++i) { const int kk = 2 * i + (lane >> 5); tv[i] = W[(size_t)(k0 + kk) * N + n0 + (lane & 31)]; }
#pragma unroll
    for (int i = 0; i < 32; ++i) { const int kk = 2 * i + (lane >> 5); scr[kk * 33 + (lane & 31)] = gk ? tv[i] * gk[k0 + kk] : tv[i]; }
    LDS_WAIT(); asm volatile("" ::: "memory");
    const int c = lane & 7;
#pragma unroll
    for (int j = 0; j < 4; ++j) { const int n = (lane >> 3) + 8 * j; const LAS float* s = scr + (8 * c) * 33 + n;
        v4u o; o.x = pk2(s[0 * 33], s[1 * 33]); o.y = pk2(s[2 * 33], s[3 * 33]); o.z = pk2(s[4 * 33], s[5 * 33]); o.w = pk2(s[6 * 33], s[7 * 33]);
        *(GAS v4u*)(WT + (size_t)(row_off + n0 + n) * K + k0 + 8 * c) = o; }
    LDS_WAIT(); asm volatile("" ::: "memory");
}
constexpr int NWAVES = 8;
#ifndef MK_PER_PHASE
#define MK_PER_PHASE 0
#endif
constexpr int NPHASES = 12;

constexpr int BATCH = 8, SEQ = 4096, D = 1024, M = BATCH * SEQ, NIN = 4096, SW = 512, AW = 512;
constexpr int NG = 32, GH = 16, NP = 64, NH = 8, HD = 64, FF = 4096, NBLK = 16, BLK = 256;
constexpr float RMS_EPS = 1e-6f;
constexpr float C2 = 0.125f * 1.4426950408889634f;

constexpr size_t MiB = 1u << 20;
constexpr size_t WS_CTL = 0, CTL_ZERO_BYTES = 1 * MiB;
constexpr size_t WS_KSUM = 512 * 1024;
constexpr size_t WS_TAB = 1 * MiB;
constexpr size_t WS_WIN = 2 * MiB, WS_WGLU = 10 * MiB, WS_WA = 11 * MiB, WS_WB = 12 * MiB, WS_WO = 13 * MiB, WS_W1 = 15 * MiB, WS_W2 = 23 * MiB;
constexpr size_t WS_U = 32 * MiB;
constexpr size_t WS_ZX = 96 * MiB;
constexpr size_t WS_Q = 144 * MiB, WS_K = 176 * MiB, WS_V = 208 * MiB;
constexpr size_t WS_SGA = 240 * MiB, WS_SGB = 272 * MiB;
constexpr size_t WS_XB = 304 * MiB;
constexpr size_t WS_RINV1 = WS_TAB + 512 * 1024, WS_RINV2 = WS_TAB + 640 * 1024;
constexpr size_t WS_VS = 368 * MiB, WS_YA = 400 * MiB;
constexpr size_t WS_MG = 432 * MiB;
constexpr size_t WS_MIX = 368 * MiB;
constexpr size_t WS_HM = 96 * MiB;
constexpr size_t WS_WS = 496 * MiB, WS_KG = 500 * MiB, WS_KM = 506 * MiB;
constexpr size_t WS_END = 507 * MiB;
constexpr int CW_TMO = 0, CW_CODE = 1, CW_BAR = 4096, CW_XL = 65536;

constexpr int RING_OFF = 0, RING_BYTES = 131072;
constexpr int LDSCTL_OFF = RING_BYTES, MISC_OFF = LDSCTL_OFF + 320;
constexpr int LDS_BYTES = 147456;

constexpr int TB_ABR = 0, TB_ABI = 2048, TB_BBR = 4096, TB_BBI = 4096 + 32768, TB_A16R = 4096 + 65536, TB_A16I = TB_A16R + 2048, TB_A512R = TB_A16I + 2048, TB_A512I = TB_A512R + 2048;
#ifndef SKEW_TICKS
#define SKEW_TICKS 0
#endif
#ifndef SSM_NAIVE
#define SSM_NAIVE 0
#endif

__device__ __forceinline__ float bf2f(bf16 v) { return __builtin_bit_cast(float, (unsigned)v << 16); }
__device__ __forceinline__ float gelu_tanh(float x) {
    const float u = 0.7978845608028654f * (x + 0.044715f * x * x * x);
    const float e = __builtin_amdgcn_exp2f(-2.0f * 1.4426950408889634f * fabsf(u));
    const float t = (1.0f - e) * __builtin_amdgcn_rcpf(1.0f + e);
    return 0.5f * x * (1.0f + (u < 0.f ? -t : t));
}

__device__ __forceinline__ void cpowk(double lr, double li, double dt, double k, double& re, double& im) { const double mg = exp(k * lr * dt), an = k * li * dt; re = mg * cos(an); im = mg * sin(an); }
__device__ __forceinline__ void cipow(double ar, double ai, int k, double& re, double& im) { double br = ar, bi = ai; re = 1.0; im = 0.0;
    while (k) { if (k & 1) { const double t = re * br - im * bi; im = re * bi + im * br; re = t; } const double t2 = br * br - bi * bi; bi = 2.0 * br * bi; br = t2; k >>= 1; } }
__device__ __forceinline__ void zoh_from_a(double ar, double ai, double lr, double li, double& cr, double& ci) { const double nr = ar - 1.0, ni = ai, den = lr * lr + li * li; cr = (nr * lr + ni * li) / den; ci = (ni * lr - nr * li) / den; }
__device__ __forceinline__ void zoh_coef(double lr, double li, double dt, double& cr, double& ci) { double ar, ai; cpowk(lr, li, dt, 1.0, ar, ai); const double nr = ar - 1.0, ni = ai, den = lr * lr + li * li; cr = (nr * lr + ni * li) / den; ci = (ni * lr - nr * li) / den; }
__device__ __forceinline__ float reduce16(const float (&v)[16], int lane) {
    float a8[8], a4[4], a2[2], a1;
    { const bool up = (lane & 32) != 0;
#pragma unroll
      for (int j = 0; j < 8; ++j) { const float send = up ? v[j] : v[j + 8]; const float keep = up ? v[j + 8] : v[j]; a8[j] = keep + __shfl_xor(send, 32); } }
    { const bool up = (lane & 16) != 0;
#pragma unroll
      for (int j = 0; j < 4; ++j) { const float send = up ? a8[j] : a8[j + 4]; const float keep = up ? a8[j + 4] : a8[j]; a4[j] = keep + __shfl_xor(send, 16); } }
    { const bool up = (lane & 8) != 0;
#pragma unroll
      for (int j = 0; j < 2; ++j) { const float send = up ? a4[j] : a4[j + 2]; const float keep = up ? a4[j + 2] : a4[j]; a2[j] = keep + __shfl_xor(send, 8); } }
    { const bool up = (lane & 4) != 0; const float send = up ? a2[0] : a2[1]; const float keep = up ? a2[1] : a2[0]; a1 = keep + __shfl_xor(send, 4); }
    a1 += __shfl_xor(a1, 2); a1 += __shfl_xor(a1, 1);
    return a1;
}
#define PH_PTRS GAS unsigned char* wsg_ = (GAS unsigned char*)args.ws; asm volatile("" : "+s"(wsg_)); unsigned char* wsl = (unsigned char*)wsg_;   \
    bf16 *Win_t = (bf16*)(wsl + WS_WIN), *Wglu_t = (bf16*)(wsl + WS_WGLU), *Wa_t = (bf16*)(wsl + WS_WA), *Wb_t = (bf16*)(wsl + WS_WB), *Wo_t = (bf16*)(wsl + WS_WO), *W1_t = (bf16*)(wsl + WS_W1), *W2_t = (bf16*)(wsl + WS_W2); \
    bf16 *U = (bf16*)(wsl + WS_U), *ZX = (bf16*)(wsl + WS_ZX), *Qb = (bf16*)(wsl + WS_Q), *Kb = (bf16*)(wsl + WS_K), *Vb = (bf16*)(wsl + WS_V), *SGA = (bf16*)(wsl + WS_SGA), *SGB = (bf16*)(wsl + WS_SGB); \
    bf16 *VS = (bf16*)(wsl + WS_VS), *YA = (bf16*)(wsl + WS_YA), *MG = (bf16*)(wsl + WS_MG), *MIX = (bf16*)(wsl + WS_MIX), *HM = (bf16*)(wsl + WS_HM); \
    float* ksum = (float*)(wsl + WS_KSUM); float* tab = (float*)(wsl + WS_TAB); bf16* XB = (bf16*)(wsl + WS_XB); float *rinv1 = (float*)(wsl + WS_RINV1), *rinv2 = (float*)(wsl + WS_RINV2); (void)XB; (void)rinv1; (void)rinv2; bf16 *WsT = (bf16*)(wsl + WS_WS), *KG = (bf16*)(wsl + WS_KG); float* KM = (float*)(wsl + WS_KM); \
    const float* x = args.in[0]; float* out = args.out; \
    (void)Win_t; (void)Wglu_t; (void)Wa_t; (void)Wb_t; (void)Wo_t; (void)W1_t; (void)W2_t; (void)U; (void)ZX; (void)Qb; (void)Kb; (void)Vb; (void)SGA; (void)SGB; (void)VS; (void)YA; (void)MG; (void)MIX; (void)HM; (void)ksum; (void)tab; (void)WsT; (void)KG; (void)KM; (void)x; (void)out
struct Args { const float* in[21]; float* out; unsigned char* ws; int ph_lo, ph_hi, li, pad; };

template <int R> __device__ __forceinline__ void rms_rows_to_bf16(const float* x0, size_t rstride, const f32x4 (&gg)[4], bf16* o0, int lane) {
    f32x4 v[R][4];
#pragma unroll
    for (int r = 0; r < R; ++r) { const GAS f32x4* xr = (const GAS f32x4*)(x0 + r * rstride) + lane;
#pragma unroll
        for (int j = 0; j < 4; ++j) v[r][j] = xr[64 * j]; }
#pragma unroll
    for (int r = 0; r < R; ++r) { float s = 0.f;
#pragma unroll
        for (int j = 0; j < 4; ++j) s += (v[r][j].x * v[r][j].x + v[r][j].y * v[r][j].y) + (v[r][j].z * v[r][j].z + v[r][j].w * v[r][j].w);
        const float rs = 1.0f / sqrtf(wave_sum(s) * (1.f / D) + RMS_EPS);
        GAS unsigned long long* o8 = (GAS unsigned long long*)(o0 + r * rstride) + lane;
#pragma unroll
        for (int j = 0; j < 4; ++j) o8[64 * j] = (unsigned long long)pk2(v[r][j].x * rs * gg[j].x, v[r][j].y * rs * gg[j].y) | ((unsigned long long)pk2(v[r][j].z * rs * gg[j].z, v[r][j].w * rs * gg[j].w) << 32); }
}
template <int R> __device__ __forceinline__ void rows_to_bf16_rinv(const float* x0, size_t rstride, bf16* o0, float* rinv, size_t istride, int lane) {
    f32x4 v[R][4];
#pragma unroll
    for (int r = 0; r < R; ++r) { const GAS f32x4* xr = (const GAS f32x4*)(x0 + r * rstride) + lane;
#pragma unroll
        for (int j = 0; j < 4; ++j) v[r][j] = xr[64 * j]; }
#pragma unroll
    for (int r = 0; r < R; ++r) { float s = 0.f; GAS unsigned long long* o8 = (GAS unsigned long long*)(o0 + r * rstride) + lane;
#pragma unroll
        for (int j = 0; j < 4; ++j) { s += (v[r][j].x * v[r][j].x + v[r][j].y * v[r][j].y) + (v[r][j].z * v[r][j].z + v[r][j].w * v[r][j].w);
            o8[64 * j] = (unsigned long long)pk2(v[r][j].x, v[r][j].y) | ((unsigned long long)pk2(v[r][j].z, v[r][j].w) << 32); }
        const float rs = 1.0f / sqrtf(wave_sum(s) * (1.f / D) + RMS_EPS);
        if (lane == 0) rinv[r * istride] = rs; }
}
__device__ __forceinline__ f32x4 bf4(unsigned long long w) { const unsigned w0 = (unsigned)w, w1 = (unsigned)(w >> 32); return (f32x4){pg8::bf_lo(w0), pg8::bf_hi(w0), pg8::bf_lo(w1), pg8::bf_hi(w1)}; }
__device__ __forceinline__ unsigned long long pk4(f32x4 v) { return (unsigned long long)pk2(v.x, v.y) | ((unsigned long long)pk2(v.z, v.w) << 32); }
__device__ __forceinline__ float sq4(f32x4 v) { return (v.x * v.x + v.y * v.y) + (v.z * v.z + v.w * v.w); }

__global__ void __launch_bounds__(NWAVES * 64, 2) fwd(Args args) {
    extern __shared__ __attribute__((aligned(16))) unsigned char lds[];
    LAS unsigned char* L = (LAS unsigned char*)lds;
    volatile LAS unsigned* MISC = (volatile LAS unsigned*)(L + MISC_OFF);
    const int tid = threadIdx.x, lane = tid & 63, wave = __builtin_amdgcn_readfirstlane(tid >> 6);
    const int G = gridDim.x; const int bx = blockIdx.x; const int vcu = (G % 8 == 0) ? (bx % 8) * (G / 8) + bx / 8 : bx;
    unsigned char* ws = args.ws;
    gu32* ctl = (gu32*)(ws + WS_CTL);
    const int gtid = vcu * (NWAVES * 64) + tid, NTHR = G * NWAVES * 64;
    for (int u = tid; u < (LDS_BYTES - LDSCTL_OFF) / 4; u += NWAVES * 64) ((LAS unsigned*)(L + LDSCTL_OFF))[u] = 0u;
    __syncthreads();
    XcdBarrier bar; bar.bar = (unsigned*)(ctl + CW_BAR) + args.li * XCD_BAR_WORDS; bar.x = xb_xcc_id(); bar.st = MISC + 8;
    if (!MK_PER_PHASE && tid == 0) MISC[10] = xb_add(&bar.bar[XB_XCNT(bar.x)], 1u);
    unsigned xl_gen = 0u;
    int cu = bx; bool xloc = false;
#define GRID_BAR() do { if (MK_PER_PHASE) { if (tid == 0) __hip_atomic_store(ctl + CW_TMO, 0xBADBA0u, RLX_AGENT); } else { xcd_barrier(bar); } } while (0)
#define ENSURE_CENSUS() do { if (!MK_PER_PHASE) { __syncthreads(); \
        if (tid == 0) { if (MISC[8] == 0u) { unsigned nloc_, nx_; xcd_barrier_complete(bar.bar, bar.x, nloc_, nx_); MISC[8] = nloc_; MISC[9] = nx_; } \
            if (MISC[11] == 0u) { bool uni_ = (G == 256); for (unsigned j_ = 0; j_ < 16; ++j_) { const unsigned c_ = xb_ld(&bar.bar[XB_XCNT(j_)]); uni_ = uni_ && (c_ == (j_ < 8u ? 32u : 0u)); } MISC[11] = uni_ ? 2u : 1u; } } \
        __syncthreads(); xloc = (MISC[11] == 2u); if (xloc) cu = (int)MISC[10] * 8 + (int)bar.x; } } while (0)
#define XL_WORD ((unsigned*)(ctl + CW_XL) + args.li * 1024 + 64 * bar.x)
#define SEAM_BAR() do { if (MK_PER_PHASE) { if (tid == 0) __hip_atomic_store(ctl + CW_TMO, 0xBADBA0u, RLX_AGENT); } \
      else if (xloc) { VM_WAIT(); __syncthreads(); \
          if (tid == 0) { __builtin_amdgcn_s_waitcnt(0); (void)xb_add(XL_WORD, 1u); const unsigned want_ = (xl_gen + 1u) * 32u; XB_SPIN(xb_ld(XL_WORD) < want_, bar.bar); \
              __builtin_amdgcn_fence(__ATOMIC_ACQUIRE, "agent"); asm volatile("s_waitcnt vmcnt(0)" ::: "memory"); } \
          ++xl_gen; __syncthreads(); } \
      else { xcd_barrier(bar); } } while (0)
    const int lo = args.ph_lo, hi = args.ph_hi;
#define IN(k) (lo <= (k) && (k) < hi)
#define BOTH(k) (IN(k) && IN((k) + 1))
    const int gw = vcu * NWAVES + wave, NGW = G * NWAVES;
#ifndef RB
#define RB 2
#endif
#define ROWDEAL const int rbase = xloc ? (int)bar.x * SEQ : 0, rfirst = xloc ? (cu >> 3) * NWAVES + wave : gw, rstep = xloc ? 32 * NWAVES : NGW, rlim = xloc ? SEQ : M

    if (IN(0)) { PH_PTRS;
        LAS float* scr = (LAS float*)(L + RING_OFF + wave * 16384);
        constexpr int I_IN = (D / 64) * (NIN / 32), I_GLU = (SW / 64) * (SW / 32), I_A = (SW / 64) * (D / 32), I_O = (D / 64) * (D / 32), I_1 = (D / 64) * (FF / 32), I_2 = (FF / 64) * (D / 32);
        constexpr int NITEMS = I_IN + I_GLU + 2 * I_A + I_O + I_1 + I_2;
        for (int it = gw; it < NITEMS; it += NGW) {
            int r = it;
            if (r < I_IN) { p0_transpose_item(args.in[2], D, NIN, Win_t, 0, scr, r, lane, args.in[1]); continue; } r -= I_IN;
            if (r < I_GLU) { p0_transpose_item(args.in[11], SW, SW, Wglu_t, 0, scr, r, lane); continue; } r -= I_GLU;
            if (r < I_A) { p0_transpose_item(args.in[13], SW, D, Wa_t, 0, scr, r, lane); continue; } r -= I_A;
            if (r < I_A) { p0_transpose_item(args.in[14], AW, D, Wb_t, 0, scr, r, lane); continue; } r -= I_A;
            if (r < I_O) { p0_transpose_item(args.in[15], D, D, Wo_t, 0, scr, r, lane); continue; } r -= I_O;
            if (r < I_1) { p0_transpose_item(args.in[18], D, FF, W1_t, 0, scr, r, lane, args.in[17]); continue; } r -= I_1;
            p0_transpose_item(args.in[19], FF, D, W2_t, 0, scr, r, lane);
        }
        for (int m = gw; m < M; m += 4 * NGW) rows_to_bf16_rinv<4>(x + (size_t)m * D, (size_t)NGW * D, XB + (size_t)m * D, rinv1 + m, (size_t)NGW, lane);
        const float *lam_re = args.in[3], *lam_im = args.in[4], *log_dt = args.in[5], *b_re = args.in[6], *b_im = args.in[7], *c_re = args.in[8], *c_im = args.in[9];
        if ((gtid & 63) == 1 && (gtid >> 6) < NG * NP) { const int gp = gtid >> 6, g = gp / NP;
            const double lr = (double)lam_re[gp], li = (double)lam_im[gp], dt = exp((double)log_dt[g]);
            double ar, ai, cr, ci, a1r, a1i; cpowk(lr, li, dt, 1.0, a1r, a1i); ar = a1r; ai = a1i; zoh_from_a(a1r, a1i, lr, li, cr, ci);
            tab[TB_ABR + gp] = (float)ar; tab[TB_ABI + gp] = (float)ai;
            cipow(a1r, a1i, 16, ar, ai); tab[TB_A16R + gp] = (float)ar; tab[TB_A16I + gp] = (float)ai;
            cipow(a1r, a1i, 512, ar, ai); tab[TB_A512R + gp] = (float)ar; tab[TB_A512I + gp] = (float)ai;
            for (int h = 0; h < GH; ++h) { const double br = (double)b_re[gp * GH + h], bi = (double)b_im[gp * GH + h];
                tab[TB_BBR + gp * GH + h] = (float)(cr * br - ci * bi); tab[TB_BBI + gp * GH + h] = (float)(cr * bi + ci * br); } }
        for (int e = gtid >> 2; (gtid & 3) == 2 && e < NG * NP * 16; e += NTHR >> 2) {
            const int p = e % NP, s_ = (e / NP) % 16, g = e / (NP * 16), gp = g * NP + p;
            const double lr = (double)lam_re[gp], li = (double)lam_im[gp], dt = exp((double)log_dt[g]);
            double wr_, wi_, cr, ci, a1r, a1i; cpowk(lr, li, dt, 1.0, a1r, a1i); cipow(a1r, a1i, 15 - s_, wr_, wi_); zoh_from_a(a1r, a1i, lr, li, cr, ci);
            float vr[GH], vi[GH];
#pragma unroll
            for (int h = 0; h < GH; ++h) { const double br = (double)b_re[gp * GH + h], bi = (double)b_im[gp * GH + h], Br = cr * br - ci * bi, Bi = cr * bi + ci * br;
                vr[h] = (float)(wr_ * Br - wi_ * Bi); vi[h] = (float)(wr_ * Bi + wi_ * Br); }
            GAS v4u* o_r = (GAS v4u*)(WsT + ((size_t)(g * 256 + p)) * 256 + s_ * 16); GAS v4u* o_i = (GAS v4u*)(WsT + ((size_t)(g * 256 + 64 + p)) * 256 + s_ * 16);
            o_r[0] = (v4u){pk2(vr[0], vr[1]), pk2(vr[2], vr[3]), pk2(vr[4], vr[5]), pk2(vr[6], vr[7])}; o_r[1] = (v4u){pk2(vr[8], vr[9]), pk2(vr[10], vr[11]), pk2(vr[12], vr[13]), pk2(vr[14], vr[15])};
            o_i[0] = (v4u){pk2(vi[0], vi[1]), pk2(vi[2], vi[3]), pk2(vi[4], vi[5]), pk2(vi[6], vi[7])}; o_i[1] = (v4u){pk2(vi[8], vi[9]), pk2(vi[10], vi[11]), pk2(vi[12], vi[13]), pk2(vi[14], vi[15])}; }
        for (int e = gtid; e < NG * 4096; e += NTHR) {
            const int g = e / 4096, r = e % 4096; ((GAS v4u*)(WsT + ((size_t)(g * 256 + 128)) * 256))[r] = (v4u){0u, 0u, 0u, 0u}; }
        for (int e = gtid >> 2; (gtid & 3) == 3 && e < NG * NP * 16; e += NTHR >> 2) {
            const int p = e % NP, t = (e / NP) % 16, g = e / (NP * 16), gp = g * NP + p;
            const double lr = (double)lam_re[gp], li = (double)lam_im[gp], dt = exp((double)log_dt[g]);
            double wr_, wi_, a1r, a1i; cpowk(lr, li, dt, 1.0, a1r, a1i); cipow(a1r, a1i, t + 1, wr_, wi_);
            for (int h = 0; h < GH; ++h) { const double cr = (double)c_re[(g * GH + h) * NP + p], ci = (double)c_im[(g * GH + h) * NP + p];
                bf16* o = KG + ((size_t)(g * 256 + t * 16 + h)) * 384 + 256 + p;
                o[0] = (bf16)f2bf((float)(cr * wr_ - ci * wi_)); o[64] = (bf16)f2bf((float)(-(cr * wi_ + ci * wr_))); } }
        for (int wt = gw >> 2; (gw & 3) == 0 && wt < NG * 16; wt += NGW >> 2) {
            const int g = wt / 16, j = wt % 16, p = lane, gp = g * NP + p;
            const double lr = (double)lam_re[gp], li = (double)lam_im[gp], dt = exp((double)log_dt[g]);
            double wr_, wi_, cr, ci, a1r, a1i; cpowk(lr, li, dt, 1.0, a1r, a1i); cipow(a1r, a1i, j, wr_, wi_); zoh_from_a(a1r, a1i, lr, li, cr, ci);
            float Br[GH], Bi[GH];
#pragma unroll
            for (int h = 0; h < GH; ++h) { const double br = (double)b_re[gp * GH + h], bi = (double)b_im[gp * GH + h]; Br[h] = (float)(cr * br - ci * bi); Bi[h] = (float)(cr * bi + ci * br); }
            for (int hp = 0; hp < GH; ++hp) { const double c1 = (double)c_re[(g * GH + hp) * NP + p], c2 = (double)c_im[(g * GH + hp) * NP + p];
                const float cwr = (float)(c1 * wr_ - c2 * wi_), cwi = (float)(c1 * wi_ + c2 * wr_);
                float v[GH];
#pragma unroll
                for (int h = 0; h < GH; ++h) v[h] = cwr * Br[h] - cwi * Bi[h];
                const float tot = reduce16(v, lane);
                if ((lane & 3) == 0) scr[hp * 16 + (lane >> 2)] = tot; }
            LDS_WAIT(); asm volatile("" ::: "memory");
            if (lane < 32) { const int hp = lane >> 1, hf = lane & 1; const LAS float* k8 = scr + hp * 16 + hf * 8;
                const v4u w = (v4u){pk2(k8[0], k8[1]), pk2(k8[2], k8[3]), pk2(k8[4], k8[5]), pk2(k8[6], k8[7])};
                for (int t = j; t < 16; ++t) *(GAS v4u*)(KG + ((size_t)(g * 256 + t * 16 + hp)) * 384 + (t - j) * 16 + hf * 8) = w; }
            LDS_WAIT(); asm volatile("" ::: "memory"); }
        for (int e = gtid; e < NG * 256 * 32; e += NTHR) {
            const int kc = e % 32, n = (e / 32) % 256, g_ = e / (32 * 256);
            if ((kc >> 1) > (n >> 4)) *(GAS v4u*)(KG + ((size_t)(g_ * 256 + n)) * 384 + kc * 8) = (v4u){0u, 0u, 0u, 0u}; }
        if (BOTH(0)) GRID_BAR();
    }
    if (hi > 1) ENSURE_CENSUS();

    if (IN(1)) { PH_PTRS;
        pg8::Gemm g{XB, Win_t, M, NIN, D, D, D}; pg8::StaticOrder S; S.init(M, NIN, G, cu);
        pg8::EpiIn E{wsl, (unsigned)WS_ZX, (unsigned)WS_Q, (unsigned)WS_K, (unsigned)WS_V, (unsigned)WS_SGA, (unsigned)WS_SGB, ksum, C2, rinv1};
        pg8::gemm_phase<pg8::EpiIn, pg8::StaticOrder, true, true>(L + RING_OFF, g, S, E);
        if (BOTH(1)) SEAM_BAR();
    }

    if (IN(2)) { PH_PTRS;
#if SSM_NAIVE
        if (wave == 0) {
            for (int item = vcu; item < BATCH * NG; item += G) {
                const int b = item / NG, g = item % NG, p = lane;
                const float abr = tab[TB_ABR + g * NP + p], abi = tab[TB_ABI + g * NP + p];
                float bbr[GH], bbi[GH], cr[GH], ci[GH];
#pragma unroll
                for (int h = 0; h < GH; ++h) { bbr[h] = tab[TB_BBR + (g * NP + p) * GH + h]; bbi[h] = tab[TB_BBI + (g * NP + p) * GH + h];
                    cr[h] = args.in[8][(g * GH + h) * NP + p]; ci[h] = args.in[9][(g * GH + h) * NP + p]; }
                const int hme = lane >> 2;
                const float dsk = args.in[10][g * GH + hme];
                float xr = 0.f, xi = 0.f;
                const bf16* zrow = ZX + (size_t)((g * 8 + b) * 256) * 384;
                bf16* vrow = VS + (size_t)b * SEQ * SW + g * GH;
                for (int t = 0; t < SEQ; ++t) {
                    const v4u w0 = *(const GAS v4u*)(zrow + (size_t)(t >> 4) * 384 + (t & 15) * 16), w1 = *(const GAS v4u*)(zrow + (size_t)(t >> 4) * 384 + (t & 15) * 16 + 8);
                    float uu[GH];
                    uu[0] = pg8::bf_lo(w0.x); uu[1] = pg8::bf_hi(w0.x); uu[2] = pg8::bf_lo(w0.y); uu[3] = pg8::bf_hi(w0.y); uu[4] = pg8::bf_lo(w0.z); uu[5] = pg8::bf_hi(w0.z); uu[6] = pg8::bf_lo(w0.w); uu[7] = pg8::bf_hi(w0.w);
                    uu[8] = pg8::bf_lo(w1.x); uu[9] = pg8::bf_hi(w1.x); uu[10] = pg8::bf_lo(w1.y); uu[11] = pg8::bf_hi(w1.y); uu[12] = pg8::bf_lo(w1.z); uu[13] = pg8::bf_hi(w1.z); uu[14] = pg8::bf_lo(w1.w); uu[15] = pg8::bf_hi(w1.w);
                    float bur = 0.f, bui = 0.f;
#pragma unroll
                    for (int h = 0; h < GH; ++h) { bur += bbr[h] * uu[h]; bui += bbi[h] * uu[h]; }
                    const float nxr = abr * xr - abi * xi + bur, nxi = abr * xi + abi * xr + bui; xr = nxr; xi = nxi;
                    float v[GH];
#pragma unroll
                    for (int h = 0; h < GH; ++h) v[h] = cr[h] * xr - ci[h] * xi;
                    const float a1 = reduce16(v, lane);
                    float um = uu[0];
#pragma unroll
                    for (int h = 1; h < GH; ++h) um = (hme == h) ? uu[h] : um;
                    const float y = a1 + dsk * um;
                    if ((lane & 3) == 0) vrow[(size_t)t * SW + hme] = (bf16)f2bf(gelu_tanh(y));
                }
            }
        }
#else
        if (cu < NG * BATCH) { const int item = cu;
            const int g_ = item >> 3, b_ = item & 7;
            { pg8::Gemm gm{ZX, WsT + (size_t)g_ * 256 * 256, NG * BATCH * 256, 256, 256, 384, 256}; pg8::OneUnit S{item, 0};
              pg8::EpiSsmState E{ZX + (size_t)item * 256 * 384, tab + TB_A16R + g_ * NP, tab + TB_A16I + g_ * NP, tab + TB_A512R + g_ * NP, tab + TB_A512I + g_ * NP};
              pg8::gemm_phase<pg8::EpiSsmState, pg8::OneUnit, false, true>(L + RING_OFF, gm, S, E); }
            VM_WAIT(); __syncthreads();
            { pg8::Gemm gm{ZX, KG + (size_t)g_ * 256 * 384, NG * BATCH * 256, 256, 384, 384, 384}; pg8::OneUnit S{item, 0};
              pg8::EpiSsmOut E{ZX + (size_t)item * 256 * 384, VS + (size_t)b_ * SEQ * SW + g_ * GH, args.in[10] + g_ * GH};
              pg8::gemm_phase<pg8::EpiSsmOut, pg8::OneUnit, true, true>(L + RING_OFF, gm, S, E); }
            __syncthreads();
        }
#endif
    }
    if (IN(3)) { PH_PTRS;
        { const attn_body::AttnTensors AT{(const attn_body::bf16*)Qb, (const attn_body::bf16*)Kb, (const attn_body::bf16*)Vb, (attn_body::bf16*)U, ksum};
          const attn_body::StaticOrder S(G, cu);
          attn_body::attn_phase<attn_body::StaticOrder>((char*)lds + RING_OFF, AT, S); }
        if (BOTH(3)) SEAM_BAR();
    }

    if (IN(4)) { PH_PTRS;
        pg8::Gemm g{VS, Wglu_t, M, SW, SW, SW, SW}; pg8::StaticOrder S; S.init(M, SW, G, cu);
        pg8::EpiGlu E{VS, YA, args.in[12]};
        pg8::gemm_phase<pg8::EpiGlu, pg8::StaticOrder, true, true>(L + RING_OFF, g, S, E);
        if (BOTH(4)) SEAM_BAR();
    }
    if (IN(5)) { PH_PTRS;
        pg8::Gemm g{U, Wb_t, M, D, AW, AW, AW}; pg8::BranchOrder S; S.base.init(M, D, G, cu); S.aoff1 = (long)WS_YA - (long)WS_U; S.boff1 = (long)WS_WA - (long)WS_WB;
        pg8::EpiGate2 E{(const unsigned char*)SGA, (const unsigned char*)SGB, MG};
        pg8::gemm_phase<pg8::EpiGate2, pg8::BranchOrder, true, true>(L + RING_OFF, g, S, E);
        if (IN(5) && IN(7)) SEAM_BAR();
    }
    if (IN(7)) { PH_PTRS;
        pg8::Gemm g{MG, Wo_t, M, D, D, D, D}; pg8::StaticOrder S; S.init(M, D, G, cu);
        pg8::EpiBf16<0> E{MIX, D, nullptr, 0, 0, 1.f};
        pg8::gemm_phase<pg8::EpiBf16<0>, pg8::StaticOrder, true, true>(L + RING_OFF, g, S, E);
        if (BOTH(7)) SEAM_BAR();
    }
    if (IN(8)) { PH_PTRS;
        f32x4 gpost[4];
#pragma unroll
        for (int j = 0; j < 4; ++j) gpost[j] = ((const GAS f32x4*)args.in[16] + lane)[64 * j];
        ROWDEAL;
        bf16* H1 = MG;
        for (int m0 = rfirst; m0 < rlim; m0 += RB * rstep) {
            f32x4 xv[RB][4], mv[RB][4];
#pragma unroll
            for (int r = 0; r < RB; ++r) { const size_t m = (size_t)rbase + (size_t)m0 + (size_t)r * rstep; const GAS unsigned long long* xr = (const GAS unsigned long long*)(XB + m * D) + lane; const GAS unsigned long long* mr = (const GAS unsigned long long*)(MIX + m * D) + lane;
#pragma unroll
                for (int j = 0; j < 4; ++j) { xv[r][j] = bf4(xr[64 * j]); mv[r][j] = bf4(mr[64 * j]); } }
#pragma unroll
            for (int r = 0; r < RB; ++r) { const size_t m = (size_t)rbase + (size_t)m0 + (size_t)r * rstep; float s = 0.f;
#pragma unroll
                for (int j = 0; j < 4; ++j) s += sq4(mv[r][j]);
                const float rs = 1.0f / sqrtf(wave_sum(s) * (1.f / D) + RMS_EPS); float s2 = 0.f;
                GAS unsigned long long* h8 = (GAS unsigned long long*)(H1 + m * D) + lane;
#pragma unroll
                for (int j = 0; j < 4; ++j) { xv[r][j] = xv[r][j] + (mv[r][j] * rs) * gpost[j]; h8[64 * j] = pk4(xv[r][j]); s2 += sq4(xv[r][j]); }
                const float r2 = 1.0f / sqrtf(wave_sum(s2) * (1.f / D) + RMS_EPS);
                if (lane == 0) rinv2[m] = r2; }
        }
        if (BOTH(8)) SEAM_BAR();
    }
    if (IN(9)) { PH_PTRS;
        pg8::Gemm g{MG, W1_t, M, FF, D, D, D}; pg8::StaticOrder S; S.init(M, FF, G, cu);
        pg8::EpiRelu2T E{HM, FF / 64, rinv2};
        pg8::gemm_phase<pg8::EpiRelu2T, pg8::StaticOrder, true, true>(L + RING_OFF, g, S, E);
        if (BOTH(9)) SEAM_BAR();
    }
    if (IN(10)) { PH_PTRS;
        pg8::Gemm g{HM, W2_t, M, D, FF, 64, FF, 256 * 64 * 2, 256 * FF * 2}; pg8::StaticOrder S; S.init(M, D, G, cu);
        pg8::EpiBf16<0> E{U, D, nullptr, 0, 0, 1.f};
        pg8::gemm_phase<pg8::EpiBf16<0>, pg8::StaticOrder, true, true>(L + RING_OFF, g, S, E);
        if (BOTH(10)) SEAM_BAR();
    }
    if (IN(11)) { PH_PTRS;
        f32x4 gp[4];
#pragma unroll
        for (int j = 0; j < 4; ++j) gp[j] = ((const GAS f32x4*)args.in[20] + lane)[64 * j];
        ROWDEAL;
        const bf16* H1 = MG;
        for (int m0 = rfirst; m0 < rlim; m0 += RB * rstep) {
            f32x4 hv[RB][4], fv[RB][4];
#pragma unroll
            for (int r = 0; r < RB; ++r) { const size_t m = (size_t)rbase + (size_t)m0 + (size_t)r * rstep; const GAS unsigned long long* hr = (const GAS unsigned long long*)(H1 + m * D) + lane; const GAS unsigned long long* fr = (const GAS unsigned long long*)(U + m * D) + lane;
#pragma unroll
                for (int j = 0; j < 4; ++j) { hv[r][j] = bf4(hr[64 * j]); fv[r][j] = bf4(fr[64 * j]); } }
#pragma unroll
            for (int r = 0; r < RB; ++r) { const size_t m = (size_t)rbase + (size_t)m0 + (size_t)r * rstep; float s = 0.f;
#pragma unroll
                for (int j = 0; j < 4; ++j) s += sq4(fv[r][j]);
                const float rs = 1.0f / sqrtf(wave_sum(s) * (1.f / D) + RMS_EPS);
                GAS f32x4* orow = (GAS f32x4*)(out + m * D) + lane;
#pragma unroll
                for (int j = 0; j < 4; ++j) orow[64 * j] = hv[r][j] + (fv[r][j] * rs) * gp[j]; }
        }
    }
#undef IN
#undef BOTH
}

extern "C" void kernel_launch(void* const* d_in, const int* in_sizes, int n_in, void* d_out, int out_size, void* d_ws, size_t ws_size, hipStream_t stream) {
    static int grid = 0;
    if (grid == 0) {
        if (n_in != 21 || in_sizes[0] != M * D || out_size != M * D || ws_size < WS_END) { fprintf(stderr, "kernel_launch: unexpected shapes / workspace (n_in %d, ws %zu)\n", n_in, ws_size); grid = -1; return; }
        int dev = 0, cus = 0, per_cu = 0;
        if (hipGetDevice(&dev) != hipSuccess || hipDeviceGetAttribute(&cus, hipDeviceAttributeMultiprocessorCount, dev) != hipSuccess) { grid = -1; return; }
        if (hipFuncSetAttribute((const void*)fwd, hipFuncAttributeMaxDynamicSharedMemorySize, LDS_BYTES) != hipSuccess) { fprintf(stderr, "kernel_launch: hipFuncSetAttribute failed\n"); grid = -1; return; }
        if (hipOccupancyMaxActiveBlocksPerMultiprocessor(&per_cu, (const void*)fwd, NWAVES * 64, LDS_BYTES) != hipSuccess || per_cu < 1) { fprintf(stderr, "kernel_launch: occupancy query says %d\n", per_cu); }
        (void)hipGetLastError();
        grid = cus;
    }
    if (grid < 0) return;
    if (hipMemsetAsync((char*)d_ws + WS_CTL, 0, CTL_ZERO_BYTES, stream) != hipSuccess) return;
    Args a{};
    for (int i = 0; i < 21; ++i) a.in[i] = (const float*)d_in[i];
    a.out = (float*)d_out; a.ws = (unsigned char*)d_ws;
#ifndef PROBE
#define PROBE 0
#endif
#if MK_PER_PHASE
    for (int p = 0; p < NPHASES; ++p) { a.ph_lo = p; a.ph_hi = p + 1; a.li = 0; hipLaunchKernelGGL(fwd, dim3(grid), dim3(NWAVES * 64), LDS_BYTES, stream, a); }
#else
#if PROBE == 0
    static const int seq[][2] = {{0, NPHASES}};
#elif PROBE == 1
    static const int seq[][2] = {{0, 3}, {2, NPHASES}};
#elif PROBE == 2
    static const int seq[][2] = {{0, 4}, {3, NPHASES}};
#elif PROBE == 3
    static const int seq[][2] = {{0, 1}, {0, NPHASES}};
#elif PROBE == 4
    static const int seq[][2] = {{0, 9}, {8, NPHASES}};
#elif PROBE == 5
    static const int seq[][2] = {{0, 7}, {4, NPHASES}};
#elif PROBE == 7
    static const int seq[][2] = {{0, 10}, {9, NPHASES}};
#elif PROBE == 8
    static const int seq[][2] = {{0, 11}, {10, NPHASES}};
#elif PROBE == 9
    static const int seq[][2] = {{0, 2}, {1, NPHASES}};
#elif PROBE == 10
    static const int seq[][2] = {{0, 5}, {4, NPHASES}};
#elif PROBE == 11
    static const int seq[][2] = {{0, 7}, {5, NPHASES}};
#elif PROBE == 12
    static const int seq[][2] = {{0, 5}, {5, NPHASES}};
#elif PROBE == 6
    static const int seq[][2] = {{0, 8}, {7, NPHASES}};
#endif
    for (int li = 0; li < (int)(sizeof(seq) / sizeof(seq[0])); ++li) { a.ph_lo = seq[li][0]; a.ph_hi = seq[li][1]; a.li = li; hipLaunchKernelGGL(fwd, dim3(grid), dim3(NWAVES * 64), LDS_BYTES, stream, a); }
#endif
}
```
